# Optimizing an MI355X kernel written in HIP

```python
import math
import jax, jax.numpy as jnp
from jax import lax
import numpy as np

D_MODEL = 2048
BATCH = 1
SEQ = 16384
DEPTH = 1

HEAD_DIM = 64
NSA_HEADS = 8
NSA_KV_HEADS = 2
NSA_HPG = NSA_HEADS // NSA_KV_HEADS
FOX_HEADS = 8
MIX_W = NSA_HEADS * HEAD_DIM
CMP_LEN = 32
CMP_STRIDE = 16
CMP_HID = 256
SLC_LEN = 64
SLC_TOPK = 16
WINDOW = 512
Q_BLOCK = 128
T5_BUCKETS = 32
T5_MAX_EXACT = 16
T5_MAX_DIST = 128
N_GROUPS = 8
EXPERTS_PER_GROUP = 8
N_EXPERTS = N_GROUPS * EXPERTS_PER_GROUP
TOP_K_EXPERTS = 2
D_EXPERT = 512
ROW_BLOCK = 128
LN_EPS = 1e-5
NEG_INF = -1e30
FORCE_SCORE = 1e4
DEEPNORM_ALPHA = (2 * DEPTH) ** 0.25
DEEPNORM_BETA = (8 * DEPTH) ** -0.25

C_NSA_Q = NSA_HEADS * HEAD_DIM
C_NSA_KV = 6 * NSA_KV_HEADS * HEAD_DIM
C_NSA_GATE = 3 * NSA_HEADS
C_FOX_QKV = 3 * FOX_HEADS * HEAD_DIM
C_FOX_F = FOX_HEADS
C_MERGE = 2 * D_MODEL
OFF_KV = C_NSA_Q
OFF_GATE = OFF_KV + C_NSA_KV
OFF_FOX = OFF_GATE + C_NSA_GATE
OFF_FGT = OFF_FOX + C_FOX_QKV
OFF_MERGE = OFF_FGT + C_FOX_F
IN_COLS = OFF_MERGE + C_MERGE

kernel_name = "hybrid_nsa_fox_hmoe_block"


def layer_norm(x, g=None, b=None):
    xf = x.astype(jnp.float32)
    mu = xf.mean(-1, keepdims=True)
    var = jnp.square(xf - mu).mean(-1, keepdims=True)
    y = (xf - mu) * lax.rsqrt(var + LN_EPS)
    if g is not None:
        y = y * g.astype(jnp.float32) + b.astype(jnp.float32)
    return y.astype(x.dtype)


def masked_softmax(s, mask):
    p = jax.nn.softmax(jnp.where(mask, s, NEG_INF), axis=-1)
    return p * mask.any(-1, keepdims=True)


def t5_bucket(dist):
    n = jnp.maximum(dist, 0)
    ratio = jnp.log(jnp.maximum(n, T5_MAX_EXACT).astype(jnp.float32) / T5_MAX_EXACT)
    big = T5_MAX_EXACT + (ratio / math.log(T5_MAX_DIST / T5_MAX_EXACT)
                          * (T5_BUCKETS - T5_MAX_EXACT)).astype(jnp.int32)
    return jnp.where(n < T5_MAX_EXACT, n, jnp.minimum(big, T5_BUCKETS - 1))


def split_heads(a, n_heads):
    B, S, _ = a.shape
    return a.reshape(B, S, n_heads, HEAD_DIM).transpose(0, 2, 1, 3)


def compress_kv(kv, pe, w1, b1, w2):
    S = kv.shape[3]
    n_cmp = (S - CMP_LEN) // CMP_STRIDE + 1
    idx = jnp.arange(n_cmp)[:, None] * CMP_STRIDE + jnp.arange(CMP_LEN)[None, :]
    blocks = kv[:, :, :, idx, :] + pe[:, None, None, None]
    flat = blocks.reshape(*blocks.shape[:4], CMP_LEN * HEAD_DIM)
    hid = jax.nn.gelu(jnp.einsum('zbgnf,zfh->zbgnh', flat, w1) + b1[:, None, None, None])
    return jnp.einsum('zbgnh,zhd->zbgnd', hid, w2)


def gather_blocks(blocks, sel):
    return jax.vmap(jax.vmap(lambda bl, ix: bl[ix]))(blocks, sel)


def nsa_attention(q, k_cmp, v_cmp, k_slc, v_slc, k_win, v_win, gates, t5_table):
    B, G, HPG, S, HD = q.shape
    n_cmp = k_cmp.shape[2]
    n_slc = S // SLC_LEN
    n_sel = min(SLC_TOPK, n_slc)
    ratio = SLC_LEN // CMP_STRIDE
    scale = HD ** -0.5
    tb = t5_table.T.reshape(G, HPG, T5_BUCKETS).astype(jnp.float32)
    g_ix = jnp.arange(G)[None, :, None, None, None]
    h_ix = jnp.arange(HPG)[None, None, :, None, None]
    cmp_end = jnp.arange(n_cmp) * CMP_STRIDE + CMP_LEN - 1
    w_main = jnp.array([0.5] + [1.0] * (ratio - 1), jnp.float32)
    blk = jnp.arange(n_slc)
    win_off = jnp.arange(WINDOW + Q_BLOCK)

    def block(qb):
        q0 = qb * Q_BLOCK
        t = q0 + jnp.arange(Q_BLOCK)
        qblk = lax.dynamic_slice_in_dim(q, q0, Q_BLOCK, axis=3)
        gblk = lax.dynamic_slice_in_dim(gates, q0, Q_BLOCK, axis=3)
        s_c = (jnp.einsum('bghtd,bgnd->bghtn', qblk, k_cmp).astype(jnp.float32) * scale
               + tb[:, :, t5_bucket(t[:, None] - cmp_end[None, :])])
        p_c = masked_softmax(s_c, cmp_end[None, :] <= t[:, None])
        o_c = jnp.einsum('bghtn,bgnd->bghtd', p_c.astype(v_cmp.dtype), v_cmp)
        imp = jnp.pad(p_c.sum(2), ((0, 0), (0, 0), (0, 0), (1, ratio * n_slc - n_cmp)))
        p_slc = (imp[..., :ratio * n_slc].reshape(B, G, Q_BLOCK, n_slc, ratio) @ w_main
                 + 0.5 * imp[..., ratio::ratio])
        cur = (t // SLC_LEN)[:, None]
        forced = (blk == 0) | (blk == cur) | (blk == cur - 1)
        score = jnp.where(forced, FORCE_SCORE, jnp.where(blk <= cur, p_slc, -1.0))
        _, sel = lax.top_k(score, n_sel)
        k_sel = gather_blocks(k_slc, sel).reshape(B, G, Q_BLOCK, n_sel * SLC_LEN, HD)
        v_sel = gather_blocks(v_slc, sel).reshape(B, G, Q_BLOCK, n_sel * SLC_LEN, HD)
        kpos = (sel[..., None] * SLC_LEN + jnp.arange(SLC_LEN)).reshape(B, G, Q_BLOCK, n_sel * SLC_LEN)
        bucket_s = t5_bucket(t[:, None] - kpos)[:, :, None]
        s_s = (jnp.einsum('bghtd,bgtkd->bghtk', qblk, k_sel).astype(jnp.float32) * scale
               + tb[g_ix, h_ix, bucket_s])
        p_s = masked_softmax(s_s, (kpos <= t[:, None])[:, :, None])
        o_s = jnp.einsum('bghtk,bgtkd->bghtd', p_s.astype(v_sel.dtype), v_sel)
        kw = lax.dynamic_slice_in_dim(k_win, q0, WINDOW + Q_BLOCK, axis=2)
        vw = lax.dynamic_slice_in_dim(v_win, q0, WINDOW + Q_BLOCK, axis=2)
        wpos = q0 - WINDOW + win_off
        dist = t[:, None] - wpos[None, :]
        s_w = (jnp.einsum('bghtd,bgkd->bghtk', qblk, kw).astype(jnp.float32) * scale
               + tb[:, :, t5_bucket(dist)])
        p_w = masked_softmax(s_w, (dist >= 0) & (dist < WINDOW) & (wpos[None, :] >= 0))
        o_w = jnp.einsum('bghtk,bgkd->bghtd', p_w.astype(vw.dtype), vw)
        return gblk[..., 0:1] * o_c + gblk[..., 1:2] * o_s + gblk[..., 2:3] * o_w

    out = lax.map(block, jnp.arange(S // Q_BLOCK))
    return out.transpose(1, 0, 4, 2, 3, 5).reshape(B, S, G * HPG * HD)


def forgetting_attention(q, k, v, log_f):
    B, H, S, HD = q.shape
    scale = HD ** -0.5
    F = lax.cumsum(log_f, axis=2)
    kpos = jnp.arange(S)

    def block(qb):
        q0 = qb * Q_BLOCK
        t = q0 + jnp.arange(Q_BLOCK)
        qblk = lax.dynamic_slice_in_dim(q, q0, Q_BLOCK, axis=2)
        Fq = lax.dynamic_slice_in_dim(F, q0, Q_BLOCK, axis=2)
        s = (jnp.einsum('bhtd,bhsd->bhts', qblk, k).astype(jnp.float32) * scale
             + (Fq[..., None] - F[:, :, None, :]))
        p = masked_softmax(s, kpos[None, :] <= t[:, None])
        return jnp.einsum('bhts,bhsd->bhtd', p.astype(v.dtype), v)

    out = lax.map(block, jnp.arange(S // Q_BLOCK))
    return out.transpose(1, 0, 3, 2, 4).reshape(B, S, H * HD)


def token_mixing(u, w_in, b_fgt, t5_table, cmp_pe, cmp_w1, cmp_b1, cmp_w2, w_br_nsa, w_br_fox, w_o):
    B, S, _ = u.shape
    proj = u @ w_in
    nsa_q, nsa_kv, nsa_g, fox_qkv, fox_f, merge = jnp.split(
        proj, [OFF_KV, OFF_GATE, OFF_FOX, OFF_FGT, OFF_MERGE], axis=-1)
    q = split_heads(nsa_q, NSA_HEADS).reshape(B, NSA_KV_HEADS, NSA_HPG, S, HEAD_DIM)
    kv = nsa_kv.reshape(B, S, 6, NSA_KV_HEADS, HEAD_DIM).transpose(2, 0, 3, 1, 4)
    kv_cmp = compress_kv(kv[0:2], cmp_pe, cmp_w1, cmp_b1, cmp_w2)
    kv_slc = kv[2:4].reshape(2, B, NSA_KV_HEADS, S // SLC_LEN, SLC_LEN, HEAD_DIM)
    kv_win = jnp.pad(kv[4:6], ((0, 0), (0, 0), (0, 0), (WINDOW, 0), (0, 0)))
    gates = jax.nn.sigmoid(nsa_g.reshape(B, S, NSA_KV_HEADS, NSA_HPG, 3).transpose(0, 2, 3, 1, 4))
    o_nsa = nsa_attention(q, kv_cmp[0], kv_cmp[1], kv_slc[0], kv_slc[1],
                          kv_win[0], kv_win[1], gates, t5_table)
    fq, fk, fv = jnp.split(fox_qkv, 3, axis=-1)
    log_f = jax.nn.log_sigmoid((fox_f + b_fgt).astype(jnp.float32)).transpose(0, 2, 1)
    o_fox = forgetting_attention(split_heads(fq, FOX_HEADS), split_heads(fk, FOX_HEADS),
                                 split_heads(fv, FOX_HEADS), log_f)
    g_nsa, g_fox = jnp.split(jax.nn.sigmoid(merge), 2, axis=-1)
    merged = g_nsa * (o_nsa @ w_br_nsa) + g_fox * (o_fox @ w_br_fox)
    return merged @ w_o


def hierarchical_moe(h, w_rg, b_rg, w_re, b_re, w_gate, w_up, w_down):
    B, S, D = h.shape
    T = B * S
    x = h.reshape(T, D)
    p_grp = jax.nn.softmax((x @ w_rg + b_rg).astype(jnp.float32), axis=-1)
    grp = jnp.argmax(p_grp, axis=-1)
    p_grp_sel = jnp.max(p_grp, axis=-1)
    e_logits = (jnp.einsum('td,dge->tge', x, w_re) + b_re)[jnp.arange(T), grp]
    p_top, e_top = lax.top_k(jax.nn.softmax(e_logits.astype(jnp.float32), axis=-1), TOP_K_EXPERTS)
    w_tok = p_grp_sel[:, None] * p_top / p_top.sum(-1, keepdims=True)
    eid = (grp[:, None] * EXPERTS_PER_GROUP + e_top).reshape(-1)
    tok = jnp.repeat(jnp.arange(T), TOP_K_EXPERTS)
    wts = w_tok.reshape(-1)
    n_rows = T * TOP_K_EXPERTS + N_EXPERTS * ROW_BLOCK
    n_blocks = n_rows // ROW_BLOCK
    order = jnp.argsort(eid)
    e_sorted = eid[order]
    counts = jnp.bincount(eid, length=N_EXPERTS)
    padded = (counts + ROW_BLOCK - 1) // ROW_BLOCK * ROW_BLOCK
    pad_end = jnp.cumsum(padded)
    pad_start = pad_end - padded
    start = jnp.cumsum(counts) - counts
    dest = pad_start[e_sorted] + jnp.arange(eid.shape[0]) - start[e_sorted]
    row_tok = jnp.zeros((n_rows,), jnp.int32).at[dest].set(tok[order])
    row_w = jnp.zeros((n_rows,), x.dtype).at[dest].set(wts[order].astype(x.dtype))
    blk_exp = jnp.minimum(jnp.searchsorted(pad_end, jnp.arange(n_blocks) * ROW_BLOCK, side='right'),
                          N_EXPERTS - 1)
    xs = x[row_tok].reshape(n_blocks, ROW_BLOCK, D)

    def expert_block(args):
        xb, e = args
        return (jax.nn.silu(xb @ w_gate[e]) * (xb @ w_up[e])) @ w_down[e]

    ys = lax.map(expert_block, (xs, blk_exp)).reshape(n_rows, D)
    y = jax.ops.segment_sum(ys * row_w[:, None], row_tok, num_segments=T)
    return y.reshape(B, S, D)


def setup_inputs(seed: int = 0) -> dict:
    key = jax.random.key(seed)
    ks = jax.random.split(key, 26)
    L = DEPTH

    def nrm(k, shape, s):
        return jax.random.normal(k, shape, jnp.float32) * s

    return {
        "x": nrm(ks[0], (BATCH, SEQ, D_MODEL), 1.0),
        "c": nrm(ks[1], (BATCH, D_MODEL), 1.0),
        "w_ada": nrm(ks[2], (L, D_MODEL, 6 * D_MODEL), 0.1 * D_MODEL ** -0.5),
        "b_ada": nrm(ks[3], (L, 6 * D_MODEL), 0.01),
        "w_in": nrm(ks[4], (L, D_MODEL, IN_COLS), D_MODEL ** -0.5),
        "b_fgt": jnp.linspace(1.0, 5.0, FOX_HEADS, dtype=jnp.float32)[None, :] + nrm(ks[5], (L, FOX_HEADS), 0.1),
        "t5_table": nrm(ks[6], (T5_BUCKETS, NSA_HEADS), 0.5),
        "cmp_pe": nrm(ks[7], (L, 2, CMP_LEN, HEAD_DIM), 0.02),
        "cmp_w1": nrm(ks[8], (L, 2, CMP_LEN * HEAD_DIM, CMP_HID), (CMP_LEN * HEAD_DIM) ** -0.5),
        "cmp_b1": nrm(ks[9], (L, 2, CMP_HID), 0.01),
        "cmp_w2": nrm(ks[10], (L, 2, CMP_HID, HEAD_DIM), CMP_HID ** -0.5),
        "w_br_nsa": nrm(ks[11], (L, MIX_W, D_MODEL), MIX_W ** -0.5),
        "w_br_fox": nrm(ks[12], (L, MIX_W, D_MODEL), MIX_W ** -0.5),
        "w_o": nrm(ks[13], (L, D_MODEL, D_MODEL), DEEPNORM_BETA * D_MODEL ** -0.5),
        "ln1_g": 1.0 + nrm(ks[14], (L, D_MODEL), 0.02),
        "ln1_b": nrm(ks[15], (L, D_MODEL), 0.01),
        "w_rg": nrm(ks[16], (L, D_MODEL, N_GROUPS), D_MODEL ** -0.5),
        "b_rg": nrm(ks[17], (L, N_GROUPS), 0.01),
        "w_re": nrm(ks[18], (L, D_MODEL, N_GROUPS, EXPERTS_PER_GROUP), D_MODEL ** -0.5),
        "b_re": nrm(ks[19], (L, N_GROUPS, EXPERTS_PER_GROUP), 0.01),
        "w_gate": nrm(ks[20], (L, N_EXPERTS, D_MODEL, D_EXPERT), D_MODEL ** -0.5),
        "w_up": nrm(ks[21], (L, N_EXPERTS, D_MODEL, D_EXPERT), D_MODEL ** -0.5),
        "w_down": nrm(ks[22], (L, N_EXPERTS, D_EXPERT, D_MODEL), DEEPNORM_BETA * D_EXPERT ** -0.5),
        "ln2_g": 1.0 + nrm(ks[23], (L, D_MODEL), 0.02),
        "ln2_b": nrm(ks[24], (L, D_MODEL), 0.01),
    }


def reference(x, c, w_ada, b_ada, w_in, b_fgt, t5_table, cmp_pe, cmp_w1, cmp_b1, cmp_w2,
              w_br_nsa, w_br_fox, w_o, ln1_g, ln1_b, w_rg, b_rg, w_re, b_re,
              w_gate, w_up, w_down, ln2_g, ln2_b):
    c_act = jax.nn.silu(c)
    for l in range(DEPTH):
        mod = (c_act @ w_ada[l] + b_ada[l])[:, None, :]
        sh1, sc1, g1, sh2, sc2, g2 = jnp.split(mod, 6, axis=-1)
        u = layer_norm(x) * (1.0 + sc1) + sh1
        y = token_mixing(u, w_in[l], b_fgt[l], t5_table, cmp_pe[l], cmp_w1[l], cmp_b1[l], cmp_w2[l],
                         w_br_nsa[l], w_br_fox[l], w_o[l])
        x = layer_norm(DEEPNORM_ALPHA * x + (1.0 + g1) * y, ln1_g[l], ln1_b[l])
        u = layer_norm(x) * (1.0 + sc2) + sh2
        y = hierarchical_moe(u, w_rg[l], b_rg[l], w_re[l], b_re[l], w_gate[l], w_up[l], w_down[l])
        x = layer_norm(DEEPNORM_ALPHA * x + (1.0 + g2) * y, ln2_g[l], ln2_b[l])
    return x
```

```cpp
#include <hip/hip_runtime.h>
#include <cstdint>
#include <cstdio>

#ifndef N_LAUNCH_SPLIT
#define N_LAUNCH_SPLIT 0
#endif

#ifndef PHREP
#define PHREP 0
#endif
#ifndef WCO
#define WCO 1
#endif
#ifndef BMSREP
#define BMSREP 0
#endif
#ifndef NSAP
#define NSAP 0
#endif
#ifndef BMS
#define BMS 1
#endif
#define REPS(k) (1 + ((PHREP >> (k)) & 1))
#define DI __device__ __forceinline__
#define LAS __attribute__((address_space(3)))
#define GAS __attribute__((address_space(1)))

typedef unsigned short bf16_t;
typedef short bf16x8 __attribute__((ext_vector_type(8)));
typedef float f32x4 __attribute__((ext_vector_type(4)));
typedef float f32x2 __attribute__((ext_vector_type(2)));
typedef float f32x16 __attribute__((ext_vector_type(16)));
typedef unsigned u32x4 __attribute__((ext_vector_type(4)));
typedef unsigned u32x2 __attribute__((ext_vector_type(2)));

constexpr int S = 16384, D = 2048, HD = 64;
constexpr int IN_COLS = 6944, OFF_GATE = 1280, OFF_FGT = 2840;
constexpr int NIN = 7168;
constexpr int NCMP = 1023, NCMP_P = 1024;
constexpr int NEXP = 64, DEXP = 512;
constexpr int MAXROWS = 2 * S + NEXP * 256;
constexpr int MAXPAN = MAXROWS / 256;
constexpr float LN_EPS = 1e-5f;
constexpr float LOG2E = 1.4426950408889634f;
constexpr float C2 = 0.125f * LOG2E;
constexpr float ALPHA = 1.189207115002721f;
constexpr int CKROWS = S + 64;
constexpr int NWAVES = 8, NTHREADS = 512;

constexpr size_t MiB = 1u << 20;
constexpr size_t al(size_t x) { return (x + 4095) & ~(size_t)4095; }
constexpr size_t WS_CTL = 0, CTL_BYTES = 1 * MiB;
constexpr size_t WS_MODP = WS_CTL + CTL_BYTES;
constexpr size_t WS_MOD = WS_MODP + al(32 * 12288 * 4);
constexpr size_t WS_PEWP = WS_MOD + al(12288 * 4);
constexpr size_t WS_BIASC = WS_PEWP + al(2 * 32 * 256 * 4);
constexpr size_t WS_WINT = WS_BIASC + al(2 * 256 * 4);
constexpr size_t WS_W1T = WS_WINT + al((size_t)NIN * D * 2);
constexpr size_t WS_BRT1 = WS_W1T + al(2 * 256 * 2048 * 2);
constexpr size_t WS_BRT2 = WS_BRT1 + al(2048 * 512 * 2);
constexpr size_t WS_WOT = WS_BRT2 + al(2048 * 512 * 2);
constexpr size_t WS_WGUT = WS_WOT + al((size_t)D * D * 2);
constexpr size_t WS_WDT = WS_WGUT + al((size_t)NEXP * 1024 * D * 2);
constexpr size_t WS_U = WS_WDT + al((size_t)NEXP * D * DEXP * 2);
constexpr size_t WS_QN = WS_U + al((size_t)S * D * 2);
constexpr size_t WS_CKV = WS_QN + al((size_t)8 * S * 64 * 2);
constexpr size_t WS_SK = WS_CKV + al((size_t)4 * CKROWS * 64 * 2);
constexpr size_t WS_SVT = WS_SK + al((size_t)2 * S * 64 * 2);
constexpr size_t WS_WK = WS_SVT + al((size_t)2 * S * 64 * 2);
constexpr size_t WS_WVT = WS_WK + al((size_t)2 * S * 64 * 2);
constexpr size_t WS_FQ = WS_WVT + al((size_t)2 * S * 64 * 2);
constexpr size_t WS_FK = WS_FQ + al((size_t)8 * S * 64 * 2);
constexpr size_t WS_FVT = WS_FK + al((size_t)8 * S * 64 * 2);
constexpr size_t WS_GM = WS_FVT + al((size_t)8 * S * 64 * 2);
constexpr size_t WS_GN = WS_GM + al((size_t)S * 4096 * 2);
constexpr size_t WS_LOGF = WS_GN + al((size_t)S * 24 * 4);
constexpr size_t WS_FC = WS_LOGF + al((size_t)S * 8 * 4);
constexpr size_t WS_HC = WS_FC + al((size_t)S * 8 * 4);
constexpr size_t WS_KC = WS_HC + al((size_t)4 * 4 * 1024 * 256 * 4);
constexpr size_t WS_VCT = WS_KC + al((size_t)2 * 1024 * 64 * 2);
constexpr size_t WS_O = WS_VCT + al((size_t)2 * 1024 * 64 * 2);
constexpr size_t WS_MG = WS_O + al((size_t)S * 1024 * 2);
constexpr size_t WS_X1 = WS_MG + al((size_t)S * D * 2);
constexpr size_t WS_TOKE = WS_X1 + al((size_t)S * D * 4);
constexpr size_t WS_TOKP = WS_TOKE + al((size_t)S * 2 * 4);
constexpr size_t WS_TOKW = WS_TOKP + al((size_t)S * 2 * 4);
constexpr size_t WS_ROWTOK = WS_TOKW + al((size_t)S * 2 * 4);
constexpr size_t WS_ROWDST = WS_ROWTOK + al((size_t)MAXROWS * 4);
constexpr size_t WS_ROWW = WS_ROWDST + al((size_t)MAXROWS * 4);
constexpr size_t WS_PANE = WS_ROWW + al((size_t)MAXROWS * 4);
constexpr size_t WS_KMAX = WS_PANE + al(1024 * 4);
constexpr size_t WS_HIST = WS_KMAX + al(256 * 8 * 4);
constexpr size_t WS_WRT = WS_HIST + al(256 * 64 * 4);
constexpr size_t WS_SELMG = WS_WRT + al(2 * 80 * 2048 * 2);
constexpr size_t WS_HISTB = WS_SELMG + al((size_t)S * 2 * 8 * 4);
constexpr int BMS_MAXU = 4352;
constexpr size_t WS_TOKL = WS_HISTB + al(2 * 256 * 256 * 4);
constexpr size_t WS_UT = WS_TOKL + al((size_t)2 * BMS_MAXU * 64 * 4);
constexpr size_t WS_END = WS_UT + al(2 * (BMS_MAXU + 8) * 4);
constexpr size_t WS_PML = WS_MG;
constexpr size_t WS_U2L = WS_MG;
constexpr size_t WS_H = WS_QN;
constexpr size_t WS_Y2 = WS_GM;
static_assert(WS_H + (size_t)MAXROWS * DEXP * 2 <= WS_FK, "H overlay");
static_assert(WS_Y2 + (size_t)2 * S * D * 2 <= WS_GN, "Y2 overlay");
static_assert(WS_END <= (size_t)1000 * MiB, "workspace budget");

constexpr int CW_BAR = 4096;
constexpr int CW_CNT = 16384;
constexpr int CW_QATT = 16384 + 256;
constexpr int CW_KMAX = 16384 + 512;

constexpr int LDS_BYTES = 147456;
constexpr int LDS_MISC = 144 * 1024 - 256;

typedef __bf16 bf16x2_t __attribute__((ext_vector_type(2)));
DI unsigned cvtpk(float lo, float hi) { f32x2 v = {lo, hi}; bf16x2_t b = __builtin_convertvector(v, bf16x2_t); return __builtin_bit_cast(unsigned, b); }
DI unsigned f2bf(float f) { unsigned u = __builtin_bit_cast(unsigned, f); return (u + 0x7fffu + ((u >> 16) & 1u)) >> 16; }
DI unsigned pk2(float lo, float hi) { return f2bf(lo) | (f2bf(hi) << 16); }
DI float bf2f(bf16_t b) { return __builtin_bit_cast(float, (unsigned)b << 16); }
DI float dpp_addf(float x, float y) { return x + y; }
template <int CTRL> DI float dpp_mov(float x) { return __builtin_bit_cast(float, __builtin_amdgcn_update_dpp(0, __builtin_bit_cast(int, x), CTRL, 0xF, 0xF, true)); }
DI float wave_sum(float v) {
    v += dpp_mov<0xB1>(v); v += dpp_mov<0x4E>(v); v += dpp_mov<0x124>(v); v += dpp_mov<0x128>(v);
    const float a = __int_as_float(__builtin_amdgcn_readlane(__float_as_int(v), 0)), b = __int_as_float(__builtin_amdgcn_readlane(__float_as_int(v), 16));
    const float c = __int_as_float(__builtin_amdgcn_readlane(__float_as_int(v), 32)), d = __int_as_float(__builtin_amdgcn_readlane(__float_as_int(v), 48));
    return (a + b) + (c + d);
}
DI float fexp2(float x) { return __builtin_amdgcn_exp2f(x); }
DI float sigmoidf_(float x) { return __builtin_amdgcn_rcpf(1.f + __builtin_amdgcn_exp2f(-1.4426950408889634f * x)); }
DI float logsigmoidf_(float x) { return fminf(x, 0.f) - log1pf(__expf(-fabsf(x))); }

#define XB_TMO      128
#define XB_XCNT(j)  (256  + 64 * (j))
#define XB_XSUB(j)  (1280 + 64 * (j))
#define XB_XGEN(j)  (2304 + 64 * (j))
#define XB_TOP      3328
#define XB_TOPGEN   3392
#define XCD_BAR_WORDS 3456
#define XB_SPIN_CAP (1u << 20)
DI unsigned xb_ld(unsigned* p)              { return __hip_atomic_load(p, __ATOMIC_RELAXED, __HIP_MEMORY_SCOPE_AGENT); }
DI unsigned xb_add(unsigned* p, unsigned v) { return __hip_atomic_fetch_add(p, v, __ATOMIC_RELAXED, __HIP_MEMORY_SCOPE_AGENT); }
DI unsigned xb_xcc_id() { return (unsigned)__builtin_amdgcn_s_getreg((3 << 11) | 20) & 0xFu; }
#define XB_SPIN(cond, bar) do { unsigned _sp = 0; while (cond) { __builtin_amdgcn_s_sleep(1); \
    if ((++_sp & 255u) == 0u) { if (xb_ld(&(bar)[XB_TMO])) break; if (_sp > XB_SPIN_CAP) { atomicAdd(&(bar)[XB_TMO], 1u); break; } } } } while (0)
struct XcdBarrier { unsigned* bar; unsigned x; volatile LAS unsigned* st; };
DI XcdBarrier xcd_barrier_post(unsigned* bar, volatile LAS unsigned* st) {
    XcdBarrier b; b.bar = bar; b.x = xb_xcc_id(); b.st = st;
    if (threadIdx.x == 0) (void)xb_add(&bar[XB_XCNT(b.x)], 1u);
    return b;
}
DI void xcd_barrier_complete(unsigned* bar, unsigned x, unsigned& nloc, unsigned& nx) {
    const unsigned G = gridDim.x * gridDim.y * gridDim.z;
    unsigned sum, cnt, mine, sp = 0u;
    for (;;) {
        sum = 0u; cnt = 0u; mine = 0u;
#pragma unroll
        for (unsigned j = 0; j < 16; ++j) { const unsigned c = xb_ld(&bar[XB_XCNT(j)]); sum += c; cnt += (c > 0u) ? 1u : 0u; mine = (j == x) ? c : mine; }
        if (sum == G) break;
        __builtin_amdgcn_s_sleep(1);
        if ((++sp & 255u) == 0u) { if (xb_ld(&bar[XB_TMO])) break; if (sp > XB_SPIN_CAP) { atomicAdd(&bar[XB_TMO], 1u); break; } }
    }
    nloc = mine > 0u ? mine : 1u; nx = cnt > 0u ? cnt : 1u;
}
DI void xcd_barrier(const XcdBarrier& b) {
    asm volatile("s_waitcnt vmcnt(0)" ::: "memory");
    __syncthreads();
    if (threadIdx.x == 0) {
        unsigned* bar = b.bar;
        __builtin_amdgcn_s_waitcnt(0);
        unsigned nloc = b.st[0], nx = b.st[1];
        if (nloc == 0u) { xcd_barrier_complete(bar, b.x, nloc, nx); b.st[0] = nloc; b.st[1] = nx; }
        const unsigned old = xb_add(&bar[XB_XSUB(b.x)], 1u);
        const unsigned gen = old / nloc;
        if (old + 1u == (gen + 1u) * nloc) {
            __builtin_amdgcn_fence(__ATOMIC_RELEASE, "agent");
            asm volatile("s_waitcnt vmcnt(0)" ::: "memory");
            const unsigned og = xb_add(&bar[XB_TOP], 1u);
            const unsigned tg = og / nx;
            if (og + 1u == (tg + 1u) * nx) xb_add(&bar[XB_TOPGEN], 1u);
            else XB_SPIN(xb_ld(&bar[XB_TOPGEN]) == tg, bar);
            __builtin_amdgcn_fence(__ATOMIC_ACQUIRE, "agent");
            xb_add(&bar[XB_XGEN(b.x)], 1u);
            asm volatile("s_waitcnt vmcnt(0)" ::: "memory");
        } else {
            XB_SPIN(xb_ld(&bar[XB_XGEN(b.x)]) == gen, bar);
            __builtin_amdgcn_fence(__ATOMIC_ACQUIRE, "agent");
            asm volatile("s_waitcnt vmcnt(0)" ::: "memory");
        }
    }
    __syncthreads();
}

namespace pg8 {
constexpr int BM = 256, BK = 64, HALF = 128, HTB = HALF * BK * 2, STAGE_BYTES = 8 * HTB, NXCD = 8, WGM = 8;
__host__ __device__ __forceinline__ int lds_byte(int r, int c) { const int st = (r >> 4) * 2 + (c >> 5), rr = r & 15, cc = c & 31, ob = rr * 64 + cc * 2; return st * 1024 + (ob ^ (((ob >> 9) & 1) << 5)); }
__host__ __device__ __forceinline__ void stage_rc(int b, int& R, int& C) { const int st = b / 1024, sb = b % 1024, swz = sb ^ (((sb >> 9) & 1) << 5); R = (st >> 1) * 16 + swz / 64; C = (st & 1) * 32 + (swz % 64) / 2; }
__host__ __device__ __forceinline__ int perm32(int rho) { const int n = rho >> 4, i = rho & 15; return 8 * (i >> 2) + 4 * n + (i & 3); }

struct Unit { int pm, pn, aux; size_t aoff, boff; };
struct Gemm { const bf16_t* A; const bf16_t* Bt; int lda, ldb, K; const int* rowtok; };

struct SchedGrid {
    int nM, nN, nwg, G, c; size_t ta, tb;
    DI void init(int M, int N, int lda, int ldb, int G_, int c_) { nM = M / BM; nN = N / BM; nwg = nM * nN; G = G_; c = c_; ta = (size_t)BM * lda * 2; tb = (size_t)BM * ldb * 2; }
    DI bool next(int i, Unit& u) const {
        const long L = (long)i * G + c; if (L >= nwg) return false;
        int wgid = (int)L; { const int q = nwg / NXCD, r = nwg % NXCD, xcd = wgid % NXCD, off = wgid / NXCD; wgid = (xcd < r ? xcd * (q + 1) : r * (q + 1) + (xcd - r) * q) + off; }
        const int nig = WGM * nN, gid = wgid / nig, fm = gid * WGM, gsz = (nM - fm) < WGM ? (nM - fm) : WGM;
        u.pm = fm + ((wgid % nig) % gsz); u.pn = (wgid % nig) / gsz; u.aux = 0; u.aoff = (size_t)u.pm * ta; u.boff = (size_t)u.pn * tb; return true;
    }
};

template <class Sched> struct SchedRange { const Sched& s; int i0, i1; DI bool next(int i, Unit& u) const { return (i0 + i < i1) && s.next(i0 + i, u); } };

DI unsigned cvt_pk_bf16(float lo, float hi) { return cvtpk(lo, hi); }

template <class Epi, class Sched, bool GATHER>
DI void gemm_phase(LAS unsigned char* lds, const Gemm g, const Sched& S, const Epi& E) {
    const int tid = threadIdx.x, wid = __builtin_amdgcn_readfirstlane(tid >> 6), lane = tid & 63, wr = wid >> 2, wc = wid & 3, fr = lane & 15, fq = lane >> 4;
    const int K = g.K, nt = K / BK;
    int Rr[2], Cc[2];
    unsigned voffA[2][2], voffB[2], nvoffA[2][2];
#pragma unroll
    for (int i = 0; i < 2; ++i) { int R, C; stage_rc(tid * 16 + i * 8192, R, C); const int Rb = Epi::PERM ? ((R & ~31) + perm32(R & 31)) : R; Rr[i] = R; Cc[i] = C;
        voffA[0][i] = (unsigned)(R * g.lda + C) * 2u; voffA[1][i] = (unsigned)((R + HALF) * g.lda + C) * 2u; voffB[i] = (unsigned)(Rb * g.ldb + C) * 2u;
        nvoffA[0][i] = voffA[0][i]; nvoffA[1][i] = voffA[1][i]; }
    const size_t kstep = (size_t)(BK * 2);
    const size_t hstepB = (size_t)HALF * g.ldb * 2;
    const unsigned ldsw = (unsigned)wid * 1024u;
    const int aoff = lds_byte(wr * 64 + fr, fq * 8), boff = lds_byte(wc * 32 + fr, fq * 8);
#define PG8_SA(b, h) (((b) * 2 + (h)) * HTB)
#define PG8_SB(b, h) ((4 + (b) * 2 + (h)) * HTB)
#define PG8_STAGE(bufoff, gbase, voff) do { _Pragma("unroll") for (int _i = 0; _i < 2; ++_i) \
        __builtin_amdgcn_global_load_lds((const unsigned*)((const char*)(gbase) + (voff)[_i]), (LAS unsigned*)(lds + (bufoff) + ldsw + _i * 8192), 16, 0, 0); } while (0)
#define PG8_LDA(dst, b, h) do { _Pragma("unroll") for (int m = 0; m < 4; ++m) _Pragma("unroll") for (int k = 0; k < 2; ++k) dst[m][k] = *(const LAS bf16x8*)(lds + PG8_SA(b, h) + aoff + m * 2048 + k * 1024); } while (0)
#define PG8_LDB(dst, b, h) do { _Pragma("unroll") for (int n = 0; n < 2; ++n) _Pragma("unroll") for (int k = 0; k < 2; ++k) dst[n][k] = *(const LAS bf16x8*)(lds + PG8_SB(b, h) + boff + n * 2048 + k * 1024); } while (0)
#define PG8_MMA(ai, bj, At, Bt) do { __builtin_amdgcn_s_setprio(1); _Pragma("unroll") for (int m = 0; m < 4; ++m) _Pragma("unroll") for (int n = 0; n < 2; ++n) _Pragma("unroll") for (int k = 0; k < 2; ++k) \
        acc[ai][bj][m][n] = __builtin_amdgcn_mfma_f32_16x16x32_bf16(Bt[n][k], At[m][k], acc[ai][bj][m][n], 0, 0, 0); __builtin_amdgcn_s_setprio(0); } while (0)
#define PG8_WAIT_V(n) asm volatile("s_waitcnt vmcnt(" #n ")" ::: "memory")
#define PG8_WAIT_L(n) asm volatile("s_waitcnt lgkmcnt(" #n ")" ::: "memory")
#define PG8_BAR __builtin_amdgcn_s_barrier()
#define PG8_SCHED __builtin_amdgcn_sched_barrier(0)
#define PG8_GATHER(dst, u) do { if constexpr (GATHER) { _Pragma("unroll") for (int _h = 0; _h < 2; ++_h) _Pragma("unroll") for (int _i = 0; _i < 2; ++_i) { \
        int _t = g.rowtok[(u).pm * BM + _h * HALF + Rr[_i]]; _t = _t < 0 ? 0 : _t; dst[_h][_i] = (unsigned)(_t * g.lda + Cc[_i]) * 2u; } } } while (0)
    Unit cur, nxt; int ui = 0;
    if (!S.next(0, cur)) return;
    f32x4 acc[2][2][4][2];
#pragma unroll
    for (int a = 0; a < 2; ++a)
#pragma unroll
        for (int b = 0; b < 2; ++b)
#pragma unroll
            for (int m = 0; m < 4; ++m)
#pragma unroll
                for (int n = 0; n < 2; ++n) acc[a][b][m][n] = (f32x4){0.f, 0.f, 0.f, 0.f};
    bf16x8 At[4][2], B0[2][2], B1[2][2];
    const char* cA = (const char*)g.A + cur.aoff; const char* cB = (const char*)g.Bt + cur.boff;
    PG8_GATHER(voffA, cur);
    PG8_STAGE(PG8_SB(0, 0), cB, voffB); PG8_STAGE(PG8_SB(0, 1), cB + hstepB, voffB); PG8_STAGE(PG8_SA(0, 0), cA, voffA[0]); PG8_STAGE(PG8_SA(0, 1), cA, voffA[1]);
    if (wr == 1) PG8_BAR;
    PG8_WAIT_V(2); PG8_BAR;
    PG8_STAGE(PG8_SB(1, 0), cB + kstep, voffB); PG8_STAGE(PG8_SA(1, 0), cA + kstep, voffA[0]); PG8_STAGE(PG8_SB(1, 1), cB + hstepB + kstep, voffB);
    PG8_WAIT_V(6); PG8_BAR;
    for (;;) {
        const bool has_next = S.next(ui + 1, nxt);
        const char* nA = has_next ? (const char*)g.A + nxt.aoff : cA; const char* nB = has_next ? (const char*)g.Bt + nxt.boff : cB;
        if constexpr (GATHER) { if (has_next) { PG8_GATHER(nvoffA, nxt); } else { _Pragma("unroll") for (int h = 0; h < 2; ++h) _Pragma("unroll") for (int i = 0; i < 2; ++i) nvoffA[h][i] = voffA[h][i]; } }
        for (int t = 0; t < nt; t += 2) {
            const bool last = (t == nt - 2);
            const char* a1 = cA + (size_t)(t + 1) * kstep;
            const char* a2 = last ? nA : cA + (size_t)(t + 2) * kstep; const char* b2 = last ? nB : cB + (size_t)(t + 2) * kstep;
            const char* a3 = a2 + kstep; const char* b3 = b2 + kstep;
            unsigned va2[2][2];
#pragma unroll
            for (int h = 0; h < 2; ++h)
#pragma unroll
                for (int i = 0; i < 2; ++i) va2[h][i] = (GATHER && last) ? nvoffA[h][i] : voffA[h][i];
            PG8_LDB(B0, 0, 0); PG8_LDB(B1, 0, 1); PG8_SCHED; PG8_LDA(At, 0, 0); PG8_STAGE(PG8_SA(1, 1), a1, voffA[1]);
            PG8_WAIT_V(8); PG8_WAIT_L(0); PG8_BAR; PG8_MMA(0, 0, At, B0); PG8_MMA(0, 1, At, B1); PG8_BAR; PG8_SCHED;
            PG8_LDA(At, 0, 1); PG8_STAGE(PG8_SB(0, 0), b2, voffB); PG8_STAGE(PG8_SB(0, 1), b2 + hstepB, voffB); PG8_STAGE(PG8_SA(0, 0), a2, va2[0]);
            PG8_WAIT_V(8); PG8_WAIT_L(0); PG8_BAR; PG8_MMA(1, 0, At, B0); PG8_MMA(1, 1, At, B1); PG8_BAR; PG8_SCHED;
            PG8_LDB(B0, 1, 0); PG8_LDB(B1, 1, 1); PG8_SCHED; PG8_LDA(At, 1, 0); PG8_STAGE(PG8_SA(0, 1), a2, va2[1]);
            PG8_WAIT_V(8); PG8_WAIT_L(0); PG8_BAR; PG8_MMA(0, 0, At, B0); PG8_MMA(0, 1, At, B1); PG8_BAR; PG8_SCHED;
            PG8_LDA(At, 1, 1); PG8_STAGE(PG8_SB(1, 0), b3, voffB); PG8_STAGE(PG8_SB(1, 1), b3 + hstepB, voffB); PG8_STAGE(PG8_SA(1, 0), a3, va2[0]);
            PG8_WAIT_V(8); PG8_WAIT_L(0); PG8_BAR; PG8_MMA(1, 0, At, B0); PG8_MMA(1, 1, At, B1); PG8_BAR; PG8_SCHED;
        }
        if (wr == 0) PG8_BAR;
        E(acc, cur, wr, wc, fr, fq);
        if (!has_next) break;
#pragma unroll
        for (int a = 0; a < 2; ++a)
#pragma unroll
            for (int b = 0; b < 2; ++b)
#pragma unroll
                for (int m = 0; m < 4; ++m)
#pragma unroll
                    for (int n = 0; n < 2; ++n) acc[a][b][m][n] = (f32x4){0.f, 0.f, 0.f, 0.f};
        cur = nxt; cA = nA; cB = nB; ++ui;
        if constexpr (GATHER) { _Pragma("unroll") for (int h = 0; h < 2; ++h) _Pragma("unroll") for (int i = 0; i < 2; ++i) voffA[h][i] = nvoffA[h][i]; }
        if (wr == 1) PG8_BAR;
    }
    PG8_WAIT_V(0);
    PG8_BAR;
#undef PG8_SA
#undef PG8_SB
#undef PG8_STAGE
#undef PG8_LDA
#undef PG8_LDB
#undef PG8_MMA
#undef PG8_WAIT_V
#undef PG8_WAIT_L
#undef PG8_BAR
#undef PG8_SCHED
#undef PG8_GATHER
}
}

struct Params {
    const float* in[25];
    float* out;
    unsigned char* ws;
    int ph_lo, ph_hi;
};
struct Frame {
    LAS unsigned char* lds;
    unsigned* ctl;
    int tid, lane, wave, G, bid;
    unsigned char* ws;
};
#define WSP(T, off) ((T*)(F.ws + (off)))

using pg8::Unit; using pg8::BM; using pg8::HALF; using pg8::cvt_pk_bf16;

struct EpiIn {
    static constexpr bool PERM = true;
    unsigned char* ws; const float* b_fgt;
    DI bf16_t* dest(int cg, bool& trans, float& sc) const {
        trans = false; sc = 1.f;
        if (cg < 8)  { sc = C2; return (bf16_t*)(ws + WS_QN) + (size_t)cg * S * 64; }
        if (cg < 12) { return (bf16_t*)(ws + WS_CKV) + (size_t)(cg - 8) * CKROWS * 64; }
        if (cg < 14) { return (bf16_t*)(ws + WS_SK) + (size_t)(cg - 12) * S * 64; }
        if (cg < 16) { trans = true; return (bf16_t*)(ws + WS_SVT) + (size_t)(cg - 14) * 64 * S; }
        if (cg < 18) { return (bf16_t*)(ws + WS_WK) + (size_t)(cg - 16) * S * 64; }
        if (cg < 20) { trans = true; return (bf16_t*)(ws + WS_WVT) + (size_t)(cg - 18) * 64 * S; }
        if (cg < 28) { sc = C2; return (bf16_t*)(ws + WS_FQ) + (size_t)(cg - 20) * S * 64; }
        if (cg < 36) { return (bf16_t*)(ws + WS_FK) + (size_t)(cg - 28) * S * 64; }
        trans = true; return (bf16_t*)(ws + WS_FVT) + (size_t)(cg - 36) * 64 * S;
    }
    DI void operator()(const f32x4 (&acc)[2][2][4][2], const Unit& u, int wr, int wc, int fr, int fq) const {
        asm volatile("" : "+v"(fr), "+v"(fq)); asm volatile("" : "+s"(wr), "+s"(wc));
        const int row0 = u.pm * BM + wr * 64 + fr;
        if (u.pn <= 10) {
#pragma unroll
            for (int bj = 0; bj < 2; ++bj) {
                const int cb = 128 * bj + 32 * wc, cg = u.pn * 4 + (cb >> 6), d0 = (cb & 63) + 8 * fq;
                bool trans; float sc; bf16_t* base = dest(cg, trans, sc);
#pragma unroll
                for (int ai = 0; ai < 2; ++ai)
#pragma unroll
                    for (int m = 0; m < 4; ++m) {
                        const int t = row0 + ai * HALF + m * 16;
                        const f32x4 v0 = acc[ai][bj][m][0] * sc, v1 = acc[ai][bj][m][1] * sc;
                        if (!trans) { u32x4 w; w.x = cvt_pk_bf16(v0[0], v0[1]); w.y = cvt_pk_bf16(v0[2], v0[3]); w.z = cvt_pk_bf16(v1[0], v1[1]); w.w = cvt_pk_bf16(v1[2], v1[3]);
                            *(u32x4*)(base + (size_t)t * 64 + d0) = w; }
                        else {
#pragma unroll
                            for (int j = 0; j < 4; ++j) { base[((size_t)(t >> 5) * 64 + d0 + j) * 32 + (t & 31)] = (bf16_t)f2bf(v0[j]); base[((size_t)(t >> 5) * 64 + d0 + 4 + j) * 32 + (t & 31)] = (bf16_t)f2bf(v1[j]); }
                        }
                    }
            }
        } else if (u.pn <= 26) {
            bf16_t* gm = (bf16_t*)(ws + WS_GM);
#pragma unroll
            for (int bj = 0; bj < 2; ++bj) {
                const int col = (u.pn - 11) * 256 + 128 * bj + 32 * wc + 8 * fq;
#pragma unroll
                for (int ai = 0; ai < 2; ++ai)
#pragma unroll
                    for (int m = 0; m < 4; ++m) {
                        const int t = row0 + ai * HALF + m * 16;
                        const f32x4 v0 = acc[ai][bj][m][0], v1 = acc[ai][bj][m][1];
                        u32x4 w; w.x = cvt_pk_bf16(sigmoidf_(v0[0]), sigmoidf_(v0[1])); w.y = cvt_pk_bf16(sigmoidf_(v0[2]), sigmoidf_(v0[3]));
                        w.z = cvt_pk_bf16(sigmoidf_(v1[0]), sigmoidf_(v1[1])); w.w = cvt_pk_bf16(sigmoidf_(v1[2]), sigmoidf_(v1[3]));
                        *(u32x4*)(gm + (size_t)t * 4096 + col) = w;
                    }
            }
        } else {
            if (wc == 0) {
                float* gn = (float*)(ws + WS_GN); float* lf = (float*)(ws + WS_LOGF);
#pragma unroll
                for (int ai = 0; ai < 2; ++ai)
#pragma unroll
                    for (int m = 0; m < 4; ++m) {
                        const int t = row0 + ai * HALF + m * 16;
#pragma unroll
                        for (int n = 0; n < 2; ++n)
#pragma unroll
                            for (int j = 0; j < 4; ++j) {
                                const int c = 8 * fq + 4 * n + j; const float v = acc[ai][0][m][n][j];
                                if (c < 24) gn[(size_t)t * 24 + c] = sigmoidf_(v);
                                else lf[(size_t)t * 8 + (c - 24)] = logsigmoidf_(v + b_fgt[c - 24]);
                            }
                    }
            }
        }
    }
};

DI float gelu_tanh(float x) { const float u = 0.7978845608028654f * (x + 0.044715f * x * x * x); return 0.5f * x * (1.f + tanhf(u)); }

struct EpiCmp {
    static constexpr bool PERM = false;
    float* hp;
    DI void operator()(const f32x4 (&acc)[2][2][4][2], const Unit& u, int wr, int wc, int fr, int fq) const {
        asm volatile("" : "+v"(fr), "+v"(fq)); asm volatile("" : "+s"(wr), "+s"(wc));
        const int row0 = u.pm * BM + wr * 64 + fr; float* base = hp + (size_t)u.aux * 1024 * 256;
#pragma unroll
        for (int bj = 0; bj < 2; ++bj)
#pragma unroll
            for (int n = 0; n < 2; ++n) { const int col = 128 * bj + 32 * wc + 16 * n + 4 * fq;
#pragma unroll
                for (int ai = 0; ai < 2; ++ai)
#pragma unroll
                    for (int m = 0; m < 4; ++m) *(f32x4*)(base + (size_t)(row0 + ai * HALF + m * 16) * 256 + col) = acc[ai][bj][m][n]; }
    }
};
struct SchedCmp {
    int G, c;
    DI bool next(int i, Unit& u) const { const int L = i * G + c; if (L >= 64) return false; const int ks = L & 3, zg = L >> 4; u.pm = (L >> 2) & 3; u.pn = 0; u.aux = ks * 4 + zg;
        u.aoff = ((size_t)zg * CKROWS * 64 + (size_t)u.pm * 256 * 1024 + ks * 512) * 2; u.boff = ((size_t)(zg >> 1) * 256 * 2048 + ks * 512) * 2; return true; }
};

template <int STEP> struct EpiMerge {
    static constexpr bool PERM = true;
    const bf16_t* gm; bf16_t* mg;
    DI void operator()(const f32x4 (&acc)[2][2][4][2], const Unit& u, int wr, int wc, int fr, int fq) const {
        asm volatile("" : "+v"(fr), "+v"(fq)); asm volatile("" : "+s"(wr), "+s"(wc));
        const int row0 = u.pm * BM + wr * 64 + fr;
#pragma unroll
        for (int bj = 0; bj < 2; ++bj) {
            const int col = u.pn * 256 + 128 * bj + 32 * wc + 8 * fq;
#pragma unroll
            for (int ai = 0; ai < 2; ++ai)
#pragma unroll
                for (int m = 0; m < 4; ++m) {
                    const int t = row0 + ai * HALF + m * 16;
                    const u32x4 gw = *(const u32x4*)(gm + (size_t)t * 4096 + (STEP - 1) * 2048 + col);
                    float gv[8], pv[8];
#pragma unroll
                    for (int j = 0; j < 4; ++j) { gv[2 * j] = __builtin_bit_cast(float, gw[j] << 16); gv[2 * j + 1] = __builtin_bit_cast(float, gw[j] & 0xffff0000u); }
                    if (STEP == 2) { const u32x4 pw = *(const u32x4*)(mg + (size_t)t * 2048 + col);
#pragma unroll
                        for (int j = 0; j < 4; ++j) { pv[2 * j] = __builtin_bit_cast(float, pw[j] << 16); pv[2 * j + 1] = __builtin_bit_cast(float, pw[j] & 0xffff0000u); } }
                    else {
#pragma unroll
                        for (int j = 0; j < 8; ++j) pv[j] = 0.f; }
                    const f32x4 v0 = acc[ai][bj][m][0], v1 = acc[ai][bj][m][1];
                    float o[8];
#pragma unroll
                    for (int j = 0; j < 4; ++j) { o[j] = pv[j] + gv[j] * v0[j]; o[4 + j] = pv[4 + j] + gv[4 + j] * v1[j]; }
                    u32x4 w; w.x = cvt_pk_bf16(o[0], o[1]); w.y = cvt_pk_bf16(o[2], o[3]); w.z = cvt_pk_bf16(o[4], o[5]); w.w = cvt_pk_bf16(o[6], o[7]);
                    *(u32x4*)(mg + (size_t)t * 2048 + col) = w;
                }
        }
    }
};

struct EpiWo {
    static constexpr bool PERM = true;
    const float* mod; bf16_t* yb;
    DI void operator()(const f32x4 (&acc)[2][2][4][2], const Unit& u, int wr, int wc, int fr, int fq) const {
        asm volatile("" : "+v"(fr), "+v"(fq)); asm volatile("" : "+s"(wr), "+s"(wc));
        const int row0 = u.pm * BM + wr * 64 + fr;
#pragma unroll
        for (int bj = 0; bj < 2; ++bj) {
            const int col = u.pn * BM + 128 * bj + 32 * wc + 8 * fq;
            const f32x4 ga = *(const f32x4*)(mod + 2 * D + col) + 1.0f, gb = *(const f32x4*)(mod + 2 * D + col + 4) + 1.0f;
#pragma unroll
            for (int ai = 0; ai < 2; ++ai)
#pragma unroll
                for (int m = 0; m < 4; ++m) {
                    const f32x4 v0 = acc[ai][bj][m][0] * ga, v1 = acc[ai][bj][m][1] * gb;
                    u32x4 w; w.x = cvt_pk_bf16(v0[0], v0[1]); w.y = cvt_pk_bf16(v0[2], v0[3]); w.z = cvt_pk_bf16(v1[0], v1[1]); w.w = cvt_pk_bf16(v1[2], v1[3]);
                    *(u32x4*)(yb + (size_t)(row0 + ai * HALF + m * 16) * D + col) = w;
                }
        }
    }
};

struct SchedMoe {
    const LAS int* pane; int npn, G, c; size_t arow_bytes, btile_bytes;
    DI bool next(int i, Unit& u) const {
        const int np = pane[0]; const int L = i * G + c; if (L >= np * npn) return false;
        const int p = L / npn, pn = L - p * npn, e = pane[1 + p];
        u.pm = p; u.pn = pn; u.aux = e; u.aoff = (size_t)p * arow_bytes; u.boff = (size_t)(e * npn + pn) * btile_bytes; return true;
    }
};
struct EpiGU {
    static constexpr bool PERM = true;
    bf16_t* h;
    DI void operator()(const f32x4 (&acc)[2][2][4][2], const Unit& u, int wr, int wc, int fr, int fq) const {
        asm volatile("" : "+v"(fr), "+v"(fq)); asm volatile("" : "+s"(wr), "+s"(wc));
        const int row0 = u.pm * BM + wr * 64 + fr; const int col = u.pn * 128 + 32 * wc + 8 * fq;
#pragma unroll
        for (int ai = 0; ai < 2; ++ai)
#pragma unroll
            for (int m = 0; m < 4; ++m) {
                const int r = row0 + ai * HALF + m * 16;
                float o[8];
#pragma unroll
                for (int n = 0; n < 2; ++n)
#pragma unroll
                    for (int j = 0; j < 4; ++j) { const float gt = acc[ai][0][m][n][j], up = acc[ai][1][m][n][j]; o[4 * n + j] = gt * sigmoidf_(gt) * up; }
                u32x4 w; w.x = cvt_pk_bf16(o[0], o[1]); w.y = cvt_pk_bf16(o[2], o[3]); w.z = cvt_pk_bf16(o[4], o[5]); w.w = cvt_pk_bf16(o[6], o[7]);
                *(u32x4*)(h + (size_t)r * DEXP + col) = w;
            }
    }
};
struct EpiDown {
    static constexpr bool PERM = true;
    const int* rowdst; const float* roww; bf16_t* y2;
    DI void operator()(const f32x4 (&acc)[2][2][4][2], const Unit& u, int wr, int wc, int fr, int fq) const {
        asm volatile("" : "+v"(fr), "+v"(fq)); asm volatile("" : "+s"(wr), "+s"(wc));
        const int row0 = u.pm * BM + wr * 64 + fr;
#pragma unroll
        for (int ai = 0; ai < 2; ++ai)
#pragma unroll
            for (int m = 0; m < 4; ++m) {
                const int r = row0 + ai * HALF + m * 16; const int dst = rowdst[r];
                if (dst >= 0) { const float w8 = roww[r];
#pragma unroll
                    for (int bj = 0; bj < 2; ++bj) { const int col = u.pn * 256 + 128 * bj + 32 * wc + 8 * fq;
                        const f32x4 v0 = acc[ai][bj][m][0] * w8, v1 = acc[ai][bj][m][1] * w8;
                        u32x4 w; w.x = cvt_pk_bf16(v0[0], v0[1]); w.y = cvt_pk_bf16(v0[2], v0[3]); w.z = cvt_pk_bf16(v1[0], v1[1]); w.w = cvt_pk_bf16(v1[2], v1[3]);
                        *(u32x4*)(y2 + (size_t)dst * D + col) = w; } }
            }
    }
};


template <int UNR = 4> DI void tr_item(const float* srcrow0, int ldsrc, int col4, bool colok, bf16_t* dst, int ldd, int nrows, LAS float* scr, int lane) {
#pragma unroll UNR
    for (int it = 0; it < 16; ++it) { const int k = it * 4 + (lane >> 4); f32x4 v = (f32x4){0.f, 0.f, 0.f, 0.f};
        if (colok) v = (UNR == 16) ? __builtin_nontemporal_load((const f32x4*)(srcrow0 + (size_t)k * ldsrc + col4)) : *(const f32x4*)(srcrow0 + (size_t)k * ldsrc + col4);
        LAS float* s = scr + k * 65 + (lane & 15) * 4; s[0] = v[0]; s[1] = v[1]; s[2] = v[2]; s[3] = v[3]; }
    asm volatile("s_waitcnt lgkmcnt(0)" ::: "memory");
    const int c = lane & 7;
#pragma unroll
    for (int it = 0; it < 8; ++it) { const int n = it * 8 + (lane >> 3); const LAS float* s = scr + (8 * c) * 65 + n;
        u32x4 o; o.x = cvtpk(s[0 * 65], s[1 * 65]); o.y = cvtpk(s[2 * 65], s[3 * 65]); o.z = cvtpk(s[4 * 65], s[5 * 65]); o.w = cvtpk(s[6 * 65], s[7 * 65]);
        if (n < nrows) { if (UNR == 16) __builtin_nontemporal_store(o, (u32x4*)(dst + (size_t)n * ldd + 8 * c)); else *(u32x4*)(dst + (size_t)n * ldd + 8 * c) = o; } }
    asm volatile("s_waitcnt lgkmcnt(0)" ::: "memory");
}

template <int PART> DI void phase_prologue(Frame& F, const Params& P) {
    LAS float* scr = (LAS float*)(F.lds + F.wave * 16640);
    const int gw = F.bid * NWAVES + F.wave, NGW = F.G * NWAVES, lane = F.lane;
    const int c4 = (lane & 15) * 4;
    constexpr int I_IN = 32 * 109, I_W1 = 2 * 32 * 4, I_BR = 8 * 32, I_WO = 32 * 32, I_G = NEXP * 32 * 8, I_D = NEXP * 8 * 32;
    constexpr int I_MOD = 48 * 32, I_PEW = 64, I_RT = 32;
    constexpr int NITEMS = I_IN + I_W1 + 2 * I_BR + I_WO + 2 * I_G + I_D + I_MOD + I_PEW + I_RT;
    constexpr int NTR = NITEMS - (I_MOD + I_PEW + I_RT);
    constexpr int I_MOE = 2 * I_G + I_D, R_MOE = I_IN + I_W1 + 2 * I_BR + I_WO;
    constexpr int NLOOP = !WCO ? NITEMS : (PART == 0 ? (I_MOD + I_PEW + I_RT) + R_MOE : I_MOE);
    for (int it = gw; it < NLOOP; it += NGW) {
        int r;
        if (!WCO) r = it < (I_MOD + I_PEW + I_RT) ? NTR + it : it - (I_MOD + I_PEW + I_RT);
        else if (PART == 1) r = R_MOE + it;
        else r = it < (I_MOD + I_PEW + I_RT) ? NTR + it : it - (I_MOD + I_PEW + I_RT);
        if (r < I_IN) {
            const int kb = r / 109, nb = r % 109, j0 = nb * 64; const float* w = P.in[4] + (size_t)(kb * 64) * IN_COLS;
            bf16_t* dst = WSP(bf16_t, WS_WINT) + (size_t)j0 * D + kb * 64;
            if (nb < 108) { const int oc = j0 < 1280 ? j0 : (j0 < 2816 ? j0 + 24 : j0 + 32); tr_item(w, IN_COLS, oc + c4, true, dst, D, 64, scr, lane); }
            else { const int oc = c4 < 24 ? OFF_GATE + c4 : OFF_FGT + (c4 - 24); tr_item(w, IN_COLS, oc, c4 < 32, dst, D, 32, scr, lane); }
            continue; } r -= I_IN;
        if (r < I_W1) { const int z = r / 128, q = r % 128, kb = q / 4, nb = q % 4;
            tr_item(P.in[8] + (size_t)z * 2048 * 256 + (size_t)(kb * 64) * 256, 256, nb * 64 + c4, true, WSP(bf16_t, WS_W1T) + ((size_t)z * 256 + nb * 64) * 2048 + kb * 64, 2048, 64, scr, lane);
            continue; } r -= I_W1;
        if (r < 2 * I_BR) { const int which = r / I_BR, q = r % I_BR, kb = q / 32, nb = q % 32;
            tr_item(P.in[11 + which] + (size_t)(kb * 64) * 2048, 2048, nb * 64 + c4, true, WSP(bf16_t, which ? WS_BRT2 : WS_BRT1) + (size_t)(nb * 64) * 512 + kb * 64, 512, 64, scr, lane);
            continue; } r -= 2 * I_BR;
        if (r < I_WO) { const int kb = r / 32, nb = r % 32;
            tr_item(P.in[13] + (size_t)(kb * 64) * 2048, 2048, nb * 64 + c4, true, WSP(bf16_t, WS_WOT) + (size_t)(nb * 64) * 2048 + kb * 64, 2048, 64, scr, lane);
            continue; } r -= I_WO;
        if (r < 2 * I_G) { const int up = r / I_G, q = r % I_G, e = q / 256, q2 = q % 256, kb = q2 / 8, nb = q2 % 8;
            const int n0 = nb * 64, drow = (n0 >> 7) * 256 + up * 128 + (n0 & 127);
            tr_item<(PART == 1 ? 16 : 4)>(P.in[20 + up] + (size_t)e * 2048 * 512 + (size_t)(kb * 64) * 512, 512, n0 + c4, true, WSP(bf16_t, WS_WGUT) + ((size_t)e * 1024 + drow) * 2048 + kb * 64, 2048, 64, scr, lane);
            continue; } r -= 2 * I_G;
        if (r < I_D) { const int e = r / 256, q2 = r % 256, kb = q2 / 32, nb = q2 % 32;
            tr_item<(PART == 1 ? 16 : 4)>(P.in[22] + (size_t)e * 512 * 2048 + (size_t)(kb * 64) * 2048, 2048, nb * 64 + c4, true, WSP(bf16_t, WS_WDT) + ((size_t)e * 2048 + nb * 64) * 512 + kb * 64, 512, 64, scr, lane);
            continue; } r -= I_D;
        if (r < I_MOD) {
            const int cc = r / 32, kc = r % 32; const float* c = P.in[1]; const float* w = P.in[2] + (size_t)(kc * 64) * 12288 + cc * 256 + lane * 4;
            f32x4 a = (f32x4){0.f, 0.f, 0.f, 0.f};
#pragma unroll 8
            for (int k = 0; k < 64; ++k) { const float cv = c[kc * 64 + k]; const float sv = cv / (1.f + __expf(-cv)); a += *(const f32x4*)(w + (size_t)k * 12288) * sv; }
            *(f32x4*)(WSP(float, WS_MODP) + (size_t)kc * 12288 + cc * 256 + lane * 4) = a;
            continue; } r -= I_MOD;
        if (r >= I_PEW) {
            const int k0 = (r - I_PEW) * 64; bf16_t* th = WSP(bf16_t, WS_WRT); bf16_t* tl = th + 80 * 2048;
#pragma unroll 4
            for (int kk = 0; kk < 64; ++kk) scr[kk * 65 + lane] = P.in[18][(size_t)(k0 + kk) * 64 + lane];
            asm volatile("s_waitcnt lgkmcnt(0)" ::: "memory");
#pragma unroll 4
            for (int n = 0; n < 64; ++n) { const float v = scr[lane * 65 + n]; const unsigned hb = f2bf(v);
                th[(size_t)(8 + n) * 2048 + k0 + lane] = (bf16_t)hb; tl[(size_t)(8 + n) * 2048 + k0 + lane] = (bf16_t)f2bf(v - __builtin_bit_cast(float, hb << 16)); }
#pragma unroll
            for (int n = 0; n < 8; ++n) { const float v = P.in[16][(size_t)(k0 + lane) * 8 + n]; const unsigned hb = f2bf(v);
                th[(size_t)n * 2048 + k0 + lane] = (bf16_t)hb; tl[(size_t)n * 2048 + k0 + lane] = (bf16_t)f2bf(v - __builtin_bit_cast(float, hb << 16));
                th[(size_t)(72 + n) * 2048 + k0 + lane] = 0; tl[(size_t)(72 + n) * 2048 + k0 + lane] = 0; }
            asm volatile("s_waitcnt lgkmcnt(0)" ::: "memory");
            continue; }
        {
            const int z = r / 32, fc = r % 32; const float* pe = P.in[7] + z * 2048 + fc * 64; const float* w = P.in[8] + (size_t)z * 2048 * 256 + (size_t)(fc * 64) * 256 + lane * 4;
            f32x4 a = (f32x4){0.f, 0.f, 0.f, 0.f};
#pragma unroll 8
            for (int k = 0; k < 64; ++k) a += *(const f32x4*)(w + (size_t)k * 256) * pe[k];
            *(f32x4*)(WSP(float, WS_PEWP) + ((size_t)z * 32 + fc) * 256 + lane * 4) = a;
        }
    }
    if (PART == 1) return;
    int* rt = WSP(int, WS_ROWTOK); int* rd = WSP(int, WS_ROWDST);
    for (int i = F.bid * NTHREADS + F.tid; i < MAXROWS; i += F.G * NTHREADS) { rt[i] = -1; rd[i] = -1; }
    { int* tk = WSP(int, WS_TOKL); for (int i = F.bid * NTHREADS + F.tid; i < 2 * BMS_MAXU * 64; i += F.G * NTHREADS) tk[i] = -1; }
}

DI void phase_ln1(Frame& F, const Params& P) {
    const int gid = F.bid * NTHREADS + F.tid;
    const float* modp = WSP(float, WS_MODP);
    if (gid < 12288) { float a = P.in[3][gid]; for (int kc = 0; kc < 32; ++kc) a += modp[(size_t)kc * 12288 + gid]; WSP(float, WS_MOD)[gid] = a; }
    else if (gid < 12288 + 512) { const int q = gid - 12288, z = q >> 8, col = q & 255; float a = P.in[9][q]; const float* pw = WSP(float, WS_PEWP);
        for (int fc = 0; fc < 32; ++fc) a += pw[((size_t)z * 32 + fc) * 256 + col]; WSP(float, WS_BIASC)[q] = a; }
    const int lane = F.lane;
    f32x4 sc[8], sh[8];
#pragma unroll
    for (int j = 0; j < 8; ++j) { const int col = 4 * lane + 256 * j; f32x4 a = *(const f32x4*)(P.in[3] + col), b = *(const f32x4*)(P.in[3] + D + col);
        for (int kc = 0; kc < 32; ++kc) { a += *(const f32x4*)(modp + (size_t)kc * 12288 + col); b += *(const f32x4*)(modp + (size_t)kc * 12288 + D + col); }
        sh[j] = a; sc[j] = b + 1.0f; }
    const int gw = F.bid * NWAVES + F.wave, NGW = F.G * NWAVES;
    const float* x = P.in[0]; bf16_t* U = WSP(bf16_t, WS_U);
    for (int m = gw; m < S; m += NGW) {
        const f32x4* xr = (const f32x4*)(x + (size_t)m * D) + lane;
        f32x4 v[8]; float s = 0.f;
#pragma unroll
        for (int j = 0; j < 8; ++j) { v[j] = xr[64 * j]; s += (v[j][0] + v[j][1]) + (v[j][2] + v[j][3]); }
        const float mean = wave_sum(s) * (1.f / D); float s2 = 0.f;
#pragma unroll
        for (int j = 0; j < 8; ++j) { v[j] = v[j] - mean; s2 += (v[j][0] * v[j][0] + v[j][1] * v[j][1]) + (v[j][2] * v[j][2] + v[j][3] * v[j][3]); }
        const float rstd = 1.f / sqrtf(wave_sum(s2) * (1.f / D) + LN_EPS);
        u32x2* o8 = (u32x2*)(U + (size_t)m * D) + lane;
#pragma unroll
        for (int j = 0; j < 8; ++j) { const f32x4 y = v[j] * rstd * sc[j] + sh[j]; u32x2 w; w.x = cvtpk(y[0], y[1]); w.y = cvtpk(y[2], y[3]); o8[64 * j] = w; }
    }
}

DI f32x16 mfma32(bf16x8 a, bf16x8 b, f32x16 c) { return __builtin_amdgcn_mfma_f32_32x32x16_bf16(a, b, c, 0, 0, 0); }
DI f32x4 mfma16(bf16x8 a, bf16x8 b, f32x4 c) { return __builtin_amdgcn_mfma_f32_16x16x32_bf16(a, b, c, 0, 0, 0); }
DI int perm23(int i) { return (i & ~12) | ((i & 4) << 1) | ((i & 8) >> 1); }
DI int crow(int r, int hi) { return (r & 3) + 8 * (r >> 2) + 4 * hi; }
constexpr float NEG_INF = -__builtin_inff();

template <int CTRL> DI float dppf(float x) { return __builtin_bit_cast(float, __builtin_amdgcn_update_dpp(0, __builtin_bit_cast(int, x), CTRL, 0xF, 0xF, true)); }
template <int CTRL> DI int dppi(int x) { return __builtin_amdgcn_update_dpp(0, x, CTRL, 0xF, 0xF, true); }
DI float xmax32(float x) { auto rr = __builtin_amdgcn_permlane32_swap(__float_as_uint(x), __float_as_uint(x), false, false); return fmaxf(__uint_as_float(rr[0]), __uint_as_float(rr[1])); }
DI float xadd32(float x) { auto rr = __builtin_amdgcn_permlane32_swap(__float_as_uint(x), __float_as_uint(x), false, false); return __uint_as_float(rr[0]) + __uint_as_float(rr[1]); }
DI float xmax16(float x) { auto rr = __builtin_amdgcn_permlane16_swap(__float_as_uint(x), __float_as_uint(x), false, false); return fmaxf(__uint_as_float(rr[0]), __uint_as_float(rr[1])); }
DI float xadd16(float x) { auto rr = __builtin_amdgcn_permlane16_swap(__float_as_uint(x), __float_as_uint(x), false, false); return __uint_as_float(rr[0]) + __uint_as_float(rr[1]); }
DI float quad_sum(float x) { x += dppf<0xB1>(x); x += dppf<0x4E>(x); return x; }
DI float row_maxf(float x) { x = fmaxf(x, dppf<0xB1>(x)); x = fmaxf(x, dppf<0x4E>(x)); x = fmaxf(x, dppf<0x124>(x)); x = fmaxf(x, dppf<0x128>(x)); return x; }
DI float row_minf(float x) { x = fminf(x, dppf<0xB1>(x)); x = fminf(x, dppf<0x4E>(x)); x = fminf(x, dppf<0x124>(x)); x = fminf(x, dppf<0x128>(x)); return x; }
DI int row_mini(int x) { int y; y = dppi<0xB1>(x); x = y < x ? y : x; y = dppi<0x4E>(x); x = y < x ? y : x; y = dppi<0x124>(x); x = y < x ? y : x; y = dppi<0x128>(x); x = y < x ? y : x; return x; }
DI float rdl(float x, int l) { return __int_as_float(__builtin_amdgcn_readlane(__float_as_int(x), l)); }
DI float wave_max_u(float x) { x = row_maxf(x); const float a = rdl(x, 0), b = rdl(x, 16), c = rdl(x, 32), d = rdl(x, 48); return fmaxf(fmaxf(a, b), fmaxf(c, d)); }
DI float wave_min_u(float x) { x = row_minf(x); const float a = rdl(x, 0), b = rdl(x, 16), c = rdl(x, 32), d = rdl(x, 48); return fminf(fminf(a, b), fminf(c, d)); }
DI int wave_min_ui(int x) { x = row_mini(x); const int a = __builtin_amdgcn_readlane(x, 0), b = __builtin_amdgcn_readlane(x, 16), c = __builtin_amdgcn_readlane(x, 32), d = __builtin_amdgcn_readlane(x, 48); const int ab = a < b ? a : b, cd = c < d ? c : d; return ab < cd ? ab : cd; }

template <int PARTS> DI void phase_cmp2_scan(Frame& F, const Params& P) {
    const int lane = F.lane;
    if (PARTS & 1) { const float* hp = WSP(float, WS_HC); const float* w2 = P.in[10];
      for (int row = F.bid * NWAVES + F.wave; row < 4 * 1024; row += F.G * NWAVES) {
        const int zg = row >> 10, n = row & 1023, z = zg >> 1, g = zg & 1;
        f32x4 hv = *(const f32x4*)(WSP(float, WS_BIASC) + z * 256 + 4 * lane);
#pragma unroll
        for (int ks = 0; ks < 4; ++ks) hv += *(const f32x4*)(hp + ((size_t)(ks * 4 + zg) * 1024 + n) * 256 + 4 * lane);
        const float h0 = gelu_tanh(hv[0]), h1 = gelu_tanh(hv[1]), h2 = gelu_tanh(hv[2]), h3 = gelu_tanh(hv[3]);
        const float* w = w2 + (size_t)z * 256 * 64 + lane;
        float a = 0.f;
#pragma unroll 8
        for (int q = 0; q < 64; ++q) { a += rdl(h0, q) * w[(4 * q) * 64]; a += rdl(h1, q) * w[(4 * q + 1) * 64]; a += rdl(h2, q) * w[(4 * q + 2) * 64]; a += rdl(h3, q) * w[(4 * q + 3) * 64]; }
        if (z == 0) WSP(bf16_t, WS_KC)[((size_t)g * 1024 + n) * 64 + lane] = (bf16_t)f2bf(a);
        else WSP(bf16_t, WS_VCT)[(size_t)g * 64 * 1024 + ((size_t)(n >> 5) * 64 + lane) * 32 + (n & 31)] = (bf16_t)f2bf(a);
      } }
    if (!(PARTS & 2)) return;
    { const int h = F.wave;
      for (int kb = F.bid - 64; kb < S / 64; kb += F.G - 64) {
        const u32x4* kr = (const u32x4*)(WSP(bf16_t, WS_FK) + ((size_t)h * S + kb * 64 + lane) * 64); float a = 0.f;
#pragma unroll
        for (int c = 0; c < 8; ++c) { const u32x4 wv = kr[c];
#pragma unroll
            for (int q = 0; q < 4; ++q) { const float lo = __builtin_bit_cast(float, wv[q] << 16), hi2 = __builtin_bit_cast(float, wv[q] & 0xffff0000u); a += lo * lo + hi2 * hi2; } }
        a = wave_max_u(a);
        if (lane == 0) WSP(float, WS_KMAX)[kb * 8 + h] = a;
      } }
    const int hb = F.G - 1 - F.bid;
    if (hb >= 0 && hb < 8) {
        const int h = hb; const float* lf = WSP(float, WS_LOGF); float* fc = WSP(float, WS_FC) + (size_t)h * S;
        LAS double* red = (LAS double*)F.lds;
        double loc = 0.0; const int t0 = F.tid * 32; float v[32];
#pragma unroll
        for (int i = 0; i < 32; ++i) { v[i] = lf[(size_t)(t0 + i) * 8 + h]; loc += (double)v[i]; }
        double inc = loc;
#pragma unroll
        for (int o = 1; o < 64; o <<= 1) { const double up = __shfl_up(inc, o); if (lane >= o) inc += up; }
        if (lane == 63) red[F.wave] = inc;
        __syncthreads();
        double run = inc - loc;
        for (int w = 0; w < F.wave; ++w) run += red[w];
#pragma unroll
        for (int i = 0; i < 32; ++i) { run += (double)v[i]; fc[t0 + i] = (float)run; }
        __syncthreads();
    }
}


constexpr int PSLC_LD = 272, XLD = 65, TB_LD = 132;
constexpr int AW_SEL = 512;
constexpr int AW_PSLC = 8 * PSLC_LD * 4;
constexpr int KROW = 144, VROW = 80;
constexpr int ST_K = 0, ST_V = 64 * KROW, ST_B = ST_V + 2 * 64 * VROW, ST_BYTES = ST_B + 256;
constexpr int AL_SELM = 0, AL_PSLC = NWAVES * AW_SEL, AL_STAGE = AL_PSLC + NWAVES * AW_PSLC, AL_TB = 135 * 1024, AL_FLAG = AL_TB + 2 * 4 * TB_LD * 4, AL_END = AL_FLAG + 128;
constexpr int SEL_TB = 3;
constexpr int AL_SEL2 = AL_PSLC, SEL2_BYTES = SEL_TB * ST_B;
static_assert(AL_SEL2 + 2 * SEL2_BYTES <= AL_TB && AL_STAGE + 2 * ST_BYTES <= AL_TB, "stages fit below the bias tables");
static_assert(AL_END <= LDS_MISC, "attention LDS map");

template <int SD, bool HAS_V, bool HAS_F, int TB = 1, int BASE = AL_STAGE, class Body>
DI void stream_tiles(Frame& F, const bf16_t* __restrict__ K, const bf16_t* __restrict__ Vtb, const float* __restrict__ Fk, float fref, int kv_first, int kv_step, int nt, Body&& body) {
    constexpr int STG = TB == 1 ? ST_BYTES : TB * ST_B;
    LAS unsigned char* st0 = F.lds + BASE;
    volatile LAS unsigned* flags = (volatile LAS unsigned*)(F.lds + AL_FLAG);
    const int tid = F.tid;
    const int krow = tid >> 3, kc = tid & 7;
    const int vsub = tid >> 8, vd = (tid & 255) >> 2, vc = tid & 3;
    const unsigned kdst = krow * KROW + kc * 16, vdst = ST_V + vsub * 64 * VROW + vd * VROW + vc * 16;
    const bf16_t* kbase = K + (size_t)krow * 64 + kc * 8; const bf16_t* vbase = HAS_V ? Vtb + tid * 8 : nullptr;
    u32x4 rk[SD][TB], rv[SD][TB]; float rf[SD];
#define ST_GLOAD(slot, kv0_) do { const int _kv = (kv0_); _Pragma("unroll") for (int _b = 0; _b < TB; ++_b) { rk[slot][_b] = *(const u32x4*)(kbase + (size_t)(_kv + 64 * _b) * 64); \
        if (HAS_V) rv[slot][_b] = *(const u32x4*)(vbase + (size_t)((_kv >> 5) + 2 * _b) * 2048); } if (HAS_F) { if (tid < 64) rf[slot] = Fk[_kv + tid]; } } while (0)
#define ST_LSTORE(stp, slot) do { LAS unsigned char* _st = (stp); _Pragma("unroll") for (int _b = 0; _b < TB; ++_b) { *(LAS u32x4*)(_st + _b * ST_B + kdst) = rk[slot][_b]; if (HAS_V) *(LAS u32x4*)(_st + _b * ST_B + vdst) = rv[slot][_b]; } \
        if (HAS_F) { if (tid < 64) *(LAS float*)(_st + ST_B + tid * 4) = (fref - rf[slot]) * LOG2E; } } while (0)
    if (nt <= 0) return;
    if (HAS_F) { if (tid < 16) flags[tid] = 0u; }
    ST_GLOAD(0, kv_first);
#pragma unroll
    for (int d = 1; d < SD; ++d) if (d < nt) ST_GLOAD(d, kv_first + d * kv_step);
    ST_LSTORE(st0, 0);
    if (SD < nt) ST_GLOAD(0, kv_first + SD * kv_step);
    __syncthreads();
    bool stop = false;
    for (int it0 = 0; it0 < nt && !stop; it0 += SD) {
#pragma unroll
        for (int d = 0; d < SD; ++d) {
            const int it = it0 + d;
            if (it >= nt || stop) break;
            const int par = (SD % 2 == 0) ? (d & 1) : (it & 1);
            __builtin_amdgcn_sched_barrier(0);
            const bool done = body(kv_first + it * kv_step, st0 + par * STG);
            __builtin_amdgcn_sched_barrier(0);
            if (it + 1 < nt) { ST_LSTORE(st0 + (par ^ 1) * STG, (d + 1) % SD); if (it + 1 + SD < nt) ST_GLOAD((d + 1) % SD, kv_first + (it + 1 + SD) * kv_step); }
            if constexpr (HAS_F) { if (F.lane == 0) flags[par * 8 + F.wave] = done ? 1u : 0u; } else { (void)done; }
            __syncthreads();
            if constexpr (HAS_F) {
                const u32x4 fa = *(volatile LAS u32x4*)(F.lds + AL_FLAG + par * 32), fb = *(volatile LAS u32x4*)(F.lds + AL_FLAG + par * 32 + 16);
                if ((fa[0] & fa[1] & fa[2] & fa[3] & fb[0] & fb[1] & fb[2] & fb[3]) != 0u) stop = true; }
        }
    }
    asm volatile("s_waitcnt vmcnt(0)" ::: "memory");
    __syncthreads();
#undef ST_GLOAD
#undef ST_LSTORE
}

DI void lds_k(bf16x8 (&kf)[4], const LAS unsigned char* st, int sub, int lane) {
    const LAS unsigned char* p = st + ST_K + (32 * sub + perm23(lane & 31)) * KROW + 16 * (lane >> 5);
#pragma unroll
    for (int ks = 0; ks < 4; ++ks) kf[ks] = *(const LAS bf16x8*)(p + 32 * ks);
}
DI void lds_v(bf16x8 (&vf)[4], const LAS unsigned char* st, int sub, int lane) {
    const LAS unsigned char* p = st + ST_V + sub * 64 * VROW + (lane & 31) * VROW + 16 * (lane >> 5);
#pragma unroll
    for (int d0 = 0; d0 < 2; ++d0)
#pragma unroll
        for (int s2 = 0; s2 < 2; ++s2) vf[d0 * 2 + s2] = *(const LAS bf16x8*)(p + d0 * 32 * VROW + 32 * s2);
}
DI f32x16 qk32f(const bf16x8 (&qf)[4], const bf16x8 (&kf)[4]) {
    f32x16 s;
#pragma unroll
    for (int r = 0; r < 16; ++r) s[r] = 0.f;
#pragma unroll
    for (int ks = 0; ks < 4; ++ks) s = mfma32(kf[ks], qf[ks], s);
    return s;
}
DI void pv32f(f32x16 (&o)[2], const f32x16& p, const bf16x8 (&vf)[4]) {
    bf16x8 pf[2];
#pragma unroll
    for (int s2 = 0; s2 < 2; ++s2) { u32x4 w; w.x = cvtpk(p[8 * s2 + 0], p[8 * s2 + 1]); w.y = cvtpk(p[8 * s2 + 2], p[8 * s2 + 3]); w.z = cvtpk(p[8 * s2 + 4], p[8 * s2 + 5]); w.w = cvtpk(p[8 * s2 + 6], p[8 * s2 + 7]); pf[s2] = __builtin_bit_cast(bf16x8, w); }
#pragma unroll
    for (int d0 = 0; d0 < 2; ++d0)
#pragma unroll
        for (int s2 = 0; s2 < 2; ++s2) o[d0] = mfma32(vf[d0 * 2 + s2], pf[s2], o[d0]);
}
DI float max16(const f32x16& s) {
    float mx = fmaxf(fmaxf(s[0], s[1]), fmaxf(s[2], s[3]));
#pragma unroll
    for (int r = 4; r < 16; r += 4) mx = fmaxf(mx, fmaxf(fmaxf(s[r], s[r + 1]), fmaxf(s[r + 2], s[r + 3])));
    return mx;
}
DI float online_upd(float mx, float& m, float& l, float& mu_out) {
    mx = xmax32(mx);
    const float mn = fmaxf(m, mx), mu = (mn == NEG_INF) ? 0.f : mn;
    const float alpha = fexp2(m - mu);
    l *= alpha; m = mn; mu_out = mu;
    return alpha;
}
DI void exp16(f32x16& s, float mu, float& l) {
    float ps = 0.f;
#pragma unroll
    for (int r = 0; r < 16; ++r) { s[r] = fexp2(s[r] - mu); ps += s[r]; }
    l += ps;
}

DI void fox_task(Frame& F, int h, int qb) {
    const int lane = F.lane, i = lane & 31, hi = lane >> 5, w = F.wave;
    const bf16_t* Q = WSP(bf16_t, WS_FQ) + (size_t)h * S * 64;
    const bf16_t* K = WSP(bf16_t, WS_FK) + (size_t)h * S * 64;
    const bf16_t* Vt = WSP(bf16_t, WS_FVT) + (size_t)h * 64 * S;
    const float* Fc = WSP(float, WS_FC) + (size_t)h * S;
    const int q0 = qb * 256, r0 = q0 + 32 * w, t = r0 + i;
    bf16x8 qf[4];
#pragma unroll
    for (int ks = 0; ks < 4; ++ks) qf[ks] = *(const bf16x8*)(Q + (size_t)t * 64 + 16 * ks + 8 * hi);
    asm volatile("" : "+v"(qf[0]), "+v"(qf[1]), "+v"(qf[2]), "+v"(qf[3]));
    const float fref = Fc[q0];
    float qn2 = 0.f;
#pragma unroll
    for (int ks = 0; ks < 4; ++ks)
#pragma unroll
        for (int j = 0; j < 8; ++j) { const float qv = bf2f((bf16_t)qf[ks][j]); qn2 += qv * qv; }
    qn2 = xadd32(qn2);
    float km2 = 0.f; { const float* kp = WSP(float, WS_KMAX) + h;
#pragma unroll
      for (int c = 0; c < 4; ++c) km2 = fmaxf(km2, kp[(lane + 64 * c) * 8]); }
    const float qkb = sqrtf(wave_max_u(qn2) * wave_max_u(km2)) * 1.01f;
    float m = NEG_INF, l = 0.f; f32x16 o[2];
#pragma unroll
    for (int r = 0; r < 16; ++r) { o[0][r] = 0.f; o[1][r] = 0.f; }
    constexpr float FOX_SKIP = 44.f;
    bool wdone = false;
    stream_tiles<4, true, true>(F, K, Vt, Fc, fref, q0 + 192, -64, qb * 4 + 4, [&](int kv0, const LAS unsigned char* st) __attribute__((always_inline)) -> bool {
        if (wdone) return true;
        if (kv0 > r0) return false;
        const bool two = (kv0 + 32 <= r0);
        bf16x8 kf[4]; f32x16 s0, s1;
        lds_k(kf, st, 0, lane); s0 = qk32f(qf, kf);
        { const LAS float* bp = (const LAS float*)(st + ST_B) + 8 * hi; const f32x4 b0 = *(const LAS f32x4*)(bp), b1 = *(const LAS f32x4*)(bp + 4), b2 = *(const LAS f32x4*)(bp + 16), b3 = *(const LAS f32x4*)(bp + 20);
#pragma unroll
          for (int r = 0; r < 16; ++r) s0[r] += (r < 4) ? b0[r & 3] : (r < 8) ? b1[r & 3] : (r < 12) ? b2[r & 3] : b3[r & 3]; }
        if (kv0 == r0) {
#pragma unroll
            for (int r = 0; r < 16; ++r) { const int key = kv0 + 16 * (r >> 3) + 8 * hi + (r & 7); s0[r] = (key <= t) ? s0[r] : NEG_INF; } }
        float mx = max16(s0);
        if (two) {
            lds_k(kf, st, 1, lane); s1 = qk32f(qf, kf);
            const LAS float* bp = (const LAS float*)(st + ST_B) + 32 + 8 * hi; const f32x4 b0 = *(const LAS f32x4*)(bp), b1 = *(const LAS f32x4*)(bp + 4), b2 = *(const LAS f32x4*)(bp + 16), b3 = *(const LAS f32x4*)(bp + 20);
#pragma unroll
            for (int r = 0; r < 16; ++r) s1[r] += (r < 4) ? b0[r & 3] : (r < 8) ? b1[r & 3] : (r < 12) ? b2[r & 3] : b3[r & 3];
            if (kv0 + 32 == r0) {
#pragma unroll
                for (int r = 0; r < 16; ++r) { const int key = kv0 + 32 + 16 * (r >> 3) + 8 * hi + (r & 7); s1[r] = (key <= t) ? s1[r] : NEG_INF; } }
            mx = fmaxf(mx, max16(s1));
        }
        float mu; const float alpha = online_upd(mx, m, l, mu);
        o[0] *= alpha; o[1] *= alpha;
        bf16x8 vf[4];
        exp16(s0, mu, l); lds_v(vf, st, 0, lane); pv32f(o, s0, vf);
        if (two) { exp16(s1, mu, l); lds_v(vf, st, 1, lane); pv32f(o, s1, vf); }
        const float b_first = *((const LAS float*)(st + ST_B));
        wdone = (qkb + b_first < wave_min_u(m) - FOX_SKIP);
        return wdone;
    });
    l = xadd32(l);
    const float inv = l > 0.f ? 1.f / l : 0.f;
    bf16_t* O = WSP(bf16_t, WS_O) + (size_t)t * 1024 + 512 + h * 64;
#pragma unroll
    for (int d0 = 0; d0 < 2; ++d0)
#pragma unroll
        for (int g4 = 0; g4 < 4; ++g4) { u32x2 wv; wv.x = cvtpk(o[d0][4 * g4] * inv, o[d0][4 * g4 + 1] * inv); wv.y = cvtpk(o[d0][4 * g4 + 2] * inv, o[d0][4 * g4 + 3] * inv);
            *(u32x2*)(O + 32 * d0 + 8 * g4 + 4 * hi) = wv; }
}

DI void t5_near(f32x16& s, const LAS float* tb, int dbase, int kstride, int key0, int hi, int dmax) {
#pragma unroll
    for (int r = 0; r < 16; ++r) { const int key = key0 + 16 * (r >> 3) + 8 * hi + (r & 7); const int dist = dbase - kstride * key;
        const int idx = dist < 0 ? 0 : (dist < 128 ? dist : 128); const float bv = tb[idx];
        s[r] = (dist >= 0 && dist < dmax) ? s[r] + bv : NEG_INF; }
}

DI void nsa_task(Frame& F, int g, int tg0, LAS float* pslc, LAS unsigned* selm, const LAS float* tbg) {
    const int lane = F.lane, i = lane & 31, hi = lane >> 5, tl = i >> 2, hh = i & 3, t0 = tg0 + 8 * F.wave, t = t0 + tl;
    const bf16_t* Q = WSP(bf16_t, WS_QN) + (size_t)(g * 4 + hh) * S * 64 + (size_t)t * 64;
    const bf16_t* Kc = WSP(bf16_t, WS_KC) + (size_t)g * 1024 * 64; const bf16_t* VcT = WSP(bf16_t, WS_VCT) + (size_t)g * 64 * 1024;
    const LAS float* tb = tbg + hh * TB_LD;
    const float tbfar = tb[128];
    bf16x8 qf[4];
#pragma unroll
    for (int ks = 0; ks < 4; ++ks) qf[ks] = *(const bf16x8*)(Q + 16 * ks + 8 * hi);
    asm volatile("" : "+v"(qf[0]), "+v"(qf[1]), "+v"(qf[2]), "+v"(qf[3]));
    const float* gn = WSP(float, WS_GN) + (size_t)t * 24 + g * 12 + hh * 3;
    const float g0 = gn[0], g2 = gn[2];
    const int tmax = t0 + 7;
    const int nt_c = (((tg0 + 63 - 31) >> 4) >> 6) + 1;
    float m = NEG_INF, l = 0.f;
    stream_tiles<2, false, false>(F, Kc, nullptr, nullptr, 0.f, 0, 64, nt_c, [&](int n0, const LAS unsigned char* st) __attribute__((always_inline)) -> bool {
#pragma unroll
        for (int sub = 0; sub < 2; ++sub) { const int ns = n0 + 32 * sub;
            if (16 * ns + 31 > tmax) continue;
            bf16x8 kf[4]; lds_k(kf, st, sub, lane); f32x16 s = qk32f(qf, kf);
            if (t0 - 16 * (ns + 31) - 31 >= 128) {
#pragma unroll
                for (int r = 0; r < 16; ++r) s[r] += tbfar; }
            else t5_near(s, tb, t - 31, 16, ns, hi, 1 << 30);
            float mu; (void)online_upd(max16(s), m, l, mu); exp16(s, mu, l);
        }
        return false; });
    l = xadd32(l);
    const float invl = l > 0.f ? 1.f / l : 0.f, mu = (m == NEG_INF) ? 0.f : m;
    float carry = 0.f;
    f32x16 oc[2];
#pragma unroll
    for (int r = 0; r < 16; ++r) { oc[0][r] = 0.f; oc[1][r] = 0.f; }
    stream_tiles<2, true, false>(F, Kc, VcT, nullptr, 0.f, 0, 64, nt_c, [&](int n0, const LAS unsigned char* st) __attribute__((always_inline)) -> bool {
#pragma unroll
        for (int sub = 0; sub < 2; ++sub) { const int ns = n0 + 32 * sub;
            if (16 * ns + 31 > tmax) continue;
            bf16x8 kf[4]; lds_k(kf, st, sub, lane); f32x16 s = qk32f(qf, kf);
            if (t0 - 16 * (ns + 31) - 31 >= 128) {
#pragma unroll
                for (int r = 0; r < 16; ++r) s[r] += tbfar; }
            else t5_near(s, tb, t - 31, 16, ns, hi, 1 << 30);
#pragma unroll
            for (int r = 0; r < 16; ++r) s[r] = fexp2(s[r] - mu) * invl;
            bf16x8 vf[4]; lds_v(vf, st, sub, lane); pv32f(oc, s, vf);
            { float a[4], b[4];
#pragma unroll
              for (int G4 = 0; G4 < 4; ++G4) { a[G4] = quad_sum(s[4 * G4] + s[4 * G4 + 1] + s[4 * G4 + 2] + 0.5f * s[4 * G4 + 3]); b[G4] = quad_sum(0.5f * s[4 * G4 + 3]); }
              const auto r1 = __builtin_amdgcn_permlane32_swap(__float_as_uint(b[1]), __float_as_uint(b[1]), false, false), r3 = __builtin_amdgcn_permlane32_swap(__float_as_uint(b[3]), __float_as_uint(b[3]), false, false);
              const float x1 = __uint_as_float(hi ? r1[0] : r1[1]), x3 = __uint_as_float(hi ? r3[0] : r3[1]);
              if (hh == 0) { LAS float* pr = pslc + tl * PSLC_LD + (ns >> 2) + 2 * hi;
                  pr[0] = a[0] + (hi ? x1 : carry); pr[1] = a[1] + b[0]; pr[4] = a[2] + (hi ? x3 : x1); pr[5] = a[3] + b[2]; }
              carry = x3; }
        }
        return false; });
    asm volatile("s_waitcnt lgkmcnt(0)" ::: "memory"); __builtin_amdgcn_wave_barrier();
    { const int cur = t0 >> 6;
      if (cur <= 15) { if (lane < 64) selm[lane] = ((lane & 7) == 0) ? ((2u << cur) - 1u) : 0u; }
      else {
#pragma unroll 1
        for (int k8 = 0; k8 < 8; ++k8) {
            float v[4];
#pragma unroll
            for (int k = 0; k < 4; ++k) { const int j = lane + 64 * k; v[k] = (j >= 1 && j <= cur - 2) ? pslc[k8 * PSLC_LD + j] : -1.f; }
            unsigned tb_ = 0u;
#pragma unroll 1
            for (int bit = 30; bit >= 0; --bit) { const float th = __uint_as_float(tb_ | (1u << bit));
                const int c = __builtin_popcountll(__ballot(v[0] >= th)) + __builtin_popcountll(__ballot(v[1] >= th)) + __builtin_popcountll(__ballot(v[2] >= th)) + __builtin_popcountll(__ballot(v[3] >= th));
                if (c >= 13) tb_ |= (1u << bit); }
            const float T = __uint_as_float(tb_);
            unsigned long long sel[4]; int ngt = 0;
#pragma unroll
            for (int k = 0; k < 4; ++k) { sel[k] = __ballot(v[k] > T); ngt += __builtin_popcountll(sel[k]); }
            int need = 13 - ngt;
#pragma unroll
            for (int k = 0; k < 4; ++k) { unsigned long long eq = __ballot(v[k] == T); while (need > 0 && eq) { const unsigned long long low = eq & (0ull - eq); sel[k] |= low; eq ^= low; --need; } }
            unsigned mk[8];
#pragma unroll
            for (int k = 0; k < 4; ++k) { mk[2 * k] = (unsigned)sel[k]; mk[2 * k + 1] = (unsigned)(sel[k] >> 32); }
#pragma unroll
            for (int w = 0; w < 8; ++w) { if (w == 0) mk[w] |= 1u; if ((cur >> 5) == w) mk[w] |= 1u << (cur & 31); if (((cur - 1) >> 5) == w) mk[w] |= 1u << ((cur - 1) & 31); }
#pragma unroll
            for (int w = 0; w < 8; ++w) if (lane == w) selm[k8 * 8 + w] = mk[w];
        } } }
    asm volatile("s_waitcnt lgkmcnt(0)" ::: "memory"); __builtin_amdgcn_wave_barrier();
    const bf16_t* Sk = WSP(bf16_t, WS_SK) + (size_t)g * S * 64; const bf16_t* SvT = WSP(bf16_t, WS_SVT) + (size_t)g * 64 * S;
    const int n16 = lane & 15, kq = lane >> 4;
    LAS float* xch = pslc;
    float* XG = WSP(float, WS_U) + (size_t)t * 512 + g * 256 + hh * 64;
#pragma unroll
    for (int d0 = 0; d0 < 2; ++d0)
#pragma unroll
        for (int g4 = 0; g4 < 4; ++g4) *(f32x4*)(XG + 32 * d0 + 8 * g4 + 4 * hi) = (f32x4){g0 * oc[d0][4 * g4], g0 * oc[d0][4 * g4 + 1], g0 * oc[d0][4 * g4 + 2], g0 * oc[d0][4 * g4 + 3]};
    const bf16_t* Wk = WSP(bf16_t, WS_WK) + (size_t)g * S * 64; const bf16_t* WvT = WSP(bf16_t, WS_WVT) + (size_t)g * 64 * S;
    float mw = NEG_INF, lw = 0.f; f32x16 ow[2];
#pragma unroll
    for (int r = 0; r < 16; ++r) { ow[0][r] = 0.f; ow[1][r] = 0.f; }
    { const int lo = tg0 - 511 > 0 ? tg0 - 511 : 0; const int kvs = lo & ~63; const int nt_w = ((tg0 - kvs) >> 6) + 1;
      if (!(NSAP & 2)) stream_tiles<2, true, false>(F, Wk, WvT, nullptr, 0.f, kvs, 64, nt_w, [&](int kv0, const LAS unsigned char* st) __attribute__((always_inline)) -> bool {
#pragma unroll
        for (int sub = 0; sub < 2; ++sub) { const int ks0 = kv0 + 32 * sub;
            if (!((ks0 <= tmax) && (t0 - (ks0 + 31) < 512))) continue;
            __builtin_amdgcn_sched_barrier(0);
            bf16x8 kf[4]; lds_k(kf, st, sub, lane); f32x16 sw = qk32f(qf, kf);
            if (t0 - ks0 - 31 >= 128 && tmax - ks0 < 512) {
#pragma unroll
                for (int r = 0; r < 16; ++r) sw[r] += tbfar; }
            else t5_near(sw, tb, t, 1, ks0, hi, 512);
            float mu2; const float alpha = online_upd(max16(sw), mw, lw, mu2);
            ow[0] *= alpha; ow[1] *= alpha;
            exp16(sw, mu2, lw); bf16x8 vf[4]; lds_v(vf, st, sub, lane); pv32f(ow, sw, vf);
            __builtin_amdgcn_sched_barrier(0);
        }
        return false; }); }
    lw = xadd32(lw);
    { const float invw = lw > 0.f ? g2 / lw : 0.f;
      asm volatile("s_waitcnt vmcnt(0)" ::: "memory");
#pragma unroll
      for (int d0 = 0; d0 < 2; ++d0)
#pragma unroll
        for (int g4 = 0; g4 < 4; ++g4) { f32x4 v = *(const f32x4*)(XG + 32 * d0 + 8 * g4 + 4 * hi);
            v[0] += invw * ow[d0][4 * g4]; v[1] += invw * ow[d0][4 * g4 + 1]; v[2] += invw * ow[d0][4 * g4 + 2]; v[3] += invw * ow[d0][4 * g4 + 3];
            *(f32x4*)(XG + 32 * d0 + 8 * g4 + 4 * hi) = v; } }
#if BMS
    { unsigned* SG = WSP(unsigned, WS_SELMG);
      SG[((size_t)(t0 + (lane >> 3)) * 2 + g) * 8 + (lane & 7)] = selm[lane];
      if (F.tid < 256) { const int j = F.tid; int c = 0;
#pragma unroll
          for (int w8 = 0; w8 < 8; ++w8) { const LAS unsigned* sw = (const LAS unsigned*)(F.lds + AL_SELM + w8 * AW_SEL);
#pragma unroll
              for (int k8 = 0; k8 < 8; ++k8) c += (int)((sw[k8 * 8 + (j >> 5)] >> (j & 31)) & 1u); }
          WSP(int, WS_HISTB)[((size_t)g * 256 + (tg0 >> 6)) * 256 + j] = c; } }
}

#else
    {
        LAS unsigned* um = selm + 64;
        if (lane < 16) { const int qd = lane >> 3, w = lane & 7; um[lane] = selm[(4 * qd + 0) * 8 + w] | selm[(4 * qd + 1) * 8 + w] | selm[(4 * qd + 2) * 8 + w] | selm[(4 * qd + 3) * 8 + w]; }
        asm volatile("s_waitcnt lgkmcnt(0)" ::: "memory"); __builtin_amdgcn_wave_barrier();
        const int hq = n16 & 3;
        const LAS float* tb2 = tbg + hq * TB_LD; const float tbfar2 = tb2[128];
        bf16x8 q2[2][2]; float m2[2], l2[2], gs[2]; f32x4 o2[2][4];
#pragma unroll
        for (int qd = 0; qd < 2; ++qd) { const int ts = t0 + 4 * qd + (n16 >> 2);
            const bf16_t* Q2 = WSP(bf16_t, WS_QN) + (size_t)(g * 4 + hq) * S * 64 + (size_t)ts * 64;
            q2[qd][0] = *(const bf16x8*)(Q2 + 8 * kq); q2[qd][1] = *(const bf16x8*)(Q2 + 32 + 8 * kq);
            asm volatile("" : "+v"(q2[qd][0]), "+v"(q2[qd][1]));
            gs[qd] = WSP(float, WS_GN)[(size_t)ts * 24 + g * 12 + hq * 3 + 1];
            m2[qd] = NEG_INF; l2[qd] = 0.f;
#pragma unroll
            for (int dt = 0; dt < 4; ++dt) o2[qd][dt] = (f32x4){0.f, 0.f, 0.f, 0.f}; }
        const unsigned kfo = ST_K + (8 * (n16 >> 2) + (n16 & 3)) * KROW + 16 * kq, vfo = ST_V + n16 * VROW + 16 * kq;
        unsigned umw[2] = {0u, 0u}, ownw[2] = {0u, 0u};
        if (!(NSAP & 1)) stream_tiles<1, true, false, SEL_TB, AL_SEL2>(F, Sk, SvT, nullptr, 0.f, 0, 64 * SEL_TB, ((tg0 >> 6) + SEL_TB) / SEL_TB, [&](int kvt, const LAS unsigned char* stt) __attribute__((always_inline)) -> bool {
#pragma unroll 1
          for (int bb = 0; bb < SEL_TB; ++bb) { const int kv0 = kvt + 64 * bb; const LAS unsigned char* st = stt + bb * ST_B;
            const int j = kv0 >> 6;
            if (j > (tg0 >> 6)) break;
            if ((j & 31) == 0) {
#pragma unroll
                for (int qd = 0; qd < 2; ++qd) { umw[qd] = __builtin_amdgcn_readfirstlane(um[qd * 8 + (j >> 5)]); ownw[qd] = selm[(4 * qd + (n16 >> 2)) * 8 + (j >> 5)]; } }
#pragma unroll
            for (int qd = 0; qd < 2; ++qd) {
                __builtin_amdgcn_sched_barrier(0);
                if (!((umw[qd] >> (j & 31)) & 1u)) continue;
                const int tq = 4 * qd + (n16 >> 2), ts = t0 + tq, tsmin = t0 + 4 * qd;
                const bool selok = (ownw[qd] >> (j & 31)) & 1u;
                f32x4 sc[2][2];
#pragma unroll
                for (int gq = 0; gq < 2; ++gq)
#pragma unroll
                    for (int ab = 0; ab < 2; ++ab) { const LAS unsigned char* kp = st + kfo + (32 * gq + 4 * ab) * KROW;
                        f32x4 a = (f32x4){0.f, 0.f, 0.f, 0.f}; a = mfma16(*(const LAS bf16x8*)(kp), q2[qd][0], a); a = mfma16(*(const LAS bf16x8*)(kp + 64), q2[qd][1], a); sc[gq][ab] = a; }
                float mx = NEG_INF;
                if (tsmin - (kv0 + 63) >= 128) {
                    const float add = selok ? tbfar2 : NEG_INF;
#pragma unroll
                    for (int gq = 0; gq < 2; ++gq)
#pragma unroll
                        for (int ab = 0; ab < 2; ++ab)
#pragma unroll
                            for (int r = 0; r < 4; ++r) { const float v = sc[gq][ab][r] + add; sc[gq][ab][r] = v; mx = fmaxf(mx, v); }
                } else {
#pragma unroll
                    for (int gq = 0; gq < 2; ++gq)
#pragma unroll
                        for (int ab = 0; ab < 2; ++ab)
#pragma unroll
                            for (int r = 0; r < 4; ++r) { const int key = kv0 + 32 * gq + 8 * kq + 4 * ab + r; const int dist = ts - key;
                                const int idx = dist < 0 ? 0 : (dist < 128 ? dist : 128); const float bv = tb2[idx];
                                const float v = (selok && dist >= 0) ? sc[gq][ab][r] + bv : NEG_INF; sc[gq][ab][r] = v; mx = fmaxf(mx, v); }
                }
                mx = xmax16(mx); mx = xmax32(mx);
                const float mn = fmaxf(m2[qd], mx), mu2 = (mn == NEG_INF) ? 0.f : mn; const float alpha = fexp2(m2[qd] - mu2);
                float ps = 0.f;
#pragma unroll
                for (int gq = 0; gq < 2; ++gq)
#pragma unroll
                    for (int ab = 0; ab < 2; ++ab)
#pragma unroll
                        for (int r = 0; r < 4; ++r) { const float p = fexp2(sc[gq][ab][r] - mu2); sc[gq][ab][r] = p; ps += p; }
                l2[qd] = l2[qd] * alpha + ps; m2[qd] = mn;
#pragma unroll
                for (int dt = 0; dt < 4; ++dt) o2[qd][dt] *= alpha;
#pragma unroll
                for (int gq = 0; gq < 2; ++gq) {
                    u32x4 pw; pw.x = cvtpk(sc[gq][0][0], sc[gq][0][1]); pw.y = cvtpk(sc[gq][0][2], sc[gq][0][3]); pw.z = cvtpk(sc[gq][1][0], sc[gq][1][1]); pw.w = cvtpk(sc[gq][1][2], sc[gq][1][3]);
                    const bf16x8 pf = __builtin_bit_cast(bf16x8, pw);
#pragma unroll
                    for (int dt = 0; dt < 4; ++dt) o2[qd][dt] = mfma16(*(const LAS bf16x8*)(st + vfo + gq * 64 * VROW + 16 * dt * VROW), pf, o2[qd][dt]);
                }
            }
          }
            return false; });
#pragma unroll
        for (int qd = 0; qd < 2; ++qd) {
            float lt = xadd16(l2[qd]); lt = xadd32(lt);
            const float inv2 = lt > 0.f ? gs[qd] / lt : 0.f;
#pragma unroll
            for (int dt = 0; dt < 4; ++dt)
#pragma unroll
                for (int r = 0; r < 4; ++r) xch[(16 * qd + n16) * XLD + 16 * dt + 4 * kq + r] = inv2 * o2[qd][dt][r];
        }
        asm volatile("s_waitcnt lgkmcnt(0)" ::: "memory"); __builtin_amdgcn_wave_barrier();
    }
    { bf16_t* O = WSP(bf16_t, WS_O) + (size_t)t * 1024 + g * 256 + hh * 64;
#pragma unroll
      for (int d0 = 0; d0 < 2; ++d0)
#pragma unroll
        for (int g4 = 0; g4 < 4; ++g4) { const f32x4 a = *(const f32x4*)(XG + 32 * d0 + 8 * g4 + 4 * hi); float v[4];
#pragma unroll
            for (int q = 0; q < 4; ++q) v[q] = a[q] + xch[i * XLD + 32 * d0 + 8 * g4 + 4 * hi + q];
            u32x2 wv; wv.x = cvtpk(v[0], v[1]); wv.y = cvtpk(v[2], v[3]); *(u32x2*)(O + 32 * d0 + 8 * g4 + 4 * hi) = wv; } }
    asm volatile("s_waitcnt lgkmcnt(0)" ::: "memory"); __builtin_amdgcn_wave_barrier();
}

#endif
constexpr int NT_FOX = 8 * 64, NT_NSA = 2 * 256, NT_ATT = NT_FOX + NT_NSA;
DI void phase_attn(Frame& F, const Params& P, int rep) {
    LAS float* tball = (LAS float*)(F.lds + AL_TB);
    for (int q = F.tid; q < 2 * 4 * 129; q += NTHREADS) { const int dist = q % 129, gh = q / 129;
        int bucket; if (dist < 16) bucket = dist; else { const float rr = logf((float)dist / 16.f) / 2.0794415416798357f * 16.f; const int big = 16 + (int)rr; bucket = big < 31 ? big : 31; }
        tball[gh * TB_LD + dist] = P.in[6][bucket * 8 + gh] * LOG2E; }
    LAS float* pslc = (LAS float*)(F.lds + AL_PSLC + F.wave * AW_PSLC); LAS unsigned* selm = (LAS unsigned*)(F.lds + AL_SELM + F.wave * AW_SEL);
    volatile LAS int* tslot = (volatile LAS int*)(F.lds + AL_FLAG + 64);
    bool first = true;
    for (;;) {
        __syncthreads();
        if (F.tid == 0) *tslot = first ? F.bid : F.G + (int)atomicAdd(F.ctl + CW_QATT + 64 * rep, 1u);
        first = false;
        __syncthreads();
        const int task = __builtin_amdgcn_readfirstlane(*tslot);
        if (task >= (BMS ? NT_NSA : NT_ATT)) break;
        if (task < NT_NSA) { const int g = task & 1, tt = 255 - (task >> 1); nsa_task(F, g, tt * 64, pslc, selm, tball + g * 4 * TB_LD); }
        else { const int q = task - NT_NSA; fox_task(F, 7 - (q >> 6), 63 - (q & 63)); }
    }
}

#if BMS
DI void phase_bms_sort(Frame& F, const Params& P) {
    LAS unsigned* masks = (LAS unsigned*)F.lds;
    LAS int* pw = (LAS int*)(F.lds + 2048);
    LAS int* wsum = (LAS int*)(F.lds + 4096);
    const int* hist = WSP(int, WS_HISTB);
    for (int item = F.bid; item < 512; item += F.G) { const int g = item >> 8, T = item & 255;
        __syncthreads();
        masks[F.tid] = WSP(unsigned, WS_SELMG)[((size_t)(T * 64 + (F.tid >> 3)) * 2 + g) * 8 + (F.tid & 7)];
        int tot = 0, off = 0;
        if (F.tid < 256) { const int* hc = hist + (size_t)g * 256 * 256 + F.tid;
#pragma unroll 8
            for (int b = 0; b < 256; ++b) { const int hv = hc[b * 256]; tot += hv; off += (b < T) ? hv : 0; } }
        const int nu = (tot + 63) >> 6; int inc = nu;
#pragma unroll
        for (int o = 1; o < 64; o <<= 1) { const int up = __shfl_up(inc, o); if (F.lane >= o) inc += up; }
        if (F.lane == 63 && F.wave < 4) wsum[F.wave] = inc;
        __syncthreads();
        { const int tok = F.tid >> 3, w = F.tid & 7; int c = 0;
#pragma unroll
          for (int q = 0; q < 8; ++q) c += (q < w) ? __builtin_popcount(masks[tok * 8 + q]) : 0;
          pw[F.tid] = c; }
        const int w0 = wsum[0], w1 = wsum[1], w2 = wsum[2], w3 = wsum[3];
        const int ub_ = inc - nu + (F.wave > 0 ? w0 : 0) + (F.wave > 1 ? w1 : 0) + (F.wave > 2 ? w2 : 0);
        __syncthreads();
        if (F.tid < 256) { const int j = F.tid;
            if (T == 0) { int* ut = WSP(int, WS_UT) + g * (BMS_MAXU + 8); if (j == 0) ut[0] = w0 + w1 + w2 + w3; for (int c = 0; c < nu; ++c) ut[1 + ub_ + c] = j | (c << 16); }
            int* tk = WSP(int, WS_TOKL) + (size_t)g * BMS_MAXU * 64 + (size_t)ub_ * 64 + off; int run = 0;
            const unsigned bitm = 1u << (j & 31), lowm = bitm - 1u;
            for (int tok = 0; tok < 64; ++tok) { const unsigned wv = masks[tok * 8 + (j >> 5)];
                if (wv & bitm) { const int slot = pw[tok * 8 + (j >> 5)] + __builtin_popcount(wv & lowm); tk[run] = (T * 64 + tok) | (slot << 16); ++run; } } }
    }
    __syncthreads();
}

DI void lds_v_T(bf16x8 (&vf)[4], const LAS unsigned char* st, int sub, int lane) {
    const LAS unsigned char* p = st + ST_V + sub * 64 * VROW + 2 * (lane & 31) * VROW + 16 * (lane >> 5);
#pragma unroll
    for (int d0 = 0; d0 < 2; ++d0)
#pragma unroll
        for (int s2 = 0; s2 < 2; ++s2) vf[d0 * 2 + s2] = *(const LAS bf16x8*)(p + d0 * VROW + 32 * s2);
}
DI void pv32f_T(f32x16 (&o)[2], const f32x16& p, const bf16x8 (&vf)[4]) {
    bf16x8 pf[2];
#pragma unroll
    for (int s2 = 0; s2 < 2; ++s2) { u32x4 w; w.x = cvtpk(p[8 * s2 + 0], p[8 * s2 + 1]); w.y = cvtpk(p[8 * s2 + 2], p[8 * s2 + 3]); w.z = cvtpk(p[8 * s2 + 4], p[8 * s2 + 5]); w.w = cvtpk(p[8 * s2 + 6], p[8 * s2 + 7]); pf[s2] = __builtin_bit_cast(bf16x8, w); }
#pragma unroll
    for (int d0 = 0; d0 < 2; ++d0)
#pragma unroll
        for (int s2 = 0; s2 < 2; ++s2) o[d0] = mfma32(pf[s2], vf[d0 * 2 + s2], o[d0]);
}
constexpr int BMS_WGU = 36;
constexpr int BL_CODE = 0, BL_ENT = 256;
static_assert(BL_ENT + BMS_WGU * 256 <= AL_STAGE && 2 * BMS_MAXU <= 256 * (BMS_WGU - 2), "block-major unit lists");
DI void phase_bms_attn(Frame& F, const Params& P) {
    const int lane = F.lane, i = lane & 31, hi = lane >> 5, tl = i >> 2, hh = i & 3;
    LAS float* tball = (LAS float*)(F.lds + AL_TB);
    LAS int* lcode = (LAS int*)(F.lds + BL_CODE); LAS int* lent = (LAS int*)(F.lds + BL_ENT);
    __syncthreads();
    for (int q = F.tid; q < 2 * 4 * 129; q += NTHREADS) { const int dist = q % 129, gh = q / 129;
        int bucket; if (dist < 16) bucket = dist; else { const float rr = logf((float)dist / 16.f) / 2.0794415416798357f * 16.f; const int big = 16 + (int)rr; bucket = big < 31 ? big : 31; }
        tball[gh * TB_LD + dist] = P.in[6][bucket * 8 + gh] * LOG2E; }
    const int* ut = WSP(int, WS_UT); const int U0 = ut[0], U1 = ut[BMS_MAXU + 8], UT_ = U0 + U1;
    const int u_lo = (int)(((long)F.bid * UT_) / F.G), u_hi = (int)(((long)(F.bid + 1) * UT_) / F.G), nu = u_hi - u_lo;
    for (int q = F.tid; q < nu * 64; q += NTHREADS) { const int u = u_lo + (q >> 6), g = u >= U0, ug = g ? u - U0 : u; lent[q] = WSP(int, WS_TOKL)[(size_t)g * BMS_MAXU * 64 + (size_t)ug * 64 + (q & 63)]; }
    for (int q = F.tid; q < nu; q += NTHREADS) { const int u = u_lo + q, g = u >= U0, ug = g ? u - U0 : u; lcode[q] = g * 256 + (ut[g * (BMS_MAXU + 8) + 1 + ug] & 0xffff); }
    __syncthreads();
    LAS unsigned char* st = F.lds + AL_STAGE;
    const int tid = F.tid, krow = tid >> 3, kc = tid & 7, vsub = tid >> 8, vd = (tid & 255) >> 2, vc = tid & 3;
    auto ent = [&](int k) -> int { return lent[k * 64 + 8 * F.wave + tl]; };
    auto loadq = [&](int k, bf16x8 (&q)[4]) { const int e = ent(k), g = lcode[k] >> 8; const int t = e < 0 ? 0 : (e & 0xffff);
        const bf16_t* Q = WSP(bf16_t, WS_QN) + (size_t)(g * 4 + hh) * S * 64 + (size_t)t * 64 + 8 * hi;
#pragma unroll
        for (int ks = 0; ks < 4; ++ks) q[ks] = *(const bf16x8*)(Q + 16 * ks); };
    auto loadkv = [&](int gj, u32x4& rk, u32x4& rv) { const int g = gj >> 8, j = gj & 255;
        rk = *(const u32x4*)(WSP(bf16_t, WS_SK) + (size_t)g * S * 64 + (size_t)(64 * j + krow) * 64 + kc * 8); rv = *(const u32x4*)(WSP(bf16_t, WS_SVT) + (size_t)g * 64 * S + (size_t)(2 * j) * 2048 + tid * 8); };
    bf16x8 qr[3][4];
    if (nu > 0) loadq(0, qr[0]);
    if (nu > 1) loadq(1, qr[1]);
    int prev = -1; bool havepf = false; u32x4 rk, rv;
    for (int k0 = 0; k0 < nu; k0 += 3) {
#pragma unroll
      for (int d = 0; d < 3; ++d) { const int k = k0 + d; if (k >= nu) break;
        const int gj = __builtin_amdgcn_readfirstlane(lcode[k]); const int g = gj >> 8, j = gj & 255;
        if (k + 2 < nu) loadq(k + 2, qr[(d + 2) % 3]);
        if (gj != prev) {
            if (!havepf) loadkv(gj, rk, rv);
            __syncthreads();
            *(LAS u32x4*)(st + krow * KROW + kc * 16) = rk; *(LAS u32x4*)(st + ST_V + vsub * 64 * VROW + vd * VROW + vc * 16) = rv;
            __syncthreads(); prev = gj; havepf = false; }
        if (k + 1 < nu) { const int nx = __builtin_amdgcn_readfirstlane(lcode[k + 1]); if (nx != gj) { loadkv(nx, rk, rv); havepf = true; } }
        const int e_cur = ent(k);
        const bool valid = e_cur >= 0; const int t = valid ? (e_cur & 0xffff) : 0, slot = valid ? (e_cur >> 16) : 0;
        const LAS float* tb = tball + (g * 4 + hh) * TB_LD;
        int tmin = valid ? t : 0x7fffffff; tmin = wave_min_ui(tmin);
        const bool far = (tmin - (64 * j + 63) >= 128);
        f32x16 sv[2];
#pragma unroll
        for (int sub = 0; sub < 2; ++sub) { bf16x8 kf[4]; lds_k(kf, st, sub, lane); sv[sub] = qk32f(qr[d], kf);
            if (!far) t5_near(sv[sub], tb, t, 1, 64 * j + 32 * sub, hi, 1 << 30); }
        const float mx = xmax32(fmaxf(max16(sv[0]), max16(sv[1])));
        const float mu = (mx == NEG_INF) ? 0.f : mx;
        float l = 0.f; f32x16 o[2];
#pragma unroll
        for (int r = 0; r < 16; ++r) { o[0][r] = 0.f; o[1][r] = 0.f; }
#pragma unroll
        for (int sub = 0; sub < 2; ++sub) { exp16(sv[sub], mu, l); bf16x8 vf[4]; lds_v_T(vf, st, sub, lane); pv32f_T(o, sv[sub], vf); }
        l = xadd32(l);
        if (valid && hi == 0) *(f32x2*)(WSP(float, WS_PML) + ((((size_t)t * 2 + g) * 16 + slot) * 4 + hh) * 2) = (f32x2){far ? mx + tb[128] : mx, l};
        bf16_t* pbase = (g ? WSP(bf16_t, WS_X1) : (bf16_t*)P.out) + 2 * i;
#pragma unroll
        for (int rg = 0; rg < 4; ++rg) { const int e2 = lent[k * 64 + 8 * F.wave + 2 * rg + hi];
            if (e2 >= 0) { bf16_t* po = pbase + ((size_t)(e2 & 0xffff) * 16 + (e2 >> 16)) * 256;
#pragma unroll
                for (int h2 = 0; h2 < 4; ++h2) __builtin_nontemporal_store(cvtpk(o[0][4 * rg + h2], o[1][4 * rg + h2]), (unsigned*)(po + h2 * 64)); } }
      }
    }
    { volatile LAS int* tslot = (volatile LAS int*)(F.lds + AL_FLAG + 64);
      for (;;) {
        __syncthreads();
        if (F.tid == 0) *tslot = (int)atomicAdd(F.ctl + CW_QATT + 64, 1u);
        __syncthreads();
        const int q = __builtin_amdgcn_readfirstlane(*tslot);
        if (q >= NT_FOX) break;
        fox_task(F, 7 - (q >> 6), 63 - (q & 63));
      } }
    __syncthreads();
}

DI void phase_bms_combine(Frame& F, const Params& P) {
    const int lane = F.lane, gw = F.bid * NWAVES + F.wave, NGW = F.G * NWAVES;
    const int slotL = lane >> 2, hhL = lane & 3;
    const int sub = lane & 7, hhO = (lane >> 3) & 3, par = lane >> 5;
    struct Item { u32x4 pv[8]; f32x2 ml; float gate; f32x4 x0, x1; };
    auto load = [&](int it, Item& I) __attribute__((always_inline)) { const int t = it >> 1, g = it & 1; const int cur = t >> 6, nsel = cur < 15 ? cur + 1 : 16;
        const bf16_t* po = (g ? WSP(bf16_t, WS_X1) : (const bf16_t*)P.out) + (size_t)t * 4096 + hhO * 64 + 8 * sub;
#pragma unroll
        for (int k = 0; k < 8; ++k) { const int slot = 2 * k + par; I.pv[k] = __builtin_nontemporal_load((const u32x4*)(po + (slot < nsel ? slot : 0) * 256)); }
        I.ml = *(const f32x2*)(WSP(float, WS_PML) + ((size_t)it * 64 + lane) * 2);
        I.gate = WSP(float, WS_GN)[(size_t)t * 24 + g * 12 + hhL * 3 + 1];
        const float* XG = WSP(float, WS_U) + (size_t)t * 512 + g * 256 + hhO * 64 + 8 * sub;
        I.x0 = (f32x4){0.f, 0.f, 0.f, 0.f}; I.x1 = I.x0; if (par == 0) { I.x0 = *(const f32x4*)XG; I.x1 = *(const f32x4*)(XG + 4); } };
    auto compute = [&](int it, const Item& I) __attribute__((always_inline)) { const int t = it >> 1, g = it & 1; const int cur = t >> 6, nsel = cur < 15 ? cur + 1 : 16;
        const bool ok = slotL < nsel;
        const float m = ok ? I.ml[0] : NEG_INF;
        float M = m; M = fmaxf(M, dppf<0x124>(M)); M = fmaxf(M, dppf<0x128>(M)); M = xmax16(M); M = xmax32(M);
        const float wgt = (m == NEG_INF) ? 0.f : fexp2(m - M);
        float den = ok ? wgt * I.ml[1] : 0.f; den += dppf<0x124>(den); den += dppf<0x128>(den); den = xadd16(den); den = xadd32(den);
        const float sc = (den > 0.f) ? wgt * I.gate / den : 0.f;
        float acc[8];
#pragma unroll
        for (int q = 0; q < 8; ++q) acc[q] = 0.f;
#pragma unroll
        for (int k = 0; k < 8; ++k) { const int slot = 2 * k + par;
            const float w = __int_as_float(__builtin_amdgcn_ds_bpermute(4 * (slot * 4 + hhO), __float_as_int(sc)));
#pragma unroll
            for (int q = 0; q < 4; ++q) { acc[2 * q] += w * __builtin_bit_cast(float, I.pv[k][q] << 16); acc[2 * q + 1] += w * __builtin_bit_cast(float, I.pv[k][q] & 0xffff0000u); } }
#pragma unroll
        for (int q = 0; q < 8; ++q) acc[q] = xadd32(acc[q]);
        if (par == 0) { u32x4 wv; wv.x = cvtpk(I.x0[0] + acc[0], I.x0[1] + acc[1]); wv.y = cvtpk(I.x0[2] + acc[2], I.x0[3] + acc[3]); wv.z = cvtpk(I.x1[0] + acc[4], I.x1[1] + acc[5]); wv.w = cvtpk(I.x1[2] + acc[6], I.x1[3] + acc[7]);
            *(u32x4*)(WSP(bf16_t, WS_O) + (size_t)t * 1024 + g * 256 + hhO * 64 + 8 * sub) = wv; } };
    for (int it = gw; it < 2 * S; it += 4 * NGW) { Item A, B, C, D2; const bool h1 = it + NGW < 2 * S, h2 = it + 2 * NGW < 2 * S, h3 = it + 3 * NGW < 2 * S;
        load(it, A); if (h1) load(it + NGW, B); if (h2) load(it + 2 * NGW, C); if (h3) load(it + 3 * NGW, D2);
        compute(it, A); if (h1) compute(it + NGW, B); if (h2) compute(it + 2 * NGW, C); if (h3) compute(it + 3 * NGW, D2); }
}
#endif

DI void phase_lnmid_route(Frame& F, const Params& P, int rep) {
    const int lane = F.lane, w = F.wave;
    const float* XI = P.in[0]; const bf16_t* YB = WSP(bf16_t, WS_X1); bf16_t* X1 = WSP(bf16_t, WS_X1); bf16_t* U2 = WSP(bf16_t, WS_U); bf16_t* U2L = WSP(bf16_t, WS_U2L); const float* mod = WSP(float, WS_MOD);
    const float* ln1g = P.in[14]; const float* ln1b = P.in[15]; const float* brg = P.in[17]; const float* bre = P.in[19];
    int* toke = WSP(int, WS_TOKE); int* tokp = WSP(int, WS_TOKP); float* tokw = WSP(float, WS_TOKW);
    const bf16_t* WTh = WSP(bf16_t, WS_WRT); const bf16_t* WTl = WTh + 80 * 2048;
    LAS float* part = (LAS float*)F.lds;
    LAS unsigned* lhist = (LAS unsigned*)(F.lds + 4 * 64 * 84 * 4);
    constexpr int PLD = 84;
    for (int blk = F.bid; blk < S / 64; blk += F.G) {
        const int base = blk * 64;
        if (F.tid < 64) lhist[F.tid] = 0u;
        { f32x4 vn[8];
          u32x2 yn[8];
          { const f32x4* rr = (const f32x4*)(XI + (size_t)(base + 8 * w) * D) + lane; const u32x2* yr = (const u32x2*)(YB + (size_t)(base + 8 * w) * D) + lane;
#pragma unroll
            for (int j = 0; j < 8; ++j) { vn[j] = rr[64 * j]; yn[j] = yr[64 * j]; } }
          for (int i8 = 0; i8 < (rep ? 0 : 8); ++i8) { const int m = base + 8 * w + i8;
            u32x2* xr = (u32x2*)(X1 + (size_t)m * D) + lane;
            f32x4 v[8]; float s = 0.f;
#pragma unroll
            for (int j = 0; j < 8; ++j) { const u32x2 yw = yn[j];
                v[j][0] = vn[j][0] * ALPHA + __builtin_bit_cast(float, yw.x << 16); v[j][1] = vn[j][1] * ALPHA + __builtin_bit_cast(float, yw.x & 0xffff0000u);
                v[j][2] = vn[j][2] * ALPHA + __builtin_bit_cast(float, yw.y << 16); v[j][3] = vn[j][3] * ALPHA + __builtin_bit_cast(float, yw.y & 0xffff0000u);
                s += (v[j][0] + v[j][1]) + (v[j][2] + v[j][3]); }
            if (i8 < 7) { const f32x4* rr = (const f32x4*)(XI + (size_t)(m + 1) * D) + lane; const u32x2* yr = (const u32x2*)(YB + (size_t)(m + 1) * D) + lane;
#pragma unroll
                for (int j = 0; j < 8; ++j) { vn[j] = rr[64 * j]; yn[j] = yr[64 * j]; } }
            float mean = wave_sum(s) * (1.f / D), s2 = 0.f;
#pragma unroll
            for (int j = 0; j < 8; ++j) { v[j] = v[j] - mean; s2 += (v[j][0] * v[j][0] + v[j][1] * v[j][1]) + (v[j][2] * v[j][2] + v[j][3] * v[j][3]); }
            float rstd = 1.f / sqrtf(wave_sum(s2) * (1.f / D) + LN_EPS);
            s = 0.f;
#pragma unroll
            for (int j = 0; j < 8; ++j) { const int col = 4 * lane + 256 * j; v[j] = v[j] * rstd * *(const f32x4*)(ln1g + col) + *(const f32x4*)(ln1b + col); { u32x2 xw; xw.x = cvtpk(v[j][0], v[j][1]); xw.y = cvtpk(v[j][2], v[j][3]); xr[64 * j] = xw; } s += (v[j][0] + v[j][1]) + (v[j][2] + v[j][3]); }
            mean = wave_sum(s) * (1.f / D); s2 = 0.f;
#pragma unroll
            for (int j = 0; j < 8; ++j) { v[j] = v[j] - mean; s2 += (v[j][0] * v[j][0] + v[j][1] * v[j][1]) + (v[j][2] * v[j][2] + v[j][3] * v[j][3]); }
            rstd = 1.f / sqrtf(wave_sum(s2) * (1.f / D) + LN_EPS);
            u32x2* oh = (u32x2*)(U2 + (size_t)m * D) + lane; u32x2* ol = (u32x2*)(U2L + (size_t)m * D) + lane;
#pragma unroll
            for (int j = 0; j < 8; ++j) { const int col = 4 * lane + 256 * j; const f32x4 y = v[j] * rstd * (*(const f32x4*)(mod + 4 * D + col) + 1.0f) + *(const f32x4*)(mod + 3 * D + col);
                u32x2 wh; wh.x = cvtpk(y[0], y[1]); wh.y = cvtpk(y[2], y[3]); oh[64 * j] = wh;
                const float r0 = y[0] - __builtin_bit_cast(float, wh.x << 16), r1 = y[1] - __builtin_bit_cast(float, wh.x & 0xffff0000u), r2 = y[2] - __builtin_bit_cast(float, wh.y << 16), r3 = y[3] - __builtin_bit_cast(float, wh.y & 0xffff0000u);
                u32x2 wl; wl.x = cvtpk(r0, r1); wl.y = cvtpk(r2, r3); ol[64 * j] = wl; }
          } }
        asm volatile("s_waitcnt vmcnt(0)" ::: "memory");
        __syncthreads();
        { const int n16 = lane & 15, kq = lane >> 4;
          const bf16_t* uh = U2 + (size_t)(base + n16) * D + w * 256 + 8 * kq; const bf16_t* ul = U2L + (size_t)(base + n16) * D + w * 256 + 8 * kq;
          const bf16_t* wh0 = WTh + (size_t)n16 * 2048 + w * 256 + 8 * kq; const bf16_t* wl0 = WTl + (size_t)n16 * 2048 + w * 256 + 8 * kq;
          f32x4 acc[4][5];
#pragma unroll
          for (int rt = 0; rt < 4; ++rt)
#pragma unroll
              for (int nt = 0; nt < 5; ++nt) acc[rt][nt] = (f32x4){0.f, 0.f, 0.f, 0.f};
#pragma unroll 1
          for (int ks = 0; ks < 8; ++ks) {
              bf16x8 a_h[4], a_l[4], b_h[5], b_l[5];
#pragma unroll
              for (int rt = 0; rt < 4; ++rt) { a_h[rt] = *(const bf16x8*)(uh + (size_t)rt * 16 * D + 32 * ks); a_l[rt] = *(const bf16x8*)(ul + (size_t)rt * 16 * D + 32 * ks); }
#pragma unroll
              for (int nt = 0; nt < 5; ++nt) { b_h[nt] = *(const bf16x8*)(wh0 + (size_t)nt * 16 * 2048 + 32 * ks); b_l[nt] = *(const bf16x8*)(wl0 + (size_t)nt * 16 * 2048 + 32 * ks); }
#pragma unroll
              for (int rt = 0; rt < 4; ++rt)
#pragma unroll
                  for (int nt = 0; nt < 5; ++nt) { acc[rt][nt] = mfma16(b_h[nt], a_h[rt], acc[rt][nt]); acc[rt][nt] = mfma16(b_l[nt], a_h[rt], acc[rt][nt]); acc[rt][nt] = mfma16(b_h[nt], a_l[rt], acc[rt][nt]); }
          }
          LAS float* slot = part + (w & 3) * 64 * PLD;
          if (w < 4) {
#pragma unroll
              for (int rt = 0; rt < 4; ++rt)
#pragma unroll
                  for (int nt = 0; nt < 5; ++nt)
#pragma unroll
                      for (int r = 0; r < 4; ++r) slot[(16 * rt + n16) * PLD + 16 * nt + 4 * kq + r] = acc[rt][nt][r]; }
          __syncthreads();
          if (w >= 4) {
#pragma unroll
              for (int rt = 0; rt < 4; ++rt)
#pragma unroll
                  for (int nt = 0; nt < 5; ++nt)
#pragma unroll
                      for (int r = 0; r < 4; ++r) slot[(16 * rt + n16) * PLD + 16 * nt + 4 * kq + r] += acc[rt][nt][r]; }
        }
        __syncthreads();
        if (F.tid < 64) { const int row = F.tid, m = base + row; const LAS float* p0 = part + row * PLD;
            float lg[8]; int grp = 0; float gmax = NEG_INF;
#pragma unroll
            for (int e = 0; e < 8; ++e) { lg[e] = ((p0[e] + p0[64 * PLD + e]) + (p0[2 * 64 * PLD + e] + p0[3 * 64 * PLD + e])) + brg[e]; if (lg[e] > gmax) { gmax = lg[e]; grp = e; } }
            float gden = 0.f;
#pragma unroll
            for (int e = 0; e < 8; ++e) gden += __expf(lg[e] - gmax);
            const float pgrp = 1.f / gden;
            int e0 = 0; float m0 = NEG_INF, le[8];
#pragma unroll
            for (int e = 0; e < 8; ++e) { { const int c = 8 + grp * 8 + e; le[e] = ((p0[c] + p0[64 * PLD + c]) + (p0[2 * 64 * PLD + c] + p0[3 * 64 * PLD + c])) + bre[grp * 8 + e]; } if (le[e] > m0) { m0 = le[e]; e0 = e; } }
            int e1 = 0; float m1 = NEG_INF;
#pragma unroll
            for (int e = 0; e < 8; ++e) if (e != e0 && le[e] > m1) { m1 = le[e]; e1 = e; }
            const float r1 = __expf(m1 - m0); const float w0 = pgrp / (1.f + r1), w1 = pgrp * r1 / (1.f + r1);
            const int ea = grp * 8 + e0, eb = grp * 8 + e1;
            const int pa = (int)__hip_atomic_fetch_add(lhist + ea, 1u, __ATOMIC_RELAXED, __HIP_MEMORY_SCOPE_WORKGROUP), pb = (int)__hip_atomic_fetch_add(lhist + eb, 1u, __ATOMIC_RELAXED, __HIP_MEMORY_SCOPE_WORKGROUP);
            toke[2 * m] = ea; toke[2 * m + 1] = eb; tokp[2 * m] = pa; tokp[2 * m + 1] = pb; tokw[2 * m] = w0; tokw[2 * m + 1] = w1;
        }
        __syncthreads();
        if (F.tid < 64) WSP(int, WS_HIST)[blk * 64 + F.tid] = (int)lhist[F.tid];
        __syncthreads();
    }
}

DI void phase_scatter(Frame& F, const Params& P) {
    LAS int* base = (LAS int*)F.lds;
    LAS int* tot = base + 64; LAS int* off = base + 128;
    LAS int* ptot = base + 192; LAS int* poff = base + 192 + 512;
    const int* hist = WSP(int, WS_HIST);
    const int* toke = WSP(int, WS_TOKE); const int* tokp = WSP(int, WS_TOKP); const float* tokw = WSP(float, WS_TOKW);
    int* rt = WSP(int, WS_ROWTOK); int* rd = WSP(int, WS_ROWDST); float* rw = WSP(float, WS_ROWW);
    for (int blk = F.bid; blk < S / 64; blk += F.G) {
        { const int e = F.tid & 63, part = F.tid >> 6; int t = 0, o = 0;
#pragma unroll 8
          for (int b = part * 32; b < part * 32 + 32; ++b) { const int hv = hist[b * 64 + e]; t += hv; o += (b < blk) ? hv : 0; }
          ptot[part * 64 + e] = t; poff[part * 64 + e] = o; }
        __syncthreads();
        if (F.tid < 64) { int t = 0, o = 0;
#pragma unroll
            for (int p = 0; p < 8; ++p) { t += ptot[p * 64 + F.tid]; o += poff[p * 64 + F.tid]; }
            tot[F.tid] = t; off[F.tid] = o; }
        __syncthreads();
        if (F.tid == 0) { int run = 0; int* pane = WSP(int, WS_PANE); int np = 0;
            for (int e = 0; e < NEXP; ++e) { const int c = tot[e]; base[e] = run; const int npan = (c + 255) >> 8;
                if (blk == 0) for (int q = 0; q < npan; ++q) pane[1 + np + q] = e;
                np += npan; run += npan * 256; }
            if (blk == 0) pane[0] = np; }
        __syncthreads();
        if (F.tid < 128) { const int i = blk * 128 + F.tid; const int e = toke[i]; const int row = base[e] + off[e] + tokp[i]; rt[row] = i >> 1; rd[row] = i; rw[row] = tokw[i]; }
        __syncthreads();
    }
}

DI void phase_final(Frame& F, const Params& P) {
    const int lane = F.lane, gw = F.bid * NWAVES + F.wave, NGW = F.G * NWAVES;
    const bf16_t* X1 = WSP(bf16_t, WS_X1); const bf16_t* Y2 = WSP(bf16_t, WS_Y2); const float* mod = WSP(float, WS_MOD);
    const float* g2p = mod + 5 * D; const float* lg = P.in[23]; const float* lb = P.in[24];
    for (int m = gw; m < S; m += NGW) {
        const u32x2* xr = (const u32x2*)(X1 + (size_t)m * D) + lane;
        const u32x2* ya = (const u32x2*)(Y2 + (size_t)(2 * m) * D) + lane; const u32x2* yb = (const u32x2*)(Y2 + (size_t)(2 * m + 1) * D) + lane;
        f32x4 v[8]; float s = 0.f;
#pragma unroll
        for (int j = 0; j < 8; ++j) { const int col = 4 * lane + 256 * j; const u32x2 a = ya[64 * j], b = yb[64 * j];
            f32x4 y; y[0] = __builtin_bit_cast(float, a.x << 16) + __builtin_bit_cast(float, b.x << 16); y[1] = __builtin_bit_cast(float, a.x & 0xffff0000u) + __builtin_bit_cast(float, b.x & 0xffff0000u);
            y[2] = __builtin_bit_cast(float, a.y << 16) + __builtin_bit_cast(float, b.y << 16); y[3] = __builtin_bit_cast(float, a.y & 0xffff0000u) + __builtin_bit_cast(float, b.y & 0xffff0000u);
            const u32x2 xw = xr[64 * j]; const f32x4 x1v = (f32x4){__builtin_bit_cast(float, xw.x << 16), __builtin_bit_cast(float, xw.x & 0xffff0000u), __builtin_bit_cast(float, xw.y << 16), __builtin_bit_cast(float, xw.y & 0xffff0000u)};
            v[j] = x1v * ALPHA + (*(const f32x4*)(g2p + col) + 1.0f) * y; s += (v[j][0] + v[j][1]) + (v[j][2] + v[j][3]); }
        const float mean = wave_sum(s) * (1.f / D); float s2 = 0.f;
#pragma unroll
        for (int j = 0; j < 8; ++j) { v[j] = v[j] - mean; s2 += (v[j][0] * v[j][0] + v[j][1] * v[j][1]) + (v[j][2] * v[j][2] + v[j][3] * v[j][3]); }
        const float rstd = 1.f / sqrtf(wave_sum(s2) * (1.f / D) + LN_EPS);
        f32x4* o = (f32x4*)(P.out + (size_t)m * D) + lane;
#pragma unroll
        for (int j = 0; j < 8; ++j) { const int col = 4 * lane + 256 * j; o[64 * j] = v[j] * rstd * *(const f32x4*)(lg + col) + *(const f32x4*)(lb + col); }
    }
}

constexpr int NPHASE = 14;
__global__ void __launch_bounds__(NTHREADS, 2) fwd_kernel(Params P) {
    extern __shared__ __attribute__((aligned(16))) unsigned char lds_raw[];
    Frame F;
    F.lds = (LAS unsigned char*)lds_raw; F.ws = P.ws; F.ctl = (unsigned*)(P.ws + WS_CTL);
    F.tid = threadIdx.x; F.lane = F.tid & 63; F.wave = __builtin_amdgcn_readfirstlane(F.tid >> 6); F.G = gridDim.x; F.bid = blockIdx.x;
    volatile LAS unsigned* misc = (volatile LAS unsigned*)(F.lds + LDS_MISC);
    if (F.tid < 16) misc[F.tid] = 0u;
    __syncthreads();
    const int lo = P.ph_lo, hi = P.ph_hi;
    XcdBarrier bar; bar.bar = F.ctl + CW_BAR; bar.x = 0; bar.st = nullptr;
    if (hi - lo > 1) bar = xcd_barrier_post(F.ctl + CW_BAR, misc + 8);
#ifndef PHMASK
#define PHMASK 0xffff
#endif
#define IN(k) (((PHMASK >> (k)) & 1) && lo <= (k) && (k) < hi)
#define RUN(k, ...) do { __VA_ARGS__; if (REPS(k) > 1) { __VA_ARGS__; } } while (0)
#define SEAM(k) do { if (IN(k) && IN((k) + 1)) xcd_barrier(bar); } while (0)
    LAS unsigned char* glds = F.lds;

    if (IN(0)) { RUN(0, phase_prologue<0>(F, P)); }
    SEAM(0);
    if (IN(1)) { RUN(1, phase_ln1(F, P)); }
    SEAM(1);
    if (IN(2)) {
        pg8::Gemm g{WSP(bf16_t, WS_U), WSP(bf16_t, WS_WINT), D, D, D, nullptr}; pg8::SchedGrid Sd; Sd.init(S, NIN, D, D, F.G, F.bid);
        EpiIn E{F.ws, P.in[5]};
        if (WCO) { const int a = F.bid & 7; using SR = pg8::SchedRange<pg8::SchedGrid>; SR r0{Sd, 0, a}, r1{Sd, a, 1 << 30};
            pg8::gemm_phase<EpiIn, SR, false>(glds, g, r0, E); __syncthreads();
            phase_prologue<1>(F, P); __syncthreads();
            pg8::gemm_phase<EpiIn, SR, false>(glds, g, r1, E); }
        else RUN(2, pg8::gemm_phase<EpiIn, pg8::SchedGrid, false>(glds, g, Sd, E));
    }
    SEAM(2);
    if (IN(3)) {
        pg8::Gemm g{WSP(bf16_t, WS_CKV), WSP(bf16_t, WS_W1T), 1024, 2048, 512, nullptr}; SchedCmp Sd{F.G, F.bid};
        EpiCmp E{WSP(float, WS_HC)};
        RUN(3, pg8::gemm_phase<EpiCmp, SchedCmp, false>(glds, g, Sd, E));
        if (F.bid >= 64) phase_cmp2_scan<2>(F, P);
    }
    SEAM(3);
    if (IN(4)) { RUN(4, phase_cmp2_scan<1>(F, P)); }
    SEAM(4);
    if (IN(5)) { { phase_attn(F, P, 0); if (REPS(5) > 1) phase_attn(F, P, 1); } }
#if BMS
    if (IN(5)) { if (hi - lo > 1) xcd_barrier(bar); phase_bms_sort(F, P); if (BMSREP & 1) phase_bms_sort(F, P);
                 if (hi - lo > 1) xcd_barrier(bar); phase_bms_attn(F, P); if (BMSREP & 2) phase_bms_attn(F, P);
                 if (hi - lo > 1) xcd_barrier(bar); phase_bms_combine(F, P); if (BMSREP & 4) phase_bms_combine(F, P); }
#endif
    SEAM(5);
    if (IN(6)) {
        pg8::Gemm g{WSP(bf16_t, WS_O), WSP(bf16_t, WS_BRT1), 1024, 512, 512, nullptr}; pg8::SchedGrid Sd; Sd.init(S, D, 1024, 512, F.G, F.bid);
        EpiMerge<1> E{WSP(bf16_t, WS_GM), WSP(bf16_t, WS_MG)};
        RUN(6, pg8::gemm_phase<EpiMerge<1>, pg8::SchedGrid, false>(glds, g, Sd, E));
    }
    if (IN(6) && IN(7)) __syncthreads();
    if (IN(7)) {
        pg8::Gemm g{WSP(bf16_t, WS_O) + 512, WSP(bf16_t, WS_BRT2), 1024, 512, 512, nullptr}; pg8::SchedGrid Sd; Sd.init(S, D, 1024, 512, F.G, F.bid);
        EpiMerge<2> E{WSP(bf16_t, WS_GM), WSP(bf16_t, WS_MG)};
        pg8::gemm_phase<EpiMerge<2>, pg8::SchedGrid, false>(glds, g, Sd, E);
    }
    SEAM(7);
    if (IN(8)) {
        pg8::Gemm g{WSP(bf16_t, WS_MG), WSP(bf16_t, WS_WOT), D, D, D, nullptr}; pg8::SchedGrid Sd; Sd.init(S, D, D, D, F.G, F.bid);
        EpiWo E{WSP(float, WS_MOD), WSP(bf16_t, WS_X1)};
        RUN(8, pg8::gemm_phase<EpiWo, pg8::SchedGrid, false>(glds, g, Sd, E));
    }
    SEAM(8);
    if (IN(9)) { phase_lnmid_route(F, P, 0); if (REPS(9) > 1) phase_lnmid_route(F, P, 1); }
    SEAM(9);
    if (IN(10)) { RUN(10, phase_scatter(F, P)); }
    SEAM(10);
    if (IN(11)) {
        LAS int* lpane = (LAS int*)(F.lds + 131072); if (F.tid < 256) lpane[F.tid] = WSP(int, WS_PANE)[F.tid]; __syncthreads();
        pg8::Gemm g{WSP(bf16_t, WS_U), WSP(bf16_t, WS_WGUT), D, D, D, WSP(int, WS_ROWTOK)}; SchedMoe Sd{lpane, 4, F.G, F.bid, 0, (size_t)256 * D * 2};
        EpiGU E{WSP(bf16_t, WS_H)};
        RUN(11, pg8::gemm_phase<EpiGU, SchedMoe, true>(glds, g, Sd, E));
    }
    SEAM(11);
    if (IN(12)) {
        LAS int* lpane = (LAS int*)(F.lds + 131072); if (F.tid < 256) lpane[F.tid] = WSP(int, WS_PANE)[F.tid]; __syncthreads();
        pg8::Gemm g{WSP(bf16_t, WS_H), WSP(bf16_t, WS_WDT), DEXP, DEXP, DEXP, nullptr}; SchedMoe Sd{lpane, 8, F.G, F.bid, (size_t)256 * DEXP * 2, (size_t)256 * DEXP * 2};
        EpiDown E{WSP(int, WS_ROWDST), WSP(float, WS_ROWW), WSP(bf16_t, WS_Y2)};
        RUN(12, pg8::gemm_phase<EpiDown, SchedMoe, false>(glds, g, Sd, E));
    }
    SEAM(12);
    if (IN(13)) { RUN(13, phase_final(F, P)); }
#undef IN
#undef SEAM
}

extern "C" void kernel_launch(void* const* d_in, const int* in_sizes, int n_in, void* d_out, int out_size, void* d_ws, size_t ws_size, hipStream_t stream) {
    static int grid = 0;
    if (grid == 0) {
        if (n_in != 25 || out_size != S * D || ws_size < WS_END) { fprintf(stderr, "kernel_launch: unexpected problem (n_in %d, out %d, ws %zu < %zu)\n", n_in, out_size, ws_size, (size_t)WS_END); grid = -1; return; }
        int dev = 0, cus = 0, per_cu = 0;
        if (hipGetDevice(&dev) != hipSuccess || hipDeviceGetAttribute(&cus, hipDeviceAttributeMultiprocessorCount, dev) != hipSuccess) { grid = -1; return; }
        if (hipFuncSetAttribute((const void*)fwd_kernel, hipFuncAttributeMaxDynamicSharedMemorySize, LDS_BYTES) != hipSuccess) { fprintf(stderr, "kernel_launch: hipFuncSetAttribute failed\n"); grid = -1; return; }
        if (hipOccupancyMaxActiveBlocksPerMultiprocessor(&per_cu, (const void*)fwd_kernel, NTHREADS, LDS_BYTES) != hipSuccess || per_cu < 1) fprintf(stderr, "kernel_launch: occupancy query says %d\n", per_cu);
        (void)hipGetLastError();
        grid = cus;
    }
    if (grid < 0) return;
    (void)hipMemsetAsync((char*)d_ws + WS_CTL, 0, CTL_BYTES, stream);
    Params p{};
    for (int i = 0; i < 25; ++i) p.in[i] = (const float*)d_in[i];
    p.out = (float*)d_out; p.ws = (unsigned char*)d_ws;
#if N_LAUNCH_SPLIT
    for (int k = 0; k < NPHASE; ++k) { p.ph_lo = k; p.ph_hi = k + 1; hipLaunchKernelGGL(fwd_kernel, dim3(grid), dim3(NTHREADS), LDS_BYTES, stream, p); }
#else
    p.ph_lo = 0; p.ph_hi = NPHASE; hipLaunchKernelGGL(fwd_kernel, dim3(grid), dim3(NTHREADS), LDS_BYTES, stream, p);
#endif
}
```

```cpp
#include <hip/hip_runtime.h>
#include <cstdint>
#include <cstdio>

#ifndef N_LAUNCH_SPLIT
#define N_LAUNCH_SPLIT 0
#endif

#ifndef PHREP
#define PHREP 0
#endif
#ifndef WCO
#define WCO 1
#endif
#ifndef BMSREP
#define BMSREP 0
#endif
#ifndef NSAP
#define NSAP 0
#endif
#ifndef BMS
#define BMS 1
#endif
#define REPS(k) (1 + ((PHREP >> (k)) & 1))
#define DI __device__ __forceinline__
#define LAS __attribute__((address_space(3)))
#define GAS __attribute__((address_space(1)))

typedef unsigned short bf16_t;
typedef short bf16x8 __attribute__((ext_vector_type(8)));
typedef float f32x4 __attribute__((ext_vector_type(4)));
typedef float f32x2 __attribute__((ext_vector_type(2)));
typedef float f32x16 __attribute__((ext_vector_type(16)));
typedef unsigned u32x4 __attribute__((ext_vector_type(4)));
typedef unsigned u32x2 __attribute__((ext_vector_type(2)));

constexpr int S = 16384, D = 2048, HD = 64;
constexpr int IN_COLS = 6944, OFF_GATE = 1280, OFF_FGT = 2840;
constexpr int NIN = 7168;
constexpr int NCMP = 1023, NCMP_P = 1024;
constexpr int NEXP = 64, DEXP = 512;
constexpr int MAXROWS = 2 * S + NEXP * 256;
constexpr int MAXPAN = MAXROWS / 256;
constexpr float LN_EPS = 1e-5f;
constexpr float LOG2E = 1.4426950408889634f;
constexpr float C2 = 0.125f * LOG2E;
constexpr float ALPHA = 1.189207115002721f;
constexpr int CKROWS = S + 64;
constexpr int NWAVES = 8, NTHREADS = 512;

constexpr size_t MiB = 1u << 20;
constexpr size_t al(size_t x) { return (x + 4095) & ~(size_t)4095; }
constexpr size_t WS_CTL = 0, CTL_BYTES = 1 * MiB;
constexpr size_t WS_MODP = WS_CTL + CTL_BYTES;
constexpr size_t WS_MOD = WS_MODP + al(32 * 12288 * 4);
constexpr size_t WS_PEWP = WS_MOD + al(12288 * 4);
constexpr size_t WS_BIASC = WS_PEWP + al(2 * 32 * 256 * 4);
constexpr size_t WS_WINT = WS_BIASC + al(2 * 256 * 4);
constexpr size_t WS_W1T = WS_WINT + al((size_t)NIN * D * 2);
constexpr size_t WS_BRT1 = WS_W1T + al(2 * 256 * 2048 * 2);
constexpr size_t WS_BRT2 = WS_BRT1 + al(2048 * 512 * 2);
constexpr size_t WS_WOT = WS_BRT2 + al(2048 * 512 * 2);
constexpr size_t WS_WGUT = WS_WOT + al((size_t)D * D * 2);
constexpr size_t WS_WDT = WS_WGUT + al((size_t)NEXP * 1024 * D * 2);
constexpr size_t WS_U = WS_WDT + al((size_t)NEXP * D * DEXP * 2);
constexpr size_t WS_QN = WS_U + al((size_t)S * D * 2);
constexpr size_t WS_CKV = WS_QN + al((size_t)8 * S * 64 * 2);
constexpr size_t WS_SK = WS_CKV + al((size_t)4 * CKROWS * 64 * 2);
constexpr size_t WS_SVT = WS_SK + al((size_t)2 * S * 64 * 2);
constexpr size_t WS_WK = WS_SVT + al((size_t)2 * S * 64 * 2);
constexpr size_t WS_WVT = WS_WK + al((size_t)2 * S * 64 * 2);
constexpr size_t WS_FQ = WS_WVT + al((size_t)2 * S * 64 * 2);
constexpr size_t WS_FK = WS_FQ + al((size_t)8 * S * 64 * 2);
constexpr size_t WS_FVT = WS_FK + al((size_t)8 * S * 64 * 2);
constexpr size_t WS_GM = WS_FVT + al((size_t)8 * S * 64 * 2);
constexpr size_t WS_GN = WS_GM + al((size_t)S * 4096 * 2);
constexpr size_t WS_LOGF = WS_GN + al((size_t)S * 24 * 4);
constexpr size_t WS_FC = WS_LOGF + al((size_t)S * 8 * 4);
constexpr size_t WS_HC = WS_FC + al((size_t)S * 8 * 4);
constexpr size_t WS_KC = WS_HC + al((size_t)4 * 4 * 1024 * 256 * 4);
constexpr size_t WS_VCT = WS_KC + al((size_t)2 * 1024 * 64 * 2);
constexpr size_t WS_O = WS_VCT + al((size_t)2 * 1024 * 64 * 2);
constexpr size_t WS_MG = WS_O + al((size_t)S * 1024 * 2);
constexpr size_t WS_X1 = WS_MG + al((size_t)S * D * 2);
constexpr size_t WS_TOKE = WS_X1 + al((size_t)S * D * 4);
constexpr size_t WS_TOKP = WS_TOKE + al((size_t)S * 2 * 4);
constexpr size_t WS_TOKW = WS_TOKP + al((size_t)S * 2 * 4);
constexpr size_t WS_ROWTOK = WS_TOKW + al((size_t)S * 2 * 4);
constexpr size_t WS_ROWDST = WS_ROWTOK + al((size_t)MAXROWS * 4);
constexpr size_t WS_ROWW = WS_ROWDST + al((size_t)MAXROWS * 4);
constexpr size_t WS_PANE = WS_ROWW + al((size_t)MAXROWS * 4);
constexpr size_t WS_KMAX = WS_PANE + al(1024 * 4);
constexpr size_t WS_HIST = WS_KMAX + al(256 * 8 * 4);
constexpr size_t WS_WRT = WS_HIST + al(256 * 64 * 4);
constexpr size_t WS_SELMG = WS_WRT + al(2 * 80 * 2048 * 2);
constexpr size_t WS_HISTB = WS_SELMG + al((size_t)S * 2 * 8 * 4);
constexpr int BMS_MAXU = 4352;
constexpr size_t WS_TOKL = WS_HISTB + al(2 * 256 * 256 * 4);
constexpr size_t WS_UT = WS_TOKL + al((size_t)2 * BMS_MAXU * 64 * 4);
constexpr size_t WS_END = WS_UT + al(2 * (BMS_MAXU + 8) * 4);
constexpr size_t WS_PML = WS_MG;
constexpr size_t WS_U2L = WS_MG;
constexpr size_t WS_H = WS_QN;
constexpr size_t WS_Y2 = WS_GM;
static_assert(WS_H + (size_t)MAXROWS * DEXP * 2 <= WS_FK, "H overlay");
static_assert(WS_Y2 + (size_t)2 * S * D * 2 <= WS_GN, "Y2 overlay");
static_assert(WS_END <= (size_t)1000 * MiB, "workspace budget");

constexpr int CW_BAR = 4096;
constexpr int CW_CNT = 16384;
constexpr int CW_QATT = 16384 + 256;
constexpr int CW_KMAX = 16384 + 512;

constexpr int LDS_BYTES = 147456;
constexpr int LDS_MISC = 144 * 1024 - 256;

typedef __bf16 bf16x2_t __attribute__((ext_vector_type(2)));
DI unsigned cvtpk(float lo, float hi) { f32x2 v = {lo, hi}; bf16x2_t b = __builtin_convertvector(v, bf16x2_t); return __builtin_bit_cast(unsigned, b); }
DI unsigned f2bf(float f) { unsigned u = __builtin_bit_cast(unsigned, f); return (u + 0x7fffu + ((u >> 16) & 1u)) >> 16; }
DI unsigned pk2(float lo, float hi) { return f2bf(lo) | (f2bf(hi) << 16); }
DI float bf2f(bf16_t b) { return __builtin_bit_cast(float, (unsigned)b << 16); }
DI float dpp_addf(float x, float y) { return x + y; }
template <int CTRL> DI float dpp_mov(float x) { return __builtin_bit_cast(float, __builtin_amdgcn_update_dpp(0, __builtin_bit_cast(int, x), CTRL, 0xF, 0xF, true)); }
DI float wave_sum(float v) {
    v += dpp_mov<0xB1>(v); v += dpp_mov<0x4E>(v); v += dpp_mov<0x124>(v); v += dpp_mov<0x128>(v);
    const float a = __int_as_float(__builtin_amdgcn_readlane(__float_as_int(v), 0)), b = __int_as_float(__builtin_amdgcn_readlane(__float_as_int(v), 16));
    const float c = __int_as_float(__builtin_amdgcn_readlane(__float_as_int(v), 32)), d = __int_as_float(__builtin_amdgcn_readlane(__float_as_int(v), 48));
    return (a + b) + (c + d);
}
DI float fexp2(float x) { return __builtin_amdgcn_exp2f(x); }
DI float sigmoidf_(float x) { return __builtin_amdgcn_rcpf(1.f + __builtin_amdgcn_exp2f(-1.4426950408889634f * x)); }
DI float logsigmoidf_(float x) { return fminf(x, 0.f) - log1pf(__expf(-fabsf(x))); }

#define XB_TMO      128
#define XB_XCNT(j)  (256  + 64 * (j))
#define XB_XSUB(j)  (1280 + 64 * (j))
#define XB_XGEN(j)  (2304 + 64 * (j))
#define XB_TOP      3328
#define XB_TOPGEN   3392
#define XCD_BAR_WORDS 3456
#define XB_SPIN_CAP (1u << 20)
DI unsigned xb_ld(unsigned* p)              { return __hip_atomic_load(p, __ATOMIC_RELAXED, __HIP_MEMORY_SCOPE_AGENT); }
DI unsigned xb_add(unsigned* p, unsigned v) { return __hip_atomic_fetch_add(p, v, __ATOMIC_RELAXED, __HIP_MEMORY_SCOPE_AGENT); }
DI unsigned xb_xcc_id() { return (unsigned)__builtin_amdgcn_s_getreg((3 << 11) | 20) & 0xFu; }
#define XB_SPIN(cond, bar) do { unsigned _sp = 0; while (cond) { __builtin_amdgcn_s_sleep(1); \
    if ((++_sp & 255u) == 0u) { if (xb_ld(&(bar)[XB_TMO])) break; if (_sp > XB_SPIN_CAP) { atomicAdd(&(bar)[XB_TMO], 1u); break; } } } } while (0)
struct XcdBarrier { unsigned* bar; unsigned x; volatile LAS unsigned* st; };
DI XcdBarrier xcd_barrier_post(unsigned* bar, volatile LAS unsigned* st) {
    XcdBarrier b; b.bar = bar; b.x = xb_xcc_id(); b.st = st;
    if (threadIdx.x == 0) (void)xb_add(&bar[XB_XCNT(b.x)], 1u);
    return b;
}
DI void xcd_barrier_complete(unsigned* bar, unsigned x, unsigned& nloc, unsigned& nx) {
    const unsigned G = gridDim.x * gridDim.y * gridDim.z;
    unsigned sum, cnt, mine, sp = 0u;
    for (;;) {
        sum = 0u; cnt = 0u; mine = 0u;
#pragma unroll
        for (unsigned j = 0; j < 16; ++j) { const unsigned c = xb_ld(&bar[XB_XCNT(j)]); sum += c; cnt += (c > 0u) ? 1u : 0u; mine = (j == x) ? c : mine; }
        if (sum == G) break;
        __builtin_amdgcn_s_sleep(1);
        if ((++sp & 255u) == 0u) { if (xb_ld(&bar[XB_TMO])) break; if (sp > XB_SPIN_CAP) { atomicAdd(&bar[XB_TMO], 1u); break; } }
    }
    nloc = mine > 0u ? mine : 1u; nx = cnt > 0u ? cnt : 1u;
}
DI void xcd_barrier(const XcdBarrier& b) {
    asm volatile("s_waitcnt vmcnt(0)" ::: "memory");
    __syncthreads();
    if (threadIdx.x == 0) {
        unsigned* bar = b.bar;
        __builtin_amdgcn_s_waitcnt(0);
        unsigned nloc = b.st[0], nx = b.st[1];
        if (nloc == 0u) { xcd_barrier_complete(bar, b.x, nloc, nx); b.st[0] = nloc; b.st[1] = nx; }
        const unsigned old = xb_add(&bar[XB_XSUB(b.x)], 1u);
        const unsigned gen = old / nloc;
        if (old + 1u == (gen + 1u) * nloc) {
            __builtin_amdgcn_fence(__ATOMIC_RELEASE, "agent");
            asm volatile("s_waitcnt vmcnt(0)" ::: "memory");
            const unsigned og = xb_add(&bar[XB_TOP], 1u);
            const unsigned tg = og / nx;
            if (og + 1u == (tg + 1u) * nx) xb_add(&bar[XB_TOPGEN], 1u);
            else XB_SPIN(xb_ld(&bar[XB_TOPGEN]) == tg, bar);
            __builtin_amdgcn_fence(__ATOMIC_ACQUIRE, "agent");
            xb_add(&bar[XB_XGEN(b.x)], 1u);
            asm volatile("s_waitcnt vmcnt(0)" ::: "memory");
        } else {
            XB_SPIN(xb_ld(&bar[XB_XGEN(b.x)]) == gen, bar);
            __builtin_amdgcn_fence(__ATOMIC_ACQUIRE, "agent");
            asm volatile("s_waitcnt vmcnt(0)" ::: "memory");
        }
    }
    __syncthreads();
}

namespace pg8 {
constexpr int BM = 256, BK = 64, HALF = 128, HTB = HALF * BK * 2, STAGE_BYTES = 8 * HTB, NXCD = 8, WGM = 8;
__host__ __device__ __forceinline__ int lds_byte(int r, int c) { const int st = (r >> 4) * 2 + (c >> 5), rr = r & 15, cc = c & 31, ob = rr * 64 + cc * 2; return st * 1024 + (ob ^ (((ob >> 9) & 1) << 5)); }
__host__ __device__ __forceinline__ void stage_rc(int b, int& R, int& C) { const int st = b / 1024, sb = b % 1024, swz = sb ^ (((sb >> 9) & 1) << 5); R = (st >> 1) * 16 + swz / 64; C = (st & 1) * 32 + (swz % 64) / 2; }
__host__ __device__ __forceinline__ int perm32(int rho) { const int n = rho >> 4, i = rho & 15; return 8 * (i >> 2) + 4 * n + (i & 3); }

struct Unit { int pm, pn, aux; size_t aoff, boff; };
struct Gemm { const bf16_t* A; const bf16_t* Bt; int lda, ldb, K; const int* rowtok; };

struct SchedGrid {
    int nM, nN, nwg, G, c; size_t ta, tb;
    DI void init(int M, int N, int lda, int ldb, int G_, int c_) { nM = M / BM; nN = N / BM; nwg = nM * nN; G = G_; c = c_; ta = (size_t)BM * lda * 2; tb = (size_t)BM * ldb * 2; }
    DI bool next(int i, Unit& u) const {
        const long L = (long)i * G + c; if (L >= nwg) return false;
        int wgid = (int)L; { const int q = nwg / NXCD, r = nwg % NXCD, xcd = wgid % NXCD, off = wgid / NXCD; wgid = (xcd < r ? xcd * (q + 1) : r * (q + 1) + (xcd - r) * q) + off; }
        const int nig = WGM * nN, gid = wgid / nig, fm = gid * WGM, gsz = (nM - fm) < WGM ? (nM - fm) : WGM;
        u.pm = fm + ((wgid % nig) % gsz); u.pn = (wgid % nig) / gsz; u.aux = 0; u.aoff = (size_t)u.pm * ta; u.boff = (size_t)u.pn * tb; return true;
    }
};

template <class Sched> struct SchedRange { const Sched& s; int i0, i1; DI bool next(int i, Unit& u) const { return (i0 + i < i1) && s.next(i0 + i, u); } };

DI unsigned cvt_pk_bf16(float lo, float hi) { return cvtpk(lo, hi); }

template <class Epi, class Sched, bool GATHER>
DI void gemm_phase(LAS unsigned char* lds, const Gemm g, const Sched& S, const Epi& E) {
    const int tid = threadIdx.x, wid = __builtin_amdgcn_readfirstlane(tid >> 6), lane = tid & 63, wr = wid >> 2, wc = wid & 3, fr = lane & 15, fq = lane >> 4;
    const int K = g.K, nt = K / BK;
    int Rr[2], Cc[2];
    unsigned voffA[2][2], voffB[2], nvoffA[2][2];
#pragma unroll
    for (int i = 0; i < 2; ++i) { int R, C; stage_rc(tid * 16 + i * 8192, R, C); const int Rb = Epi::PERM ? ((R & ~31) + perm32(R & 31)) : R; Rr[i] = R; Cc[i] = C;
        voffA[0][i] = (unsigned)(R * g.lda + C) * 2u; voffA[1][i] = (unsigned)((R + HALF) * g.lda + C) * 2u; voffB[i] = (unsigned)(Rb * g.ldb + C) * 2u;
        nvoffA[0][i] = voffA[0][i]; nvoffA[1][i] = voffA[1][i]; }
    const size_t kstep = (size_t)(BK * 2);
    const size_t hstepB = (size_t)HALF * g.ldb * 2;
    const unsigned ldsw = (unsigned)wid * 1024u;
    const int aoff = lds_byte(wr * 64 + fr, fq * 8), boff = lds_byte(wc * 32 + fr, fq * 8);
#define PG8_SA(b, h) (((b) * 2 + (h)) * HTB)
#define PG8_SB(b, h) ((4 + (b) * 2 + (h)) * HTB)
#define PG8_STAGE(bufoff, gbase, voff) do { _Pragma("unroll") for (int _i = 0; _i < 2; ++_i) \
        __builtin_amdgcn_global_load_lds((const unsigned*)((const char*)(gbase) + (voff)[_i]), (LAS unsigned*)(lds + (bufoff) + ldsw + _i * 8192), 16, 0, 0); } while (0)
#define PG8_LDA(dst, b, h) do { _Pragma("unroll") for (int m = 0; m < 4; ++m) _Pragma("unroll") for (int k = 0; k < 2; ++k) dst[m][k] = *(const LAS bf16x8*)(lds + PG8_SA(b, h) + aoff + m * 2048 + k * 1024); } while (0)
#define PG8_LDB(dst, b, h) do { _Pragma("unroll") for (int n = 0; n < 2; ++n) _Pragma("unroll") for (int k = 0; k < 2; ++k) dst[n][k] = *(const LAS bf16x8*)(lds + PG8_SB(b, h) + boff + n * 2048 + k * 1024); } while (0)
#define PG8_MMA(ai, bj, At, Bt) do { __builtin_amdgcn_s_setprio(1); _Pragma("unroll") for (int m = 0; m < 4; ++m) _Pragma("unroll") for (int n = 0; n < 2; ++n) _Pragma("unroll") for (int k = 0; k < 2; ++k) \
        acc[ai][bj][m][n] = __builtin_amdgcn_mfma_f32_16x16x32_bf16(Bt[n][k], At[m][k], acc[ai][bj][m][n], 0, 0, 0); __builtin_amdgcn_s_setprio(0); } while (0)
#define PG8_WAIT_V(n) asm volatile("s_waitcnt vmcnt(" #n ")" ::: "memory")
#define PG8_WAIT_L(n) asm volatile("s_waitcnt lgkmcnt(" #n ")" ::: "memory")
#define PG8_BAR __builtin_amdgcn_s_barrier()
#define PG8_SCHED __builtin_amdgcn_sched_barrier(0)
#define PG8_GATHER(dst, u) do { if constexpr (GATHER) { _Pragma("unroll") for (int _h = 0; _h < 2; ++_h) _Pragma("unroll") for (int _i = 0; _i < 2; ++_i) { \
        int _t = g.rowtok[(u).pm * BM + _h * HALF + Rr[_i]]; _t = _t < 0 ? 0 : _t; dst[_h][_i] = (unsigned)(_t * g.lda + Cc[_i]) * 2u; } } } while (0)
    Unit cur, nxt; int ui = 0;
    if (!S.next(0, cur)) return;
    f32x4 acc[2][2][4][2];
#pragma unroll
    for (int a = 0; a < 2; ++a)
#pragma unroll
        for (int b = 0; b < 2; ++b)
#pragma unroll
            for (int m = 0; m < 4; ++m)
#pragma unroll
                for (int n = 0; n < 2; ++n) acc[a][b][m][n] = (f32x4){0.f, 0.f, 0.f, 0.f};
    bf16x8 At[4][2], B0[2][2], B1[2][2];
    const char* cA = (const char*)g.A + cur.aoff; const char* cB = (const char*)g.Bt + cur.boff;
    PG8_GATHER(voffA, cur);
    PG8_STAGE(PG8_SB(0, 0), cB, voffB); PG8_STAGE(PG8_SB(0, 1), cB + hstepB, voffB); PG8_STAGE(PG8_SA(0, 0), cA, voffA[0]); PG8_STAGE(PG8_SA(0, 1), cA, voffA[1]);
    if (wr == 1) PG8_BAR;
    PG8_WAIT_V(2); PG8_BAR;
    PG8_STAGE(PG8_SB(1, 0), cB + kstep, voffB); PG8_STAGE(PG8_SA(1, 0), cA + kstep, voffA[0]); PG8_STAGE(PG8_SB(1, 1), cB + hstepB + kstep, voffB);
    PG8_WAIT_V(6); PG8_BAR;
    for (;;) {
        const bool has_next = S.next(ui + 1, nxt);
        const char* nA = has_next ? (const char*)g.A + nxt.aoff : cA; const char* nB = has_next ? (const char*)g.Bt + nxt.boff : cB;
        if constexpr (GATHER) { if (has_next) { PG8_GATHER(nvoffA, nxt); } else { _Pragma("unroll") for (int h = 0; h < 2; ++h) _Pragma("unroll") for (int i = 0; i < 2; ++i) nvoffA[h][i] = voffA[h][i]; } }
        for (int t = 0; t < nt; t += 2) {
            const bool last = (t == nt - 2);
            const char* a1 = cA + (size_t)(t + 1) * kstep;
            const char* a2 = last ? nA : cA + (size_t)(t + 2) * kstep; const char* b2 = last ? nB : cB + (size_t)(t + 2) * kstep;
            const char* a3 = a2 + kstep; const char* b3 = b2 + kstep;
            unsigned va2[2][2];
#pragma unroll
            for (int h = 0; h < 2; ++h)
#pragma unroll
                for (int i = 0; i < 2; ++i) va2[h][i] = (GATHER && last) ? nvoffA[h][i] : voffA[h][i];
            PG8_LDB(B0, 0, 0); PG8_LDB(B1, 0, 1); PG8_SCHED; PG8_LDA(At, 0, 0); PG8_STAGE(PG8_SA(1, 1), a1, voffA[1]);
            PG8_WAIT_V(8); PG8_WAIT_L(0); PG8_BAR; PG8_MMA(0, 0, At, B0); PG8_MMA(0, 1, At, B1); PG8_BAR; PG8_SCHED;
            PG8_LDA(At, 0, 1); PG8_STAGE(PG8_SB(0, 0), b2, voffB); PG8_STAGE(PG8_SB(0, 1), b2 + hstepB, voffB); PG8_STAGE(PG8_SA(0, 0), a2, va2[0]);
            PG8_WAIT_V(8); PG8_WAIT_L(0); PG8_BAR; PG8_MMA(1, 0, At, B0); PG8_MMA(1, 1, At, B1); PG8_BAR; PG8_SCHED;
            PG8_LDB(B0, 1, 0); PG8_LDB(B1, 1, 1); PG8_SCHED; PG8_LDA(At, 1, 0); PG8_STAGE(PG8_SA(0, 1), a2, va2[1]);
            PG8_WAIT_V(8); PG8_WAIT_L(0); PG8_BAR; PG8_MMA(0, 0, At, B0); PG8_MMA(0, 1, At, B1); PG8_BAR; PG8_SCHED;
            PG8_LDA(At, 1, 1); PG8_STAGE(PG8_SB(1, 0), b3, voffB); PG8_STAGE(PG8_SB(1, 1), b3 + hstepB, voffB); PG8_STAGE(PG8_SA(1, 0), a3, va2[0]);
            PG8_WAIT_V(8); PG8_WAIT_L(0); PG8_BAR; PG8_MMA(1, 0, At, B0); PG8_MMA(1, 1, At, B1); PG8_BAR; PG8_SCHED;
        }
        if (wr == 0) PG8_BAR;
        E(acc, cur, wr, wc, fr, fq);
        if (!has_next) break;
#pragma unroll
        for (int a = 0; a < 2; ++a)
#pragma unroll
            for (int b = 0; b < 2; ++b)
#pragma unroll
                for (int m = 0; m < 4; ++m)
#pragma unroll
                    for (int n = 0; n < 2; ++n) acc[a][b][m][n] = (f32x4){0.f, 0.f, 0.f, 0.f};
        cur = nxt; cA = nA; cB = nB; ++ui;
        if constexpr (GATHER) { _Pragma("unroll") for (int h = 0; h < 2; ++h) _Pragma("unroll") for (int i = 0; i < 2; ++i) voffA[h][i] = nvoffA[h][i]; }
        if (wr == 1) PG8_BAR;
    }
    PG8_WAIT_V(0);
    PG8_BAR;
#undef PG8_SA
#undef PG8_SB
#undef PG8_STAGE
#undef PG8_LDA
#undef PG8_LDB
#undef PG8_MMA
#undef PG8_WAIT_V
#undef PG8_WAIT_L
#undef PG8_BAR
#undef PG8_SCHED
#undef PG8_GATHER
}
}

struct Params {
    const float* in[25];
    float* out;
    unsigned char* ws;
    int ph_lo, ph_hi;
};
struct Frame {
    LAS unsigned char* lds;
    unsigned* ctl;
    int tid, lane, wave, G, bid;
    unsigned char* ws;
};
#define WSP(T, off) ((T*)(F.ws + (off)))

using pg8::Unit; using pg8::BM; using pg8::HALF; using pg8::cvt_pk_bf16;

struct EpiIn {
    static constexpr bool PERM = true;
    unsigned char* ws; const float* b_fgt;
    DI bf16_t* dest(int cg, bool& trans, float& sc) const {
        trans = false; sc = 1.f;
        if (cg < 8)  { sc = C2; return (bf16_t*)(ws + WS_QN) + (size_t)cg * S * 64; }
        if (cg < 12) { return (bf16_t*)(ws + WS_CKV) + (size_t)(cg - 8) * CKROWS * 64; }
        if (cg < 14) { return (bf16_t*)(ws + WS_SK) + (size_t)(cg - 12) * S * 64; }
        if (cg < 16) { trans = true; return (bf16_t*)(ws + WS_SVT) + (size_t)(cg - 14) * 64 * S; }
        if (cg < 18) { return (bf16_t*)(ws + WS_WK) + (size_t)(cg - 16) * S * 64; }
        if (cg < 20) { trans = true; return (bf16_t*)(ws + WS_WVT) + (size_t)(cg - 18) * 64 * S; }
        if (cg < 28) { sc = C2; return (bf16_t*)(ws + WS_FQ) + (size_t)(cg - 20) * S * 64; }
        if (cg < 36) { return (bf16_t*)(ws + WS_FK) + (size_t)(cg - 28) * S * 64; }
        trans = true; return (bf16_t*)(ws + WS_FVT) + (size_t)(cg - 36) * 64 * S;
    }
    DI void operator()(const f32x4 (&acc)[2][2][4][2], const Unit& u, int wr, int wc, int fr, int fq) const {
        asm volatile("" : "+v"(fr), "+v"(fq)); asm volatile("" : "+s"(wr), "+s"(wc));
        const int row0 = u.pm * BM + wr * 64 + fr;
        if (u.pn <= 10) {
#pragma unroll
            for (int bj = 0; bj < 2; ++bj) {
                const int cb = 128 * bj + 32 * wc, cg = u.pn * 4 + (cb >> 6), d0 = (cb & 63) + 8 * fq;
                bool trans; float sc; bf16_t* base = dest(cg, trans, sc);
#pragma unroll
                for (int ai = 0; ai < 2; ++ai)
#pragma unroll
                    for (int m = 0; m < 4; ++m) {
                        const int t = row0 + ai * HALF + m * 16;
                        const f32x4 v0 = acc[ai][bj][m][0] * sc, v1 = acc[ai][bj][m][1] * sc;
                        if (!trans) { u32x4 w; w.x = cvt_pk_bf16(v0[0], v0[1]); w.y = cvt_pk_bf16(v0[2], v0[3]); w.z = cvt_pk_bf16(v1[0], v1[1]); w.w = cvt_pk_bf16(v1[2], v1[3]);
                            *(u32x4*)(base + (size_t)t * 64 + d0) = w; }
                        else {
#pragma unroll
                            for (int j = 0; j < 4; ++j) { base[((size_t)(t >> 5) * 64 + d0 + j) * 32 + (t & 31)] = (bf16_t)f2bf(v0[j]); base[((size_t)(t >> 5) * 64 + d0 + 4 + j) * 32 + (t & 31)] = (bf16_t)f2bf(v1[j]); }
                        }
                    }
            }
        } else if (u.pn <= 26) {
            bf16_t* gm = (bf16_t*)(ws + WS_GM);
#pragma unroll
            for (int bj = 0; bj < 2; ++bj) {
                const int col = (u.pn - 11) * 256 + 128 * bj + 32 * wc + 8 * fq;
#pragma unroll
                for (int ai = 0; ai < 2; ++ai)
#pragma unroll
                    for (int m = 0; m < 4; ++m) {
                        const int t = row0 + ai * HALF + m * 16;
                        const f32x4 v0 = acc[ai][bj][m][0], v1 = acc[ai][bj][m][1];
                        u32x4 w; w.x = cvt_pk_bf16(sigmoidf_(v0[0]), sigmoidf_(v0[1])); w.y = cvt_pk_bf16(sigmoidf_(v0[2]), sigmoidf_(v0[3]));
                        w.z = cvt_pk_bf16(sigmoidf_(v1[0]), sigmoidf_(v1[1])); w.w = cvt_pk_bf16(sigmoidf_(v1[2]), sigmoidf_(v1[3]));
                        *(u32x4*)(gm + (size_t)t * 4096 + col) = w;
                    }
            }
        } else {
            if (wc == 0) {
                float* gn = (float*)(ws + WS_GN); float* lf = (float*)(ws + WS_LOGF);
#pragma unroll
                for (int ai = 0; ai < 2; ++ai)
#pragma unroll
                    for (int m = 0; m < 4; ++m) {
                        const int t = row0 + ai * HALF + m * 16;
#pragma unroll
                        for (int n = 0; n < 2; ++n)
#pragma unroll
                            for (int j = 0; j < 4; ++j) {
                                const int c = 8 * fq + 4 * n + j; const float v = acc[ai][0][m][n][j];
                                if (c < 24) gn[(size_t)t * 24 + c] = sigmoidf_(v);
                                else lf[(size_t)t * 8 + (c - 24)] = logsigmoidf_(v + b_fgt[c - 24]);
                            }
                    }
            }
        }
    }
};

DI float gelu_tanh(float x) { const float u = 0.7978845608028654f * (x + 0.044715f * x * x * x); return 0.5f * x * (1.f + tanhf(u)); }

struct EpiCmp {
    static constexpr bool PERM = false;
    float* hp;
    DI void operator()(const f32x4 (&acc)[2][2][4][2], const Unit& u, int wr, int wc, int fr, int fq) const {
        asm volatile("" : "+v"(fr), "+v"(fq)); asm volatile("" : "+s"(wr), "+s"(wc));
        const int row0 = u.pm * BM + wr * 64 + fr; float* base = hp + (size_t)u.aux * 1024 * 256;
#pragma unroll
        for (int bj = 0; bj < 2; ++bj)
#pragma unroll
            for (int n = 0; n < 2; ++n) { const int col = 128 * bj + 32 * wc + 16 * n + 4 * fq;
#pragma unroll
                for (int ai = 0; ai < 2; ++ai)
#pragma unroll
                    for (int m = 0; m < 4; ++m) *(f32x4*)(base + (size_t)(row0 + ai * HALF + m * 16) * 256 + col) = acc[ai][bj][m][n]; }
    }
};
struct SchedCmp {
    int G, c;
    DI bool next(int i, Unit& u) const { const int L = i * G + c; if (L >= 64) return false; const int ks = L & 3, zg = L >> 4; u.pm = (L >> 2) & 3; u.pn = 0; u.aux = ks * 4 + zg;
        u.aoff = ((size_t)zg * CKROWS * 64 + (size_t)u.pm * 256 * 1024 + ks * 512) * 2; u.boff = ((size_t)(zg >> 1) * 256 * 2048 + ks * 512) * 2; return true; }
};

template <int STEP> struct EpiMerge {
    static constexpr bool PERM = true;
    const bf16_t* gm; bf16_t* mg;
    DI void operator()(const f32x4 (&acc)[2][2][4][2], const Unit& u, int wr, int wc, int fr, int fq) const {
        asm volatile("" : "+v"(fr), "+v"(fq)); asm volatile("" : "+s"(wr), "+s"(wc));
        const int row0 = u.pm * BM + wr * 64 + fr;
#pragma unroll
        for (int bj = 0; bj < 2; ++bj) {
            const int col = u.pn * 256 + 128 * bj + 32 * wc + 8 * fq;
#pragma unroll
            for (int ai = 0; ai < 2; ++ai)
#pragma unroll
                for (int m = 0; m < 4; ++m) {
                    const int t = row0 + ai * HALF + m * 16;
                    const u32x4 gw = *(const u32x4*)(gm + (size_t)t * 4096 + (STEP - 1) * 2048 + col);
                    float gv[8], pv[8];
#pragma unroll
                    for (int j = 0; j < 4; ++j) { gv[2 * j] = __builtin_bit_cast(float, gw[j] << 16); gv[2 * j + 1] = __builtin_bit_cast(float, gw[j] & 0xffff0000u); }
                    if (STEP == 2) { const u32x4 pw = *(const u32x4*)(mg + (size_t)t * 2048 + col);
#pragma unroll
                        for (int j = 0; j < 4; ++j) { pv[2 * j] = __builtin_bit_cast(float, pw[j] << 16); pv[2 * j + 1] = __builtin_bit_cast(float, pw[j] & 0xffff0000u); } }
                    else {
#pragma unroll
                        for (int j = 0; j < 8; ++j) pv[j] = 0.f; }
                    const f32x4 v0 = acc[ai][bj][m][0], v1 = acc[ai][bj][m][1];
                    float o[8];
#pragma unroll
                    for (int j = 0; j < 4; ++j) { o[j] = pv[j] + gv[j] * v0[j]; o[4 + j] = pv[4 + j] + gv[4 + j] * v1[j]; }
                    u32x4 w; w.x = cvt_pk_bf16(o[0], o[1]); w.y = cvt_pk_bf16(o[2], o[3]); w.z = cvt_pk_bf16(o[4], o[5]); w.w = cvt_pk_bf16(o[6], o[7]);
                    *(u32x4*)(mg + (size_t)t * 2048 + col) = w;
                }
        }
    }
};

struct EpiWo {
    static constexpr bool PERM = true;
    const float* mod; bf16_t* yb;
    DI void operator()(const f32x4 (&acc)[2][2][4][2], const Unit& u, int wr, int wc, int fr, int fq) const {
        asm volatile("" : "+v"(fr), "+v"(fq)); asm volatile("" : "+s"(wr), "+s"(wc));
        const int row0 = u.pm * BM + wr * 64 + fr;
#pragma unroll
        for (int bj = 0; bj < 2; ++bj) {
            const int col = u.pn * BM + 128 * bj + 32 * wc + 8 * fq;
            const f32x4 ga = *(const f32x4*)(mod + 2 * D + col) + 1.0f, gb = *(const f32x4*)(mod + 2 * D + col + 4) + 1.0f;
#pragma unroll
            for (int ai = 0; ai < 2; ++ai)
#pragma unroll
                for (int m = 0; m < 4; ++m) {
                    const f32x4 v0 = acc[ai][bj][m][0] * ga, v1 = acc[ai][bj][m][1] * gb;
                    u32x4 w; w.x = cvt_pk_bf16(v0[0], v0[1]); w.y = cvt_pk_bf16(v0[2], v0[3]); w.z = cvt_pk_bf16(v1[0], v1[1]); w.w = cvt_pk_bf16(v1[2], v1[3]);
                    *(u32x4*)(yb + (size_t)(row0 + ai * HALF + m * 16) * D + col) = w;
                }
        }
    }
};

struct SchedMoe {
    const LAS int* pane; int npn, G, c; size_t arow_bytes, btile_bytes;
    DI bool next(int i, Unit& u) const {
        const int np = pane[0]; const int L = i * G + c; if (L >= np * npn) return false;
        const int p = L / npn, pn = L - p * npn, e = pane[1 + p];
        u.pm = p; u.pn = pn; u.aux = e; u.aoff = (size_t)p * arow_bytes; u.boff = (size_t)(e * npn + pn) * btile_bytes; return true;
    }
};
struct EpiGU {
    static constexpr bool PERM = true;
    bf16_t* h;
    DI void operator()(const f32x4 (&acc)[2][2][4][2], const Unit& u, int wr, int wc, int fr, int fq) const {
        asm volatile("" : "+v"(fr), "+v"(fq)); asm volatile("" : "+s"(wr), "+s"(wc));
        const int row0 = u.pm * BM + wr * 64 + fr; const int col = u.pn * 128 + 32 * wc + 8 * fq;
#pragma unroll
        for (int ai = 0; ai < 2; ++ai)
#pragma unroll
            for (int m = 0; m < 4; ++m) {
                const int r = row0 + ai * HALF + m * 16;
                float o[8];
#pragma unroll
                for (int n = 0; n < 2; ++n)
#pragma unroll
                    for (int j = 0; j < 4; ++j) { const float gt = acc[ai][0][m][n][j], up = acc[ai][1][m][n][j]; o[4 * n + j] = gt * sigmoidf_(gt) * up; }
                u32x4 w; w.x = cvt_pk_bf16(o[0], o[1]); w.y = cvt_pk_bf16(o[2], o[3]); w.z = cvt_pk_bf16(o[4], o[5]); w.w = cvt_pk_bf16(o[6], o[7]);
                *(u32x4*)(h + (size_t)r * DEXP + col) = w;
            }
    }
};
struct EpiDown {
    static constexpr bool PERM = true;
    const int* rowdst; const float* roww; bf16_t* y2;
    DI void operator()(const f32x4 (&acc)[2][2][4][2], const Unit& u, int wr, int wc, int fr, int fq) const {
        asm volatile("" : "+v"(fr), "+v"(fq)); asm volatile("" : "+s"(wr), "+s"(wc));
        const int row0 = u.pm * BM + wr * 64 + fr;
#pragma unroll
        for (int ai = 0; ai < 2; ++ai)
#pragma unroll
            for (int m = 0; m < 4; ++m) {
                const int r = row0 + ai * HALF + m * 16; const int dst = rowdst[r];
                if (dst >= 0) { const float w8 = roww[r];
#pragma unroll
                    for (int bj = 0; bj < 2; ++bj) { const int col = u.pn * 256 + 128 * bj + 32 * wc + 8 * fq;
                        const f32x4 v0 = acc[ai][bj][m][0] * w8, v1 = acc[ai][bj][m][1] * w8;
                        u32x4 w; w.x = cvt_pk_bf16(v0[0], v0[1]); w.y = cvt_pk_bf16(v0[2], v0[3]); w.z = cvt_pk_bf16(v1[0], v1[1]); w.w = cvt_pk_bf16(v1[2], v1[3]);
                        *(u32x4*)(y2 + (size_t)dst * D + col) = w; } }
            }
    }
};


template <int UNR = 4> DI void tr_item(const float* srcrow0, int ldsrc, int col4, bool colok, bf16_t* dst, int ldd, int nrows, LAS float* scr, int lane) {
#pragma unroll UNR
    for (int it = 0; it < 16; ++it) { const int k = it * 4 + (lane >> 4); f32x4 v = (f32x4){0.f, 0.f, 0.f, 0.f};
        if (colok) v = (UNR == 16) ? __builtin_nontemporal_load((const f32x4*)(srcrow0 + (size_t)k * ldsrc + col4)) : *(const f32x4*)(srcrow0 + (size_t)k * ldsrc + col4);
        LAS float* s = scr + k * 65 + (lane & 15) * 4; s[0] = v[0]; s[1] = v[1]; s[2] = v[2]; s[3] = v[3]; }
    asm volatile("s_waitcnt lgkmcnt(0)" ::: "memory");
    const int c = lane & 7;
#pragma unroll
    for (int it = 0; it < 8; ++it) { const int n = it * 8 + (lane >> 3); const LAS float* s = scr + (8 * c) * 65 + n;
        u32x4 o; o.x = cvtpk(s[0 * 65], s[1 * 65]); o.y = cvtpk(s[2 * 65], s[3 * 65]); o.z = cvtpk(s[4 * 65], s[5 * 65]); o.w = cvtpk(s[6 * 65], s[7 * 65]);
        if (n < nrows) { if (UNR == 16) __builtin_nontemporal_store(o, (u32x4*)(dst + (size_t)n * ldd + 8 * c)); else *(u32x4*)(dst + (size_t)n * ldd + 8 * c) = o; } }
    asm volatile("s_waitcnt lgkmcnt(0)" ::: "memory");
}

template <int PART> DI void phase_prologue(Frame& F, const Params& P) {
    LAS float* scr = (LAS float*)(F.lds + F.wave * 16640);
    const int gw = F.bid * NWAVES + F.wave, NGW = F.G * NWAVES, lane = F.lane;
    const int c4 = (lane & 15) * 4;
    constexpr int I_IN = 32 * 109, I_W1 = 2 * 32 * 4, I_BR = 8 * 32, I_WO = 32 * 32, I_G = NEXP * 32 * 8, I_D = NEXP * 8 * 32;
    constexpr int I_MOD = 48 * 32, I_PEW = 64, I_RT = 32;
    constexpr int NITEMS = I_IN + I_W1 + 2 * I_BR + I_WO + 2 * I_G + I_D + I_MOD + I_PEW + I_RT;
    constexpr int NTR = NITEMS - (I_MOD + I_PEW + I_RT);
    constexpr int I_MOE = 2 * I_G + I_D, R_MOE = I_IN + I_W1 + 2 * I_BR + I_WO;
    constexpr int NLOOP = !WCO ? NITEMS : (PART == 0 ? (I_MOD + I_PEW + I_RT) + R_MOE : I_MOE);
    for (int it = gw; it < NLOOP; it += NGW) {
        int r;
        if (!WCO) r = it < (I_MOD + I_PEW + I_RT) ? NTR + it : it - (I_MOD + I_PEW + I_RT);
        else if (PART == 1) r = R_MOE + it;
        else r = it < (I_MOD + I_PEW + I_RT) ? NTR + it : it - (I_MOD + I_PEW + I_RT);
        if (r < I_IN) {
            const int kb = r / 109, nb = r % 109, j0 = nb * 64; const float* w = P.in[4] + (size_t)(kb * 64) * IN_COLS;
            bf16_t* dst = WSP(bf16_t, WS_WINT) + (size_t)j0 * D + kb * 64;
            if (nb < 108) { const int oc = j0 < 1280 ? j0 : (j0 < 2816 ? j0 + 24 : j0 + 32); tr_item(w, IN_COLS, oc + c4, true, dst, D, 64, scr, lane); }
            else { const int oc = c4 < 24 ? OFF_GATE + c4 : OFF_FGT + (c4 - 24); tr_item(w, IN_COLS, oc, c4 < 32, dst, D, 32, scr, lane); }
            continue; } r -= I_IN;
        if (r < I_W1) { const int z = r / 128, q = r % 128, kb = q / 4, nb = q % 4;
            tr_item(P.in[8] + (size_t)z * 2048 * 256 + (size_t)(kb * 64) * 256, 256, nb * 64 + c4, true, WSP(bf16_t, WS_W1T) + ((size_t)z * 256 + nb * 64) * 2048 + kb * 64, 2048, 64, scr, lane);
            continue; } r -= I_W1;
        if (r < 2 * I_BR) { const int which = r / I_BR, q = r % I_BR, kb = q / 32, nb = q % 32;
            tr_item(P.in[11 + which] + (size_t)(kb * 64) * 2048, 2048, nb * 64 + c4, true, WSP(bf16_t, which ? WS_BRT2 : WS_BRT1) + (size_t)(nb * 64) * 512 + kb * 64, 512, 64, scr, lane);
            continue; } r -= 2 * I_BR;
        if (r < I_WO) { const int kb = r / 32, nb = r % 32;
            tr_item(P.in[13] + (size_t)(kb * 64) * 2048, 2048, nb * 64 + c4, true, WSP(bf16_t, WS_WOT) + (size_t)(nb * 64) * 2048 + kb * 64, 2048, 64, scr, lane);
            continue; } r -= I_WO;
        if (r < 2 * I_G) { const int up = r / I_G, q = r % I_G, e = q / 256, q2 = q % 256, kb = q2 / 8, nb = q2 % 8;
            const int n0 = nb * 64, drow = (n0 >> 7) * 256 + up * 128 + (n0 & 127);
            tr_item<(PART == 1 ? 16 : 4)>(P.in[20 + up] + (size_t)e * 2048 * 512 + (size_t)(kb * 64) * 512, 512, n0 + c4, true, WSP(bf16_t, WS_WGUT) + ((size_t)e * 1024 + drow) * 2048 + kb * 64, 2048, 64, scr, lane);
            continue; } r -= 2 * I_G;
        if (r < I_D) { const int e = r / 256, q2 = r % 256, kb = q2 / 32, nb = q2 % 32;
            tr_item<(PART == 1 ? 16 : 4)>(P.in[22] + (size_t)e * 512 * 2048 + (size_t)(kb * 64) * 2048, 2048, nb * 64 + c4, true, WSP(bf16_t, WS_WDT) + ((size_t)e * 2048 + nb * 64) * 512 + kb * 64, 512, 64, scr, lane);
            continue; } r -= I_D;
        if (r < I_MOD) {
            const int cc = r / 32, kc = r % 32; const float* c = P.in[1]; const float* w = P.in[2] + (size_t)(kc * 64) * 12288 + cc * 256 + lane * 4;
            f32x4 a = (f32x4){0.f, 0.f, 0.f, 0.f};
#pragma unroll 8
            for (int k = 0; k < 64; ++k) { const float cv = c[kc * 64 + k]; const float sv = cv / (1.f + __expf(-cv)); a += *(const f32x4*)(w + (size_t)k * 12288) * sv; }
            *(f32x4*)(WSP(float, WS_MODP) + (size_t)kc * 12288 + cc * 256 + lane * 4) = a;
            continue; } r -= I_MOD;
        if (r >= I_PEW) {
            const int k0 = (r - I_PEW) * 64; bf16_t* th = WSP(bf16_t, WS_WRT); bf16_t* tl = th + 80 * 2048;
#pragma unroll 4
            for (int kk = 0; kk < 64; ++kk) scr[kk * 65 + lane] = P.in[18][(size_t)(k0 + kk) * 64 + lane];
            asm volatile("s_waitcnt lgkmcnt(0)" ::: "memory");
#pragma unroll 4
            for (int n = 0; n < 64; ++n) { const float v = scr[lane * 65 + n]; const unsigned hb = f2bf(v);
                th[(size_t)(8 + n) * 2048 + k0 + lane] = (bf16_t)hb; tl[(size_t)(8 + n) * 2048 + k0 + lane] = (bf16_t)f2bf(v - __builtin_bit_cast(float, hb << 16)); }
#pragma unroll
            for (int n = 0; n < 8; ++n) { const float v = P.in[16][(size_t)(k0 + lane) * 8 + n]; const unsigned hb = f2bf(v);
                th[(size_t)n * 2048 + k0 + lane] = (bf16_t)hb; tl[(size_t)n * 2048 + k0 + lane] = (bf16_t)f2bf(v - __builtin_bit_cast(float, hb << 16));
                th[(size_t)(72 + n) * 2048 + k0 + lane] = 0; tl[(size_t)(72 + n) * 2048 + k0 + lane] = 0; }
            asm volatile("s_waitcnt lgkmcnt(0)" ::: "memory");
            continue; }
        {
            const int z = r / 32, fc = r % 32; const float* pe = P.in[7] + z * 2048 + fc * 64; const float* w = P.in[8] + (size_t)z * 2048 * 256 + (size_t)(fc * 64) * 256 + lane * 4;
            f32x4 a = (f32x4){0.f, 0.f, 0.f, 0.f};
#pragma unroll 8
            for (int k = 0; k < 64; ++k) a += *(const f32x4*)(w + (size_t)k * 256) * pe[k];
            *(f32x4*)(WSP(float, WS_PEWP) + ((size_t)z * 32 + fc) * 256 + lane * 4) = a;
        }
    }
    if (PART == 1) return;
    int* rt = WSP(int, WS_ROWTOK); int* rd = WSP(int, WS_ROWDST);
    for (int i = F.bid * NTHREADS + F.tid; i < MAXROWS; i += F.G * NTHREADS) { rt[i] = -1; rd[i] = -1; }
    { int* tk = WSP(int, WS_TOKL); for (int i = F.bid * NTHREADS + F.tid; i < 2 * BMS_MAXU * 64; i += F.G * NTHREADS) tk[i] = -1; }
}

DI void phase_ln1(Frame& F, const Params& P) {
    const int gid = F.bid * NTHREADS + F.tid;
    const float* modp = WSP(float, WS_MODP);
    if (gid < 12288) { float a = P.in[3][gid]; for (int kc = 0; kc < 32; ++kc) a += modp[(size_t)kc * 12288 + gid]; WSP(float, WS_MOD)[gid] = a; }
    else if (gid < 12288 + 512) { const int q = gid - 12288, z = q >> 8, col = q & 255; float a = P.in[9][q]; const float* pw = WSP(float, WS_PEWP);
        for (int fc = 0; fc < 32; ++fc) a += pw[((size_t)z * 32 + fc) * 256 + col]; WSP(float, WS_BIASC)[q] = a; }
    const int lane = F.lane;
    f32x4 sc[8], sh[8];
#pragma unroll
    for (int j = 0; j < 8; ++j) { const int col = 4 * lane + 256 * j; f32x4 a = *(const f32x4*)(P.in[3] + col), b = *(const f32x4*)(P.in[3] + D + col);
        for (int kc = 0; kc < 32; ++kc) { a += *(const f32x4*)(modp + (size_t)kc * 12288 + col); b += *(const f32x4*)(modp + (size_t)kc * 12288 + D + col); }
        sh[j] = a; sc[j] = b + 1.0f; }
    const int gw = F.bid * NWAVES + F.wave, NGW = F.G * NWAVES;
    const float* x = P.in[0]; bf16_t* U = WSP(bf16_t, WS_U);
    for (int m = gw; m < S; m += NGW) {
        const f32x4* xr = (const f32x4*)(x + (size_t)m * D) + lane;
        f32x4 v[8]; float s = 0.f;
#pragma unroll
        for (int j = 0; j < 8; ++j) { v[j] = xr[64 * j]; s += (v[j][0] + v[j][1]) + (v[j][2] + v[j][3]); }
        const float mean = wave_sum(s) * (1.f / D); float s2 = 0.f;
#pragma unroll
        for (int j = 0; j < 8; ++j) { v[j] = v[j] - mean; s2 += (v[j][0] * v[j][0] + v[j][1] * v[j][1]) + (v[j][2] * v[j][2] + v[j][3] * v[j][3]); }
        const float rstd = 1.f / sqrtf(wave_sum(s2) * (1.f / D) + LN_EPS);
        u32x2* o8 = (u32x2*)(U + (size_t)m * D) + lane;
#pragma unroll
        for (int j = 0; j < 8; ++j) { const f32x4 y = v[j] * rstd * sc[j] + sh[j]; u32x2 w; w.x = cvtpk(y[0], y[1]); w.y = cvtpk(y[2], y[3]); o8[64 * j] = w; }
    }
}

DI f32x16 mfma32(bf16x8 a, bf16x8 b, f32x16 c) { return __builtin_amdgcn_mfma_f32_32x32x16_bf16(a, b, c, 0, 0, 0); }
DI f32x4 mfma16(bf16x8 a, bf16x8 b, f32x4 c) { return __builtin_amdgcn_mfma_f32_16x16x32_bf16(a, b, c, 0, 0, 0); }
DI int perm23(int i) { return (i & ~12) | ((i & 4) << 1) | ((i & 8) >> 1); }
DI int crow(int r, int hi) { return (r & 3) + 8 * (r >> 2) + 4 * hi; }
constexpr float NEG_INF = -__builtin_inff();

template <int CTRL> DI float dppf(float x) { return __builtin_bit_cast(float, __builtin_amdgcn_update_dpp(0, __builtin_bit_cast(int, x), CTRL, 0xF, 0xF, true)); }
template <int CTRL> DI int dppi(int x) { return __builtin_amdgcn_update_dpp(0, x, CTRL, 0xF, 0xF, true); }
DI float xmax32(float x) { auto rr = __builtin_amdgcn_permlane32_swap(__float_as_uint(x), __float_as_uint(x), false, false); return fmaxf(__uint_as_float(rr[0]), __uint_as_float(rr[1])); }
DI float xadd32(float x) { auto rr = __builtin_amdgcn_permlane32_swap(__float_as_uint(x), __float_as_uint(x), false, false); return __uint_as_float(rr[0]) + __uint_as_float(rr[1]); }
DI float xmax16(float x) { auto rr = __builtin_amdgcn_permlane16_swap(__float_as_uint(x), __float_as_uint(x), false, false); return fmaxf(__uint_as_float(rr[0]), __uint_as_float(rr[1])); }
DI float xadd16(float x) { auto rr = __builtin_amdgcn_permlane16_swap(__float_as_uint(x), __float_as_uint(x), false, false); return __uint_as_float(rr[0]) + __uint_as_float(rr[1]); }
DI float quad_sum(float x) { x += dppf<0xB1>(x); x += dppf<0x4E>(x); return x; }
DI float row_maxf(float x) { x = fmaxf(x, dppf<0xB1>(x)); x = fmaxf(x, dppf<0x4E>(x)); x = fmaxf(x, dppf<0x124>(x)); x = fmaxf(x, dppf<0x128>(x)); return x; }
DI float row_minf(float x) { x = fminf(x, dppf<0xB1>(x)); x = fminf(x, dppf<0x4E>(x)); x = fminf(x, dppf<0x124>(x)); x = fminf(x, dppf<0x128>(x)); return x; }
DI int row_mini(int x) { int y; y = dppi<0xB1>(x); x = y < x ? y : x; y = dppi<0x4E>(x); x = y < x ? y : x; y = dppi<0x124>(x); x = y < x ? y : x; y = dppi<0x128>(x); x = y < x ? y : x; return x; }
DI float rdl(float x, int l) { return __int_as_float(__builtin_amdgcn_readlane(__float_as_int(x), l)); }
DI float wave_max_u(float x) { x = row_maxf(x); const float a = rdl(x, 0), b = rdl(x, 16), c = rdl(x, 32), d = rdl(x, 48); return fmaxf(fmaxf(a, b), fmaxf(c, d)); }
DI float wave_min_u(float x) { x = row_minf(x); const float a = rdl(x, 0), b = rdl(x, 16), c = rdl(x, 32), d = rdl(x, 48); return fminf(fminf(a, b), fminf(c, d)); }
DI int wave_min_ui(int x) { x = row_mini(x); const int a = __builtin_amdgcn_readlane(x, 0), b = __builtin_amdgcn_readlane(x, 16), c = __builtin_amdgcn_readlane(x, 32), d = __builtin_amdgcn_readlane(x, 48); const int ab = a < b ? a : b, cd = c < d ? c : d; return ab < cd ? ab : cd; }

DI void phase_cmp2_scan(Frame& F, const Params& P) {
    const int lane = F.lane;
    { const float* hp = WSP(float, WS_HC); const float* w2 = P.in[10];
      for (int row = F.bid * NWAVES + F.wave; row < 4 * 1024; row += F.G * NWAVES) {
        const int zg = row >> 10, n = row & 1023, z = zg >> 1, g = zg & 1;
        f32x4 hv = *(const f32x4*)(WSP(float, WS_BIASC) + z * 256 + 4 * lane);
#pragma unroll
        for (int ks = 0; ks < 4; ++ks) hv += *(const f32x4*)(hp + ((size_t)(ks * 4 + zg) * 1024 + n) * 256 + 4 * lane);
        const float h0 = gelu_tanh(hv[0]), h1 = gelu_tanh(hv[1]), h2 = gelu_tanh(hv[2]), h3 = gelu_tanh(hv[3]);
        const float* w = w2 + (size_t)z * 256 * 64 + lane;
        float a = 0.f;
#pragma unroll 8
        for (int q = 0; q < 64; ++q) { a += rdl(h0, q) * w[(4 * q) * 64]; a += rdl(h1, q) * w[(4 * q + 1) * 64]; a += rdl(h2, q) * w[(4 * q + 2) * 64]; a += rdl(h3, q) * w[(4 * q + 3) * 64]; }
        if (z == 0) WSP(bf16_t, WS_KC)[((size_t)g * 1024 + n) * 64 + lane] = (bf16_t)f2bf(a);
        else WSP(bf16_t, WS_VCT)[(size_t)g * 64 * 1024 + ((size_t)(n >> 5) * 64 + lane) * 32 + (n & 31)] = (bf16_t)f2bf(a);
      } }
    { const int h = F.wave;
      for (int kb = F.bid; kb < S / 64; kb += F.G) {
        const u32x4* kr = (const u32x4*)(WSP(bf16_t, WS_FK) + ((size_t)h * S + kb * 64 + lane) * 64); float a = 0.f;
#pragma unroll
        for (int c = 0; c < 8; ++c) { const u32x4 wv = kr[c];
#pragma unroll
            for (int q = 0; q < 4; ++q) { const float lo = __builtin_bit_cast(float, wv[q] << 16), hi2 = __builtin_bit_cast(float, wv[q] & 0xffff0000u); a += lo * lo + hi2 * hi2; } }
        a = wave_max_u(a);
        if (lane == 0) WSP(float, WS_KMAX)[kb * 8 + h] = a;
      } }
    const int hb = F.G - 1 - F.bid;
    if (hb >= 0 && hb < 8) {
        const int h = hb; const float* lf = WSP(float, WS_LOGF); float* fc = WSP(float, WS_FC) + (size_t)h * S;
        LAS double* red = (LAS double*)F.lds;
        double loc = 0.0; const int t0 = F.tid * 32; float v[32];
#pragma unroll
        for (int i = 0; i < 32; ++i) { v[i] = lf[(size_t)(t0 + i) * 8 + h]; loc += (double)v[i]; }
        double inc = loc;
#pragma unroll
        for (int o = 1; o < 64; o <<= 1) { const double up = __shfl_up(inc, o); if (lane >= o) inc += up; }
        if (lane == 63) red[F.wave] = inc;
        __syncthreads();
        double run = inc - loc;
        for (int w = 0; w < F.wave; ++w) run += red[w];
#pragma unroll
        for (int i = 0; i < 32; ++i) { run += (double)v[i]; fc[t0 + i] = (float)run; }
        __syncthreads();
    }
}


constexpr int PSLC_LD = 272, XLD = 65, TB_LD = 132;
constexpr int AW_SEL = 512;
constexpr int AW_PSLC = 8 * PSLC_LD * 4;
constexpr int KROW = 144, VROW = 80;
constexpr int ST_K = 0, ST_V = 64 * KROW, ST_B = ST_V + 2 * 64 * VROW, ST_BYTES = ST_B + 256;
constexpr int AL_SELM = 0, AL_PSLC = NWAVES * AW_SEL, AL_STAGE = AL_PSLC + NWAVES * AW_PSLC, AL_TB = 135 * 1024, AL_FLAG = AL_TB + 2 * 4 * TB_LD * 4, AL_END = AL_FLAG + 128;
constexpr int SEL_TB = 3;
constexpr int AL_SEL2 = AL_PSLC, SEL2_BYTES = SEL_TB * ST_B;
static_assert(AL_SEL2 + 2 * SEL2_BYTES <= AL_TB && AL_STAGE + 2 * ST_BYTES <= AL_TB, "stages fit below the bias tables");
static_assert(AL_END <= LDS_MISC, "attention LDS map");

template <int SD, bool HAS_V, bool HAS_F, int TB = 1, int BASE = AL_STAGE, class Body>
DI void stream_tiles(Frame& F, const bf16_t* __restrict__ K, const bf16_t* __restrict__ Vtb, const float* __restrict__ Fk, float fref, int kv_first, int kv_step, int nt, Body&& body) {
    constexpr int STG = TB == 1 ? ST_BYTES : TB * ST_B;
    LAS unsigned char* st0 = F.lds + BASE;
    volatile LAS unsigned* flags = (volatile LAS unsigned*)(F.lds + AL_FLAG);
    const int tid = F.tid;
    const int krow = tid >> 3, kc = tid & 7;
    const int vsub = tid >> 8, vd = (tid & 255) >> 2, vc = tid & 3;
    const unsigned kdst = krow * KROW + kc * 16, vdst = ST_V + vsub * 64 * VROW + vd * VROW + vc * 16;
    const bf16_t* kbase = K + (size_t)krow * 64 + kc * 8; const bf16_t* vbase = HAS_V ? Vtb + tid * 8 : nullptr;
    u32x4 rk[SD][TB], rv[SD][TB]; float rf[SD];
#define ST_GLOAD(slot, kv0_) do { const int _kv = (kv0_); _Pragma("unroll") for (int _b = 0; _b < TB; ++_b) { rk[slot][_b] = *(const u32x4*)(kbase + (size_t)(_kv + 64 * _b) * 64); \
        if (HAS_V) rv[slot][_b] = *(const u32x4*)(vbase + (size_t)((_kv >> 5) + 2 * _b) * 2048); } if (HAS_F) { if (tid < 64) rf[slot] = Fk[_kv + tid]; } } while (0)
#define ST_LSTORE(stp, slot) do { LAS unsigned char* _st = (stp); _Pragma("unroll") for (int _b = 0; _b < TB; ++_b) { *(LAS u32x4*)(_st + _b * ST_B + kdst) = rk[slot][_b]; if (HAS_V) *(LAS u32x4*)(_st + _b * ST_B + vdst) = rv[slot][_b]; } \
        if (HAS_F) { if (tid < 64) *(LAS float*)(_st + ST_B + tid * 4) = (fref - rf[slot]) * LOG2E; } } while (0)
    if (nt <= 0) return;
    if (HAS_F) { if (tid < 16) flags[tid] = 0u; }
    ST_GLOAD(0, kv_first);
#pragma unroll
    for (int d = 1; d < SD; ++d) if (d < nt) ST_GLOAD(d, kv_first + d * kv_step);
    ST_LSTORE(st0, 0);
    if (SD < nt) ST_GLOAD(0, kv_first + SD * kv_step);
    __syncthreads();
    bool stop = false;
    for (int it0 = 0; it0 < nt && !stop; it0 += SD) {
#pragma unroll
        for (int d = 0; d < SD; ++d) {
            const int it = it0 + d;
            if (it >= nt || stop) break;
            const int par = (SD % 2 == 0) ? (d & 1) : (it & 1);
            __builtin_amdgcn_sched_barrier(0);
            const bool done = body(kv_first + it * kv_step, st0 + par * STG);
            __builtin_amdgcn_sched_barrier(0);
            if (it + 1 < nt) { ST_LSTORE(st0 + (par ^ 1) * STG, (d + 1) % SD); if (it + 1 + SD < nt) ST_GLOAD((d + 1) % SD, kv_first + (it + 1 + SD) * kv_step); }
            if constexpr (HAS_F) { if (F.lane == 0) flags[par * 8 + F.wave] = done ? 1u : 0u; } else { (void)done; }
            __syncthreads();
            if constexpr (HAS_F) {
                const u32x4 fa = *(volatile LAS u32x4*)(F.lds + AL_FLAG + par * 32), fb = *(volatile LAS u32x4*)(F.lds + AL_FLAG + par * 32 + 16);
                if ((fa[0] & fa[1] & fa[2] & fa[3] & fb[0] & fb[1] & fb[2] & fb[3]) != 0u) stop = true; }
        }
    }
    asm volatile("s_waitcnt vmcnt(0)" ::: "memory");
    __syncthreads();
#undef ST_GLOAD
#undef ST_LSTORE
}

DI void lds_k(bf16x8 (&kf)[4], const LAS unsigned char* st, int sub, int lane) {
    const LAS unsigned char* p = st + ST_K + (32 * sub + perm23(lane & 31)) * KROW + 16 * (lane >> 5);
#pragma unroll
    for (int ks = 0; ks < 4; ++ks) kf[ks] = *(const LAS bf16x8*)(p + 32 * ks);
}
DI void lds_v(bf16x8 (&vf)[4], const LAS unsigned char* st, int sub, int lane) {
    const LAS unsigned char* p = st + ST_V + sub * 64 * VROW + (lane & 31) * VROW + 16 * (lane >> 5);
#pragma unroll
    for (int d0 = 0; d0 < 2; ++d0)
#pragma unroll
        for (int s2 = 0; s2 < 2; ++s2) vf[d0 * 2 + s2] = *(const LAS bf16x8*)(p + d0 * 32 * VROW + 32 * s2);
}
DI f32x16 qk32f(const bf16x8 (&qf)[4], const bf16x8 (&kf)[4]) {
    f32x16 s;
#pragma unroll
    for (int r = 0; r < 16; ++r) s[r] = 0.f;
#pragma unroll
    for (int ks = 0; ks < 4; ++ks) s = mfma32(kf[ks], qf[ks], s);
    return s;
}
DI void pv32f(f32x16 (&o)[2], const f32x16& p, const bf16x8 (&vf)[4]) {
    bf16x8 pf[2];
#pragma unroll
    for (int s2 = 0; s2 < 2; ++s2) { u32x4 w; w.x = cvtpk(p[8 * s2 + 0], p[8 * s2 + 1]); w.y = cvtpk(p[8 * s2 + 2], p[8 * s2 + 3]); w.z = cvtpk(p[8 * s2 + 4], p[8 * s2 + 5]); w.w = cvtpk(p[8 * s2 + 6], p[8 * s2 + 7]); pf[s2] = __builtin_bit_cast(bf16x8, w); }
#pragma unroll
    for (int d0 = 0; d0 < 2; ++d0)
#pragma unroll
        for (int s2 = 0; s2 < 2; ++s2) o[d0] = mfma32(vf[d0 * 2 + s2], pf[s2], o[d0]);
}
DI float max16(const f32x16& s) {
    float mx = fmaxf(fmaxf(s[0], s[1]), fmaxf(s[2], s[3]));
#pragma unroll
    for (int r = 4; r < 16; r += 4) mx = fmaxf(mx, fmaxf(fmaxf(s[r], s[r + 1]), fmaxf(s[r + 2], s[r + 3])));
    return mx;
}
DI float online_upd(float mx, float& m, float& l, float& mu_out) {
    mx = xmax32(mx);
    const float mn = fmaxf(m, mx), mu = (mn == NEG_INF) ? 0.f : mn;
    const float alpha = fexp2(m - mu);
    l *= alpha; m = mn; mu_out = mu;
    return alpha;
}
DI void exp16(f32x16& s, float mu, float& l) {
    float ps = 0.f;
#pragma unroll
    for (int r = 0; r < 16; ++r) { s[r] = fexp2(s[r] - mu); ps += s[r]; }
    l += ps;
}

DI void fox_task(Frame& F, int h, int qb) {
    const int lane = F.lane, i = lane & 31, hi = lane >> 5, w = F.wave;
    const bf16_t* Q = WSP(bf16_t, WS_FQ) + (size_t)h * S * 64;
    const bf16_t* K = WSP(bf16_t, WS_FK) + (size_t)h * S * 64;
    const bf16_t* Vt = WSP(bf16_t, WS_FVT) + (size_t)h * 64 * S;
    const float* Fc = WSP(float, WS_FC) + (size_t)h * S;
    const int q0 = qb * 256, r0 = q0 + 32 * w, t = r0 + i;
    bf16x8 qf[4];
#pragma unroll
    for (int ks = 0; ks < 4; ++ks) qf[ks] = *(const bf16x8*)(Q + (size_t)t * 64 + 16 * ks + 8 * hi);
    asm volatile("" : "+v"(qf[0]), "+v"(qf[1]), "+v"(qf[2]), "+v"(qf[3]));
    const float fref = Fc[q0];
    float qn2 = 0.f;
#pragma unroll
    for (int ks = 0; ks < 4; ++ks)
#pragma unroll
        for (int j = 0; j < 8; ++j) { const float qv = bf2f((bf16_t)qf[ks][j]); qn2 += qv * qv; }
    qn2 = xadd32(qn2);
    float km2 = 0.f; { const float* kp = WSP(float, WS_KMAX) + h;
#pragma unroll
      for (int c = 0; c < 4; ++c) km2 = fmaxf(km2, kp[(lane + 64 * c) * 8]); }
    const float qkb = sqrtf(wave_max_u(qn2) * wave_max_u(km2)) * 1.01f;
    float m = NEG_INF, l = 0.f; f32x16 o[2];
#pragma unroll
    for (int r = 0; r < 16; ++r) { o[0][r] = 0.f; o[1][r] = 0.f; }
    constexpr float FOX_SKIP = 44.f;
    bool wdone = false;
    stream_tiles<4, true, true>(F, K, Vt, Fc, fref, q0 + 192, -64, qb * 4 + 4, [&](int kv0, const LAS unsigned char* st) __attribute__((always_inline)) -> bool {
        if (wdone) return true;
        if (kv0 > r0) return false;
        const bool two = (kv0 + 32 <= r0);
        bf16x8 kf[4]; f32x16 s0, s1;
        lds_k(kf, st, 0, lane); s0 = qk32f(qf, kf);
        { const LAS float* bp = (const LAS float*)(st + ST_B) + 8 * hi; const f32x4 b0 = *(const LAS f32x4*)(bp), b1 = *(const LAS f32x4*)(bp + 4), b2 = *(const LAS f32x4*)(bp + 16), b3 = *(const LAS f32x4*)(bp + 20);
#pragma unroll
          for (int r = 0; r < 16; ++r) s0[r] += (r < 4) ? b0[r & 3] : (r < 8) ? b1[r & 3] : (r < 12) ? b2[r & 3] : b3[r & 3]; }
        if (kv0 == r0) {
#pragma unroll
            for (int r = 0; r < 16; ++r) { const int key = kv0 + 16 * (r >> 3) + 8 * hi + (r & 7); s0[r] = (key <= t) ? s0[r] : NEG_INF; } }
        float mx = max16(s0);
        if (two) {
            lds_k(kf, st, 1, lane); s1 = qk32f(qf, kf);
            const LAS float* bp = (const LAS float*)(st + ST_B) + 32 + 8 * hi; const f32x4 b0 = *(const LAS f32x4*)(bp), b1 = *(const LAS f32x4*)(bp + 4), b2 = *(const LAS f32x4*)(bp + 16), b3 = *(const LAS f32x4*)(bp + 20);
#pragma unroll
            for (int r = 0; r < 16; ++r) s1[r] += (r < 4) ? b0[r & 3] : (r < 8) ? b1[r & 3] : (r < 12) ? b2[r & 3] : b3[r & 3];
            if (kv0 + 32 == r0) {
#pragma unroll
                for (int r = 0; r < 16; ++r) { const int key = kv0 + 32 + 16 * (r >> 3) + 8 * hi + (r & 7); s1[r] = (key <= t) ? s1[r] : NEG_INF; } }
            mx = fmaxf(mx, max16(s1));
        }
        float mu; const float alpha = online_upd(mx, m, l, mu);
        o[0] *= alpha; o[1] *= alpha;
        bf16x8 vf[4];
        exp16(s0, mu, l); lds_v(vf, st, 0, lane); pv32f(o, s0, vf);
        if (two) { exp16(s1, mu, l); lds_v(vf, st, 1, lane); pv32f(o, s1, vf); }
        const float b_first = *((const LAS float*)(st + ST_B));
        wdone = (qkb + b_first < wave_min_u(m) - FOX_SKIP);
        return wdone;
    });
    l = xadd32(l);
    const float inv = l > 0.f ? 1.f / l : 0.f;
    bf16_t* O = WSP(bf16_t, WS_O) + (size_t)t * 1024 + 512 + h * 64;
#pragma unroll
    for (int d0 = 0; d0 < 2; ++d0)
#pragma unroll
        for (int g4 = 0; g4 < 4; ++g4) { u32x2 wv; wv.x = cvtpk(o[d0][4 * g4] * inv, o[d0][4 * g4 + 1] * inv); wv.y = cvtpk(o[d0][4 * g4 + 2] * inv, o[d0][4 * g4 + 3] * inv);
            *(u32x2*)(O + 32 * d0 + 8 * g4 + 4 * hi) = wv; }
}

DI void t5_near(f32x16& s, const LAS float* tb, int dbase, int kstride, int key0, int hi, int dmax) {
#pragma unroll
    for (int r = 0; r < 16; ++r) { const int key = key0 + 16 * (r >> 3) + 8 * hi + (r & 7); const int dist = dbase - kstride * key;
        const int idx = dist < 0 ? 0 : (dist < 128 ? dist : 128); const float bv = tb[idx];
        s[r] = (dist >= 0 && dist < dmax) ? s[r] + bv : NEG_INF; }
}

DI void nsa_task(Frame& F, int g, int tg0, LAS float* pslc, LAS unsigned* selm, const LAS float* tbg) {
    const int lane = F.lane, i = lane & 31, hi = lane >> 5, tl = i >> 2, hh = i & 3, t0 = tg0 + 8 * F.wave, t = t0 + tl;
    const bf16_t* Q = WSP(bf16_t, WS_QN) + (size_t)(g * 4 + hh) * S * 64 + (size_t)t * 64;
    const bf16_t* Kc = WSP(bf16_t, WS_KC) + (size_t)g * 1024 * 64; const bf16_t* VcT = WSP(bf16_t, WS_VCT) + (size_t)g * 64 * 1024;
    const LAS float* tb = tbg + hh * TB_LD;
    const float tbfar = tb[128];
    bf16x8 qf[4];
#pragma unroll
    for (int ks = 0; ks < 4; ++ks) qf[ks] = *(const bf16x8*)(Q + 16 * ks + 8 * hi);
    asm volatile("" : "+v"(qf[0]), "+v"(qf[1]), "+v"(qf[2]), "+v"(qf[3]));
    const float* gn = WSP(float, WS_GN) + (size_t)t * 24 + g * 12 + hh * 3;
    const float g0 = gn[0], g2 = gn[2];
    const int tmax = t0 + 7;
    const int nt_c = (((tg0 + 63 - 31) >> 4) >> 6) + 1;
    float m = NEG_INF, l = 0.f;
    stream_tiles<2, false, false>(F, Kc, nullptr, nullptr, 0.f, 0, 64, nt_c, [&](int n0, const LAS unsigned char* st) __attribute__((always_inline)) -> bool {
#pragma unroll
        for (int sub = 0; sub < 2; ++sub) { const int ns = n0 + 32 * sub;
            if (16 * ns + 31 > tmax) continue;
            bf16x8 kf[4]; lds_k(kf, st, sub, lane); f32x16 s = qk32f(qf, kf);
            if (t0 - 16 * (ns + 31) - 31 >= 128) {
#pragma unroll
                for (int r = 0; r < 16; ++r) s[r] += tbfar; }
            else t5_near(s, tb, t - 31, 16, ns, hi, 1 << 30);
            float mu; (void)online_upd(max16(s), m, l, mu); exp16(s, mu, l);
        }
        return false; });
    l = xadd32(l);
    const float invl = l > 0.f ? 1.f / l : 0.f, mu = (m == NEG_INF) ? 0.f : m;
    float carry = 0.f;
    f32x16 oc[2];
#pragma unroll
    for (int r = 0; r < 16; ++r) { oc[0][r] = 0.f; oc[1][r] = 0.f; }
    stream_tiles<2, true, false>(F, Kc, VcT, nullptr, 0.f, 0, 64, nt_c, [&](int n0, const LAS unsigned char* st) __attribute__((always_inline)) -> bool {
#pragma unroll
        for (int sub = 0; sub < 2; ++sub) { const int ns = n0 + 32 * sub;
            if (16 * ns + 31 > tmax) continue;
            bf16x8 kf[4]; lds_k(kf, st, sub, lane); f32x16 s = qk32f(qf, kf);
            if (t0 - 16 * (ns + 31) - 31 >= 128) {
#pragma unroll
                for (int r = 0; r < 16; ++r) s[r] += tbfar; }
            else t5_near(s, tb, t - 31, 16, ns, hi, 1 << 30);
#pragma unroll
            for (int r = 0; r < 16; ++r) s[r] = fexp2(s[r] - mu) * invl;
            bf16x8 vf[4]; lds_v(vf, st, sub, lane); pv32f(oc, s, vf);
            { float a[4], b[4];
#pragma unroll
              for (int G4 = 0; G4 < 4; ++G4) { a[G4] = quad_sum(s[4 * G4] + s[4 * G4 + 1] + s[4 * G4 + 2] + 0.5f * s[4 * G4 + 3]); b[G4] = quad_sum(0.5f * s[4 * G4 + 3]); }
              const auto r1 = __builtin_amdgcn_permlane32_swap(__float_as_uint(b[1]), __float_as_uint(b[1]), false, false), r3 = __builtin_amdgcn_permlane32_swap(__float_as_uint(b[3]), __float_as_uint(b[3]), false, false);
              const float x1 = __uint_as_float(hi ? r1[0] : r1[1]), x3 = __uint_as_float(hi ? r3[0] : r3[1]);
              if (hh == 0) { LAS float* pr = pslc + tl * PSLC_LD + (ns >> 2) + 2 * hi;
                  pr[0] = a[0] + (hi ? x1 : carry); pr[1] = a[1] + b[0]; pr[4] = a[2] + (hi ? x3 : x1); pr[5] = a[3] + b[2]; }
              carry = x3; }
        }
        return false; });
    asm volatile("s_waitcnt lgkmcnt(0)" ::: "memory"); __builtin_amdgcn_wave_barrier();
    { const int cur = t0 >> 6;
      if (cur <= 15) { if (lane < 64) selm[lane] = ((lane & 7) == 0) ? ((2u << cur) - 1u) : 0u; }
      else {
#pragma unroll 1
        for (int k8 = 0; k8 < 8; ++k8) {
            float v[4];
#pragma unroll
            for (int k = 0; k < 4; ++k) { const int j = lane + 64 * k; v[k] = (j >= 1 && j <= cur - 2) ? pslc[k8 * PSLC_LD + j] : -1.f; }
            unsigned tb_ = 0u;
#pragma unroll 1
            for (int bit = 30; bit >= 0; --bit) { const float th = __uint_as_float(tb_ | (1u << bit));
                const int c = __builtin_popcountll(__ballot(v[0] >= th)) + __builtin_popcountll(__ballot(v[1] >= th)) + __builtin_popcountll(__ballot(v[2] >= th)) + __builtin_popcountll(__ballot(v[3] >= th));
                if (c >= 13) tb_ |= (1u << bit);
                if (c == 13) break; }
            const float T = __uint_as_float(tb_);
            unsigned long long sel[4]; int ngt = 0;
#pragma unroll
            for (int k = 0; k < 4; ++k) { sel[k] = __ballot(v[k] > T); ngt += __builtin_popcountll(sel[k]); }
            int need = 13 - ngt;
#pragma unroll
            for (int k = 0; k < 4; ++k) { unsigned long long eq = __ballot(v[k] == T); while (need > 0 && eq) { const unsigned long long low = eq & (0ull - eq); sel[k] |= low; eq ^= low; --need; } }
            unsigned mk[8];
#pragma unroll
            for (int k = 0; k < 4; ++k) { mk[2 * k] = (unsigned)sel[k]; mk[2 * k + 1] = (unsigned)(sel[k] >> 32); }
#pragma unroll
            for (int w = 0; w < 8; ++w) { if (w == 0) mk[w] |= 1u; if ((cur >> 5) == w) mk[w] |= 1u << (cur & 31); if (((cur - 1) >> 5) == w) mk[w] |= 1u << ((cur - 1) & 31); }
#pragma unroll
            for (int w = 0; w < 8; ++w) if (lane == w) selm[k8 * 8 + w] = mk[w];
        } } }
    asm volatile("s_waitcnt lgkmcnt(0)" ::: "memory"); __builtin_amdgcn_wave_barrier();
    const bf16_t* Sk = WSP(bf16_t, WS_SK) + (size_t)g * S * 64; const bf16_t* SvT = WSP(bf16_t, WS_SVT) + (size_t)g * 64 * S;
    const int n16 = lane & 15, kq = lane >> 4;
    LAS float* xch = pslc;
    float* XG = WSP(float, WS_U) + (size_t)t * 512 + g * 256 + hh * 64;
#pragma unroll
    for (int d0 = 0; d0 < 2; ++d0)
#pragma unroll
        for (int g4 = 0; g4 < 4; ++g4) *(f32x4*)(XG + 32 * d0 + 8 * g4 + 4 * hi) = (f32x4){g0 * oc[d0][4 * g4], g0 * oc[d0][4 * g4 + 1], g0 * oc[d0][4 * g4 + 2], g0 * oc[d0][4 * g4 + 3]};
    const bf16_t* Wk = WSP(bf16_t, WS_WK) + (size_t)g * S * 64; const bf16_t* WvT = WSP(bf16_t, WS_WVT) + (size_t)g * 64 * S;
    float mw = NEG_INF, lw = 0.f; f32x16 ow[2];
#pragma unroll
    for (int r = 0; r < 16; ++r) { ow[0][r] = 0.f; ow[1][r] = 0.f; }
    { const int lo = tg0 - 511 > 0 ? tg0 - 511 : 0; const int kvs = lo & ~63; const int nt_w = ((tg0 - kvs) >> 6) + 1;
      if (!(NSAP & 2)) stream_tiles<2, true, false>(F, Wk, WvT, nullptr, 0.f, kvs, 64, nt_w, [&](int kv0, const LAS unsigned char* st) __attribute__((always_inline)) -> bool {
#pragma unroll
        for (int sub = 0; sub < 2; ++sub) { const int ks0 = kv0 + 32 * sub;
            if (!((ks0 <= tmax) && (t0 - (ks0 + 31) < 512))) continue;
            __builtin_amdgcn_sched_barrier(0);
            bf16x8 kf[4]; lds_k(kf, st, sub, lane); f32x16 sw = qk32f(qf, kf);
            if (t0 - ks0 - 31 >= 128 && tmax - ks0 < 512) {
#pragma unroll
                for (int r = 0; r < 16; ++r) sw[r] += tbfar; }
            else t5_near(sw, tb, t, 1, ks0, hi, 512);
            float mu2; const float alpha = online_upd(max16(sw), mw, lw, mu2);
            ow[0] *= alpha; ow[1] *= alpha;
            exp16(sw, mu2, lw); bf16x8 vf[4]; lds_v(vf, st, sub, lane); pv32f(ow, sw, vf);
            __builtin_amdgcn_sched_barrier(0);
        }
        return false; }); }
    lw = xadd32(lw);
    { const float invw = lw > 0.f ? g2 / lw : 0.f;
      asm volatile("s_waitcnt vmcnt(0)" ::: "memory");
#pragma unroll
      for (int d0 = 0; d0 < 2; ++d0)
#pragma unroll
        for (int g4 = 0; g4 < 4; ++g4) { f32x4 v = *(const f32x4*)(XG + 32 * d0 + 8 * g4 + 4 * hi);
            v[0] += invw * ow[d0][4 * g4]; v[1] += invw * ow[d0][4 * g4 + 1]; v[2] += invw * ow[d0][4 * g4 + 2]; v[3] += invw * ow[d0][4 * g4 + 3];
            *(f32x4*)(XG + 32 * d0 + 8 * g4 + 4 * hi) = v; } }
#if BMS
    { unsigned* SG = WSP(unsigned, WS_SELMG);
      SG[((size_t)(t0 + (lane >> 3)) * 2 + g) * 8 + (lane & 7)] = selm[lane];
      if (F.tid < 256) { const int j = F.tid; int c = 0;
#pragma unroll
          for (int w8 = 0; w8 < 8; ++w8) { const LAS unsigned* sw = (const LAS unsigned*)(F.lds + AL_SELM + w8 * AW_SEL);
#pragma unroll
              for (int k8 = 0; k8 < 8; ++k8) c += (int)((sw[k8 * 8 + (j >> 5)] >> (j & 31)) & 1u); }
          WSP(int, WS_HISTB)[((size_t)g * 256 + (tg0 >> 6)) * 256 + j] = c; } }
}

#else
    {
        LAS unsigned* um = selm + 64;
        if (lane < 16) { const int qd = lane >> 3, w = lane & 7; um[lane] = selm[(4 * qd + 0) * 8 + w] | selm[(4 * qd + 1) * 8 + w] | selm[(4 * qd + 2) * 8 + w] | selm[(4 * qd + 3) * 8 + w]; }
        asm volatile("s_waitcnt lgkmcnt(0)" ::: "memory"); __builtin_amdgcn_wave_barrier();
        const int hq = n16 & 3;
        const LAS float* tb2 = tbg + hq * TB_LD; const float tbfar2 = tb2[128];
        bf16x8 q2[2][2]; float m2[2], l2[2], gs[2]; f32x4 o2[2][4];
#pragma unroll
        for (int qd = 0; qd < 2; ++qd) { const int ts = t0 + 4 * qd + (n16 >> 2);
            const bf16_t* Q2 = WSP(bf16_t, WS_QN) + (size_t)(g * 4 + hq) * S * 64 + (size_t)ts * 64;
            q2[qd][0] = *(const bf16x8*)(Q2 + 8 * kq); q2[qd][1] = *(const bf16x8*)(Q2 + 32 + 8 * kq);
            asm volatile("" : "+v"(q2[qd][0]), "+v"(q2[qd][1]));
            gs[qd] = WSP(float, WS_GN)[(size_t)ts * 24 + g * 12 + hq * 3 + 1];
            m2[qd] = NEG_INF; l2[qd] = 0.f;
#pragma unroll
            for (int dt = 0; dt < 4; ++dt) o2[qd][dt] = (f32x4){0.f, 0.f, 0.f, 0.f}; }
        const unsigned kfo = ST_K + (8 * (n16 >> 2) + (n16 & 3)) * KROW + 16 * kq, vfo = ST_V + n16 * VROW + 16 * kq;
        unsigned umw[2] = {0u, 0u}, ownw[2] = {0u, 0u};
        if (!(NSAP & 1)) stream_tiles<1, true, false, SEL_TB, AL_SEL2>(F, Sk, SvT, nullptr, 0.f, 0, 64 * SEL_TB, ((tg0 >> 6) + SEL_TB) / SEL_TB, [&](int kvt, const LAS unsigned char* stt) __attribute__((always_inline)) -> bool {
#pragma unroll 1
          for (int bb = 0; bb < SEL_TB; ++bb) { const int kv0 = kvt + 64 * bb; const LAS unsigned char* st = stt + bb * ST_B;
            const int j = kv0 >> 6;
            if (j > (tg0 >> 6)) break;
            if ((j & 31) == 0) {
#pragma unroll
                for (int qd = 0; qd < 2; ++qd) { umw[qd] = __builtin_amdgcn_readfirstlane(um[qd * 8 + (j >> 5)]); ownw[qd] = selm[(4 * qd + (n16 >> 2)) * 8 + (j >> 5)]; } }
#pragma unroll
            for (int qd = 0; qd < 2; ++qd) {
                __builtin_amdgcn_sched_barrier(0);
                if (!((umw[qd] >> (j & 31)) & 1u)) continue;
                const int tq = 4 * qd + (n16 >> 2), ts = t0 + tq, tsmin = t0 + 4 * qd;
                const bool selok = (ownw[qd] >> (j & 31)) & 1u;
                f32x4 sc[2][2];
#pragma unroll
                for (int gq = 0; gq < 2; ++gq)
#pragma unroll
                    for (int ab = 0; ab < 2; ++ab) { const LAS unsigned char* kp = st + kfo + (32 * gq + 4 * ab) * KROW;
                        f32x4 a = (f32x4){0.f, 0.f, 0.f, 0.f}; a = mfma16(*(const LAS bf16x8*)(kp), q2[qd][0], a); a = mfma16(*(const LAS bf16x8*)(kp + 64), q2[qd][1], a); sc[gq][ab] = a; }
                float mx = NEG_INF;
                if (tsmin - (kv0 + 63) >= 128) {
                    const float add = selok ? tbfar2 : NEG_INF;
#pragma unroll
                    for (int gq = 0; gq < 2; ++gq)
#pragma unroll
                        for (int ab = 0; ab < 2; ++ab)
#pragma unroll
                            for (int r = 0; r < 4; ++r) { const float v = sc[gq][ab][r] + add; sc[gq][ab][r] = v; mx = fmaxf(mx, v); }
                } else {
#pragma unroll
                    for (int gq = 0; gq < 2; ++gq)
#pragma unroll
                        for (int ab = 0; ab < 2; ++ab)
#pragma unroll
                            for (int r = 0; r < 4; ++r) { const int key = kv0 + 32 * gq + 8 * kq + 4 * ab + r; const int dist = ts - key;
                                const int idx = dist < 0 ? 0 : (dist < 128 ? dist : 128); const float bv = tb2[idx];
                                const float v = (selok && dist >= 0) ? sc[gq][ab][r] + bv : NEG_INF; sc[gq][ab][r] = v; mx = fmaxf(mx, v); }
                }
                mx = xmax16(mx); mx = xmax32(mx);
                const float mn = fmaxf(m2[qd], mx), mu2 = (mn == NEG_INF) ? 0.f : mn; const float alpha = fexp2(m2[qd] - mu2);
                float ps = 0.f;
#pragma unroll
                for (int gq = 0; gq < 2; ++gq)
#pragma unroll
                    for (int ab = 0; ab < 2; ++ab)
#pragma unroll
                        for (int r = 0; r < 4; ++r) { const float p = fexp2(sc[gq][ab][r] - mu2); sc[gq][ab][r] = p; ps += p; }
                l2[qd] = l2[qd] * alpha + ps; m2[qd] = mn;
#pragma unroll
                for (int dt = 0; dt < 4; ++dt) o2[qd][dt] *= alpha;
#pragma unroll
                for (int gq = 0; gq < 2; ++gq) {
                    u32x4 pw; pw.x = cvtpk(sc[gq][0][0], sc[gq][0][1]); pw.y = cvtpk(sc[gq][0][2], sc[gq][0][3]); pw.z = cvtpk(sc[gq][1][0], sc[gq][1][1]); pw.w = cvtpk(sc[gq][1][2], sc[gq][1][3]);
                    const bf16x8 pf = __builtin_bit_cast(bf16x8, pw);
#pragma unroll
                    for (int dt = 0; dt < 4; ++dt) o2[qd][dt] = mfma16(*(const LAS bf16x8*)(st + vfo + gq * 64 * VROW + 16 * dt * VROW), pf, o2[qd][dt]);
                }
            }
          }
            return false; });
#pragma unroll
        for (int qd = 0; qd < 2; ++qd) {
            float lt = xadd16(l2[qd]); lt = xadd32(lt);
            const float inv2 = lt > 0.f ? gs[qd] / lt : 0.f;
#pragma unroll
            for (int dt = 0; dt < 4; ++dt)
#pragma unroll
                for (int r = 0; r < 4; ++r) xch[(16 * qd + n16) * XLD + 16 * dt + 4 * kq + r] = inv2 * o2[qd][dt][r];
        }
        asm volatile("s_waitcnt lgkmcnt(0)" ::: "memory"); __builtin_amdgcn_wave_barrier();
    }
    { bf16_t* O = WSP(bf16_t, WS_O) + (size_t)t * 1024 + g * 256 + hh * 64;
#pragma unroll
      for (int d0 = 0; d0 < 2; ++d0)
#pragma unroll
        for (int g4 = 0; g4 < 4; ++g4) { const f32x4 a = *(const f32x4*)(XG + 32 * d0 + 8 * g4 + 4 * hi); float v[4];
#pragma unroll
            for (int q = 0; q < 4; ++q) v[q] = a[q] + xch[i * XLD + 32 * d0 + 8 * g4 + 4 * hi + q];
            u32x2 wv; wv.x = cvtpk(v[0], v[1]); wv.y = cvtpk(v[2], v[3]); *(u32x2*)(O + 32 * d0 + 8 * g4 + 4 * hi) = wv; } }
    asm volatile("s_waitcnt lgkmcnt(0)" ::: "memory"); __builtin_amdgcn_wave_barrier();
}

#endif
constexpr int NT_FOX = 8 * 64, NT_NSA = 2 * 256, NT_ATT = NT_FOX + NT_NSA;
DI void phase_attn(Frame& F, const Params& P, int rep) {
    LAS float* tball = (LAS float*)(F.lds + AL_TB);
    for (int q = F.tid; q < 2 * 4 * 129; q += NTHREADS) { const int dist = q % 129, gh = q / 129;
        int bucket; if (dist < 16) bucket = dist; else { const float rr = logf((float)dist / 16.f) / 2.0794415416798357f * 16.f; const int big = 16 + (int)rr; bucket = big < 31 ? big : 31; }
        tball[gh * TB_LD + dist] = P.in[6][bucket * 8 + gh] * LOG2E; }
    LAS float* pslc = (LAS float*)(F.lds + AL_PSLC + F.wave * AW_PSLC); LAS unsigned* selm = (LAS unsigned*)(F.lds + AL_SELM + F.wave * AW_SEL);
    volatile LAS int* tslot = (volatile LAS int*)(F.lds + AL_FLAG + 64);
    bool first = true;
    for (;;) {
        __syncthreads();
        if (F.tid == 0) *tslot = first ? F.bid : F.G + (int)atomicAdd(F.ctl + CW_QATT + 64 * rep, 1u);
        first = false;
        __syncthreads();
        const int task = __builtin_amdgcn_readfirstlane(*tslot);
        if (task >= (BMS ? NT_NSA : NT_ATT)) break;
        if (task < NT_NSA) { const int g = task & 1, tt = 255 - (task >> 1); nsa_task(F, g, tt * 64, pslc, selm, tball + g * 4 * TB_LD); }
        else { const int q = task - NT_NSA; fox_task(F, 7 - (q >> 6), 63 - (q & 63)); }
    }
}

#if BMS
DI void phase_bms_sort(Frame& F, const Params& P) {
    LAS unsigned* masks = (LAS unsigned*)F.lds;
    LAS int* pw = (LAS int*)(F.lds + 2048);
    LAS int* wsum = (LAS int*)(F.lds + 4096);
    const int* hist = WSP(int, WS_HISTB);
    for (int item = F.bid; item < 512; item += F.G) { const int g = item >> 8, T = item & 255;
        __syncthreads();
        masks[F.tid] = WSP(unsigned, WS_SELMG)[((size_t)(T * 64 + (F.tid >> 3)) * 2 + g) * 8 + (F.tid & 7)];
        int tot = 0, off = 0;
        if (F.tid < 256) { const int* hc = hist + (size_t)g * 256 * 256 + F.tid;
#pragma unroll 8
            for (int b = 0; b < 256; ++b) { const int hv = hc[b * 256]; tot += hv; off += (b < T) ? hv : 0; } }
        const int nu = (tot + 63) >> 6; int inc = nu;
#pragma unroll
        for (int o = 1; o < 64; o <<= 1) { const int up = __shfl_up(inc, o); if (F.lane >= o) inc += up; }
        if (F.lane == 63 && F.wave < 4) wsum[F.wave] = inc;
        __syncthreads();
        { const int tok = F.tid >> 3, w = F.tid & 7; int c = 0;
#pragma unroll
          for (int q = 0; q < 8; ++q) c += (q < w) ? __builtin_popcount(masks[tok * 8 + q]) : 0;
          pw[F.tid] = c; }
        const int w0 = wsum[0], w1 = wsum[1], w2 = wsum[2], w3 = wsum[3];
        const int ub_ = inc - nu + (F.wave > 0 ? w0 : 0) + (F.wave > 1 ? w1 : 0) + (F.wave > 2 ? w2 : 0);
        __syncthreads();
        if (F.tid < 256) { const int j = F.tid;
            if (T == 0) { int* ut = WSP(int, WS_UT) + g * (BMS_MAXU + 8); if (j == 0) ut[0] = w0 + w1 + w2 + w3; for (int c = 0; c < nu; ++c) ut[1 + ub_ + c] = j | (c << 16); }
            int* tk = WSP(int, WS_TOKL) + (size_t)g * BMS_MAXU * 64 + (size_t)ub_ * 64 + off; int run = 0;
            const unsigned bitm = 1u << (j & 31), lowm = bitm - 1u;
            for (int tok = 0; tok < 64; ++tok) { const unsigned wv = masks[tok * 8 + (j >> 5)];
                if (wv & bitm) { const int slot = pw[tok * 8 + (j >> 5)] + __builtin_popcount(wv & lowm); tk[run] = (T * 64 + tok) | (slot << 16); ++run; } } }
    }
    __syncthreads();
}

DI void lds_v_T(bf16x8 (&vf)[4], const LAS unsigned char* st, int sub, int lane) {
    const LAS unsigned char* p = st + ST_V + sub * 64 * VROW + 2 * (lane & 31) * VROW + 16 * (lane >> 5);
#pragma unroll
    for (int d0 = 0; d0 < 2; ++d0)
#pragma unroll
        for (int s2 = 0; s2 < 2; ++s2) vf[d0 * 2 + s2] = *(const LAS bf16x8*)(p + d0 * VROW + 32 * s2);
}
DI void pv32f_T(f32x16 (&o)[2], const f32x16& p, const bf16x8 (&vf)[4]) {
    bf16x8 pf[2];
#pragma unroll
    for (int s2 = 0; s2 < 2; ++s2) { u32x4 w; w.x = cvtpk(p[8 * s2 + 0], p[8 * s2 + 1]); w.y = cvtpk(p[8 * s2 + 2], p[8 * s2 + 3]); w.z = cvtpk(p[8 * s2 + 4], p[8 * s2 + 5]); w.w = cvtpk(p[8 * s2 + 6], p[8 * s2 + 7]); pf[s2] = __builtin_bit_cast(bf16x8, w); }
#pragma unroll
    for (int d0 = 0; d0 < 2; ++d0)
#pragma unroll
        for (int s2 = 0; s2 < 2; ++s2) o[d0] = mfma32(pf[s2], vf[d0 * 2 + s2], o[d0]);
}
constexpr int BMS_WGU = 36;
constexpr int BL_CODE = 0, BL_ENT = 256;
static_assert(BL_ENT + BMS_WGU * 256 <= AL_STAGE && 2 * BMS_MAXU <= 256 * (BMS_WGU - 2), "block-major unit lists");
DI void phase_bms_attn(Frame& F, const Params& P) {
    const int lane = F.lane, i = lane & 31, hi = lane >> 5, tl = i >> 2, hh = i & 3;
    LAS float* tball = (LAS float*)(F.lds + AL_TB);
    LAS int* lcode = (LAS int*)(F.lds + BL_CODE); LAS int* lent = (LAS int*)(F.lds + BL_ENT);
    __syncthreads();
    for (int q = F.tid; q < 2 * 4 * 129; q += NTHREADS) { const int dist = q % 129, gh = q / 129;
        int bucket; if (dist < 16) bucket = dist; else { const float rr = logf((float)dist / 16.f) / 2.0794415416798357f * 16.f; const int big = 16 + (int)rr; bucket = big < 31 ? big : 31; }
        tball[gh * TB_LD + dist] = P.in[6][bucket * 8 + gh] * LOG2E; }
    const int* ut = WSP(int, WS_UT); const int U0 = ut[0], U1 = ut[BMS_MAXU + 8], UT_ = U0 + U1;
    const int u_lo = (int)(((long)F.bid * UT_) / F.G), u_hi = (int)(((long)(F.bid + 1) * UT_) / F.G), nu = u_hi - u_lo;
    for (int q = F.tid; q < nu * 64; q += NTHREADS) { const int u = u_lo + (q >> 6), g = u >= U0, ug = g ? u - U0 : u; lent[q] = WSP(int, WS_TOKL)[(size_t)g * BMS_MAXU * 64 + (size_t)ug * 64 + (q & 63)]; }
    for (int q = F.tid; q < nu; q += NTHREADS) { const int u = u_lo + q, g = u >= U0, ug = g ? u - U0 : u; lcode[q] = g * 256 + (ut[g * (BMS_MAXU + 8) + 1 + ug] & 0xffff); }
    __syncthreads();
    LAS unsigned char* st = F.lds + AL_STAGE;
    const int tid = F.tid, krow = tid >> 3, kc = tid & 7, vsub = tid >> 8, vd = (tid & 255) >> 2, vc = tid & 3;
    auto ent = [&](int k) -> int { return lent[k * 64 + 8 * F.wave + tl]; };
    auto loadq = [&](int k, bf16x8 (&q)[4]) { const int e = ent(k), g = lcode[k] >> 8; const int t = e < 0 ? 0 : (e & 0xffff);
        const bf16_t* Q = WSP(bf16_t, WS_QN) + (size_t)(g * 4 + hh) * S * 64 + (size_t)t * 64 + 8 * hi;
#pragma unroll
        for (int ks = 0; ks < 4; ++ks) q[ks] = *(const bf16x8*)(Q + 16 * ks); };
    auto loadkv = [&](int gj, u32x4& rk, u32x4& rv) { const int g = gj >> 8, j = gj & 255;
        rk = *(const u32x4*)(WSP(bf16_t, WS_SK) + (size_t)g * S * 64 + (size_t)(64 * j + krow) * 64 + kc * 8); rv = *(const u32x4*)(WSP(bf16_t, WS_SVT) + (size_t)g * 64 * S + (size_t)(2 * j) * 2048 + tid * 8); };
    bf16x8 qr[3][4];
    if (nu > 0) loadq(0, qr[0]);
    if (nu > 1) loadq(1, qr[1]);
    int prev = -1; bool havepf = false; u32x4 rk, rv;
    for (int k0 = 0; k0 < nu; k0 += 3) {
#pragma unroll
      for (int d = 0; d < 3; ++d) { const int k = k0 + d; if (k >= nu) break;
        const int gj = __builtin_amdgcn_readfirstlane(lcode[k]); const int g = gj >> 8, j = gj & 255;
        if (k + 2 < nu) loadq(k + 2, qr[(d + 2) % 3]);
        if (gj != prev) {
            if (!havepf) loadkv(gj, rk, rv);
            __syncthreads();
            *(LAS u32x4*)(st + krow * KROW + kc * 16) = rk; *(LAS u32x4*)(st + ST_V + vsub * 64 * VROW + vd * VROW + vc * 16) = rv;
            __syncthreads(); prev = gj; havepf = false; }
        if (k + 1 < nu) { const int nx = __builtin_amdgcn_readfirstlane(lcode[k + 1]); if (nx != gj) { loadkv(nx, rk, rv); havepf = true; } }
        const int e_cur = ent(k);
        const bool valid = e_cur >= 0; const int t = valid ? (e_cur & 0xffff) : 0, slot = valid ? (e_cur >> 16) : 0;
        const LAS float* tb = tball + (g * 4 + hh) * TB_LD;
        int tmin = valid ? t : 0x7fffffff; tmin = wave_min_ui(tmin);
        const bool far = (tmin - (64 * j + 63) >= 128);
        f32x16 sv[2];
#pragma unroll
        for (int sub = 0; sub < 2; ++sub) { bf16x8 kf[4]; lds_k(kf, st, sub, lane); sv[sub] = qk32f(qr[d], kf);
            if (!far) t5_near(sv[sub], tb, t, 1, 64 * j + 32 * sub, hi, 1 << 30); }
        const float mx = xmax32(fmaxf(max16(sv[0]), max16(sv[1])));
        const float mu = (mx == NEG_INF) ? 0.f : mx;
        float l = 0.f; f32x16 o[2];
#pragma unroll
        for (int r = 0; r < 16; ++r) { o[0][r] = 0.f; o[1][r] = 0.f; }
#pragma unroll
        for (int sub = 0; sub < 2; ++sub) { exp16(sv[sub], mu, l); bf16x8 vf[4]; lds_v_T(vf, st, sub, lane); pv32f_T(o, sv[sub], vf); }
        l = xadd32(l);
        if (valid && hi == 0) *(f32x2*)(WSP(float, WS_PML) + ((((size_t)t * 2 + g) * 16 + slot) * 4 + hh) * 2) = (f32x2){far ? mx + tb[128] : mx, l};
        bf16_t* pbase = (g ? WSP(bf16_t, WS_X1) : (bf16_t*)P.out) + 2 * i;
#pragma unroll
        for (int rg = 0; rg < 4; ++rg) { const int e2 = lent[k * 64 + 8 * F.wave + 2 * rg + hi];
            if (e2 >= 0) { bf16_t* po = pbase + ((size_t)(e2 & 0xffff) * 16 + (e2 >> 16)) * 256;
#pragma unroll
                for (int h2 = 0; h2 < 4; ++h2) __builtin_nontemporal_store(cvtpk(o[0][4 * rg + h2], o[1][4 * rg + h2]), (unsigned*)(po + h2 * 64)); } }
      }
    }
    { volatile LAS int* tslot = (volatile LAS int*)(F.lds + AL_FLAG + 64);
      for (;;) {
        __syncthreads();
        if (F.tid == 0) *tslot = (int)atomicAdd(F.ctl + CW_QATT + 64, 1u);
        __syncthreads();
        const int q = __builtin_amdgcn_readfirstlane(*tslot);
        if (q >= NT_FOX) break;
        fox_task(F, 7 - (q >> 6), 63 - (q & 63));
      } }
    __syncthreads();
}

DI void phase_bms_combine(Frame& F, const Params& P) {
    const int lane = F.lane, gw = F.bid * NWAVES + F.wave, NGW = F.G * NWAVES;
    const int slotL = lane >> 2, hhL = lane & 3;
    const int sub = lane & 7, hhO = (lane >> 3) & 3, par = lane >> 5;
    struct Item { u32x4 pv[8]; f32x2 ml; float gate; f32x4 x0, x1; };
    auto load = [&](int it, Item& I) __attribute__((always_inline)) { const int t = it >> 1, g = it & 1; const int cur = t >> 6, nsel = cur < 15 ? cur + 1 : 16;
        const bf16_t* po = (g ? WSP(bf16_t, WS_X1) : (const bf16_t*)P.out) + (size_t)t * 4096 + hhO * 64 + 8 * sub;
#pragma unroll
        for (int k = 0; k < 8; ++k) { const int slot = 2 * k + par; I.pv[k] = __builtin_nontemporal_load((const u32x4*)(po + (slot < nsel ? slot : 0) * 256)); }
        I.ml = *(const f32x2*)(WSP(float, WS_PML) + ((size_t)it * 64 + lane) * 2);
        I.gate = WSP(float, WS_GN)[(size_t)t * 24 + g * 12 + hhL * 3 + 1];
        const float* XG = WSP(float, WS_U) + (size_t)t * 512 + g * 256 + hhO * 64 + 8 * sub;
        I.x0 = (f32x4){0.f, 0.f, 0.f, 0.f}; I.x1 = I.x0; if (par == 0) { I.x0 = *(const f32x4*)XG; I.x1 = *(const f32x4*)(XG + 4); } };
    auto compute = [&](int it, const Item& I) __attribute__((always_inline)) { const int t = it >> 1, g = it & 1; const int cur = t >> 6, nsel = cur < 15 ? cur + 1 : 16;
        const bool ok = slotL < nsel;
        const float m = ok ? I.ml[0] : NEG_INF;
        float M = m; M = fmaxf(M, dppf<0x124>(M)); M = fmaxf(M, dppf<0x128>(M)); M = xmax16(M); M = xmax32(M);
        const float wgt = (m == NEG_INF) ? 0.f : fexp2(m - M);
        float den = ok ? wgt * I.ml[1] : 0.f; den += dppf<0x124>(den); den += dppf<0x128>(den); den = xadd16(den); den = xadd32(den);
        const float sc = (den > 0.f) ? wgt * I.gate / den : 0.f;
        float acc[8];
#pragma unroll
        for (int q = 0; q < 8; ++q) acc[q] = 0.f;
#pragma unroll
        for (int k = 0; k < 8; ++k) { const int slot = 2 * k + par;
            const float w = __int_as_float(__builtin_amdgcn_ds_bpermute(4 * (slot * 4 + hhO), __float_as_int(sc)));
#pragma unroll
            for (int q = 0; q < 4; ++q) { acc[2 * q] += w * __builtin_bit_cast(float, I.pv[k][q] << 16); acc[2 * q + 1] += w * __builtin_bit_cast(float, I.pv[k][q] & 0xffff0000u); } }
#pragma unroll
        for (int q = 0; q < 8; ++q) acc[q] = xadd32(acc[q]);
        if (par == 0) { u32x4 wv; wv.x = cvtpk(I.x0[0] + acc[0], I.x0[1] + acc[1]); wv.y = cvtpk(I.x0[2] + acc[2], I.x0[3] + acc[3]); wv.z = cvtpk(I.x1[0] + acc[4], I.x1[1] + acc[5]); wv.w = cvtpk(I.x1[2] + acc[6], I.x1[3] + acc[7]);
            *(u32x4*)(WSP(bf16_t, WS_O) + (size_t)t * 1024 + g * 256 + hhO * 64 + 8 * sub) = wv; } };
    for (int it = gw; it < 2 * S; it += 4 * NGW) { Item A, B, C, D2; const bool h1 = it + NGW < 2 * S, h2 = it + 2 * NGW < 2 * S, h3 = it + 3 * NGW < 2 * S;
        load(it, A); if (h1) load(it + NGW, B); if (h2) load(it + 2 * NGW, C); if (h3) load(it + 3 * NGW, D2);
        compute(it, A); if (h1) compute(it + NGW, B); if (h2) compute(it + 2 * NGW, C); if (h3) compute(it + 3 * NGW, D2); }
}
#endif

DI void phase_lnmid_route(Frame& F, const Params& P, int rep) {
    const int lane = F.lane, w = F.wave;
    const float* XI = P.in[0]; const bf16_t* YB = WSP(bf16_t, WS_X1); bf16_t* X1 = WSP(bf16_t, WS_X1); bf16_t* U2 = WSP(bf16_t, WS_U); bf16_t* U2L = WSP(bf16_t, WS_U2L); const float* mod = WSP(float, WS_MOD);
    const float* ln1g = P.in[14]; const float* ln1b = P.in[15]; const float* brg = P.in[17]; const float* bre = P.in[19];
    int* toke = WSP(int, WS_TOKE); int* tokp = WSP(int, WS_TOKP); float* tokw = WSP(float, WS_TOKW);
    const bf16_t* WTh = WSP(bf16_t, WS_WRT); const bf16_t* WTl = WTh + 80 * 2048;
    LAS float* part = (LAS float*)F.lds;
    LAS unsigned* lhist = (LAS unsigned*)(F.lds + 4 * 64 * 84 * 4);
    constexpr int PLD = 84;
    for (int blk = F.bid; blk < S / 64; blk += F.G) {
        const int base = blk * 64;
        if (F.tid < 64) lhist[F.tid] = 0u;
        { f32x4 vn[8];
          u32x2 yn[8];
          { const f32x4* rr = (const f32x4*)(XI + (size_t)(base + 8 * w) * D) + lane; const u32x2* yr = (const u32x2*)(YB + (size_t)(base + 8 * w) * D) + lane;
#pragma unroll
            for (int j = 0; j < 8; ++j) { vn[j] = rr[64 * j]; yn[j] = yr[64 * j]; } }
          for (int i8 = 0; i8 < (rep ? 0 : 8); ++i8) { const int m = base + 8 * w + i8;
            u32x2* xr = (u32x2*)(X1 + (size_t)m * D) + lane;
            f32x4 v[8]; float s = 0.f;
#pragma unroll
            for (int j = 0; j < 8; ++j) { const u32x2 yw = yn[j];
                v[j][0] = vn[j][0] * ALPHA + __builtin_bit_cast(float, yw.x << 16); v[j][1] = vn[j][1] * ALPHA + __builtin_bit_cast(float, yw.x & 0xffff0000u);
                v[j][2] = vn[j][2] * ALPHA + __builtin_bit_cast(float, yw.y << 16); v[j][3] = vn[j][3] * ALPHA + __builtin_bit_cast(float, yw.y & 0xffff0000u);
                s += (v[j][0] + v[j][1]) + (v[j][2] + v[j][3]); }
            if (i8 < 7) { const f32x4* rr = (const f32x4*)(XI + (size_t)(m + 1) * D) + lane; const u32x2* yr = (const u32x2*)(YB + (size_t)(m + 1) * D) + lane;
#pragma unroll
                for (int j = 0; j < 8; ++j) { vn[j] = rr[64 * j]; yn[j] = yr[64 * j]; } }
            float mean = wave_sum(s) * (1.f / D), s2 = 0.f;
#pragma unroll
            for (int j = 0; j < 8; ++j) { v[j] = v[j] - mean; s2 += (v[j][0] * v[j][0] + v[j][1] * v[j][1]) + (v[j][2] * v[j][2] + v[j][3] * v[j][3]); }
            float rstd = 1.f / sqrtf(wave_sum(s2) * (1.f / D) + LN_EPS);
            s = 0.f;
#pragma unroll
            for (int j = 0; j < 8; ++j) { const int col = 4 * lane + 256 * j; v[j] = v[j] * rstd * *(const f32x4*)(ln1g + col) + *(const f32x4*)(ln1b + col); { u32x2 xw; xw.x = cvtpk(v[j][0], v[j][1]); xw.y = cvtpk(v[j][2], v[j][3]); xr[64 * j] = xw; } s += (v[j][0] + v[j][1]) + (v[j][2] + v[j][3]); }
            mean = wave_sum(s) * (1.f / D); s2 = 0.f;
#pragma unroll
            for (int j = 0; j < 8; ++j) { v[j] = v[j] - mean; s2 += (v[j][0] * v[j][0] + v[j][1] * v[j][1]) + (v[j][2] * v[j][2] + v[j][3] * v[j][3]); }
            rstd = 1.f / sqrtf(wave_sum(s2) * (1.f / D) + LN_EPS);
            u32x2* oh = (u32x2*)(U2 + (size_t)m * D) + lane; u32x2* ol = (u32x2*)(U2L + (size_t)m * D) + lane;
#pragma unroll
            for (int j = 0; j < 8; ++j) { const int col = 4 * lane + 256 * j; const f32x4 y = v[j] * rstd * (*(const f32x4*)(mod + 4 * D + col) + 1.0f) + *(const f32x4*)(mod + 3 * D + col);
                u32x2 wh; wh.x = cvtpk(y[0], y[1]); wh.y = cvtpk(y[2], y[3]); oh[64 * j] = wh;
                const float r0 = y[0] - __builtin_bit_cast(float, wh.x << 16), r1 = y[1] - __builtin_bit_cast(float, wh.x & 0xffff0000u), r2 = y[2] - __builtin_bit_cast(float, wh.y << 16), r3 = y[3] - __builtin_bit_cast(float, wh.y & 0xffff0000u);
                u32x2 wl; wl.x = cvtpk(r0, r1); wl.y = cvtpk(r2, r3); ol[64 * j] = wl; }
          } }
        asm volatile("s_waitcnt vmcnt(0)" ::: "memory");
        __syncthreads();
        { const int n16 = lane & 15, kq = lane >> 4;
          const bf16_t* uh = U2 + (size_t)(base + n16) * D + w * 256 + 8 * kq; const bf16_t* ul = U2L + (size_t)(base + n16) * D + w * 256 + 8 * kq;
          const bf16_t* wh0 = WTh + (size_t)n16 * 2048 + w * 256 + 8 * kq; const bf16_t* wl0 = WTl + (size_t)n16 * 2048 + w * 256 + 8 * kq;
          f32x4 acc[4][5];
#pragma unroll
          for (int rt = 0; rt < 4; ++rt)
#pragma unroll
              for (int nt = 0; nt < 5; ++nt) acc[rt][nt] = (f32x4){0.f, 0.f, 0.f, 0.f};
#pragma unroll 1
          for (int ks = 0; ks < 8; ++ks) {
              bf16x8 a_h[4], a_l[4], b_h[5], b_l[5];
#pragma unroll
              for (int rt = 0; rt < 4; ++rt) { a_h[rt] = *(const bf16x8*)(uh + (size_t)rt * 16 * D + 32 * ks); a_l[rt] = *(const bf16x8*)(ul + (size_t)rt * 16 * D + 32 * ks); }
#pragma unroll
              for (int nt = 0; nt < 5; ++nt) { b_h[nt] = *(const bf16x8*)(wh0 + (size_t)nt * 16 * 2048 + 32 * ks); b_l[nt] = *(const bf16x8*)(wl0 + (size_t)nt * 16 * 2048 + 32 * ks); }
#pragma unroll
              for (int rt = 0; rt < 4; ++rt)
#pragma unroll
                  for (int nt = 0; nt < 5; ++nt) { acc[rt][nt] = mfma16(b_h[nt], a_h[rt], acc[rt][nt]); acc[rt][nt] = mfma16(b_l[nt], a_h[rt], acc[rt][nt]); acc[rt][nt] = mfma16(b_h[nt], a_l[rt], acc[rt][nt]); }
          }
          LAS float* slot = part + (w & 3) * 64 * PLD;
          if (w < 4) {
#pragma unroll
              for (int rt = 0; rt < 4; ++rt)
#pragma unroll
                  for (int nt = 0; nt < 5; ++nt)
#pragma unroll
                      for (int r = 0; r < 4; ++r) slot[(16 * rt + n16) * PLD + 16 * nt + 4 * kq + r] = acc[rt][nt][r]; }
          __syncthreads();
          if (w >= 4) {
#pragma unroll
              for (int rt = 0; rt < 4; ++rt)
#pragma unroll
                  for (int nt = 0; nt < 5; ++nt)
#pragma unroll
                      for (int r = 0; r < 4; ++r) slot[(16 * rt + n16) * PLD + 16 * nt + 4 * kq + r] += acc[rt][nt][r]; }
        }
        __syncthreads();
        if (F.tid < 64) { const int row = F.tid, m = base + row; const LAS float* p0 = part + row * PLD;
            float lg[8]; int grp = 0; float gmax = NEG_INF;
#pragma unroll
            for (int e = 0; e < 8; ++e) { lg[e] = ((p0[e] + p0[64 * PLD + e]) + (p0[2 * 64 * PLD + e] + p0[3 * 64 * PLD + e])) + brg[e]; if (lg[e] > gmax) { gmax = lg[e]; grp = e; } }
            float gden = 0.f;
#pragma unroll
            for (int e = 0; e < 8; ++e) gden += __expf(lg[e] - gmax);
            const float pgrp = 1.f / gden;
            int e0 = 0; float m0 = NEG_INF, le[8];
#pragma unroll
            for (int e = 0; e < 8; ++e) { { const int c = 8 + grp * 8 + e; le[e] = ((p0[c] + p0[64 * PLD + c]) + (p0[2 * 64 * PLD + c] + p0[3 * 64 * PLD + c])) + bre[grp * 8 + e]; } if (le[e] > m0) { m0 = le[e]; e0 = e; } }
            int e1 = 0; float m1 = NEG_INF;
#pragma unroll
            for (int e = 0; e < 8; ++e) if (e != e0 && le[e] > m1) { m1 = le[e]; e1 = e; }
            const float r1 = __expf(m1 - m0); const float w0 = pgrp / (1.f + r1), w1 = pgrp * r1 / (1.f + r1);
            const int ea = grp * 8 + e0, eb = grp * 8 + e1;
            const int pa = (int)__hip_atomic_fetch_add(lhist + ea, 1u, __ATOMIC_RELAXED, __HIP_MEMORY_SCOPE_WORKGROUP), pb = (int)__hip_atomic_fetch_add(lhist + eb, 1u, __ATOMIC_RELAXED, __HIP_MEMORY_SCOPE_WORKGROUP);
            toke[2 * m] = ea; toke[2 * m + 1] = eb; tokp[2 * m] = pa; tokp[2 * m + 1] = pb; tokw[2 * m] = w0; tokw[2 * m + 1] = w1;
        }
        __syncthreads();
        if (F.tid < 64) WSP(int, WS_HIST)[blk * 64 + F.tid] = (int)lhist[F.tid];
        __syncthreads();
    }
}

DI void phase_scatter(Frame& F, const Params& P) {
    LAS int* base = (LAS int*)F.lds;
    LAS int* tot = base + 64; LAS int* off = base + 128;
    LAS int* ptot = base + 192; LAS int* poff = base + 192 + 512;
    const int* hist = WSP(int, WS_HIST);
    const int* toke = WSP(int, WS_TOKE); const int* tokp = WSP(int, WS_TOKP); const float* tokw = WSP(float, WS_TOKW);
    int* rt = WSP(int, WS_ROWTOK); int* rd = WSP(int, WS_ROWDST); float* rw = WSP(float, WS_ROWW);
    for (int blk = F.bid; blk < S / 64; blk += F.G) {
        { const int e = F.tid & 63, part = F.tid >> 6; int t = 0, o = 0;
#pragma unroll 8
          for (int b = part * 32; b < part * 32 + 32; ++b) { const int hv = hist[b * 64 + e]; t += hv; o += (b < blk) ? hv : 0; }
          ptot[part * 64 + e] = t; poff[part * 64 + e] = o; }
        __syncthreads();
        if (F.tid < 64) { int t = 0, o = 0;
#pragma unroll
            for (int p = 0; p < 8; ++p) { t += ptot[p * 64 + F.tid]; o += poff[p * 64 + F.tid]; }
            tot[F.tid] = t; off[F.tid] = o; }
        __syncthreads();
        if (F.tid == 0) { int run = 0; int* pane = WSP(int, WS_PANE); int np = 0;
            for (int e = 0; e < NEXP; ++e) { const int c = tot[e]; base[e] = run; const int npan = (c + 255) >> 8;
                if (blk == 0) for (int q = 0; q < npan; ++q) pane[1 + np + q] = e;
                np += npan; run += npan * 256; }
            if (blk == 0) pane[0] = np; }
        __syncthreads();
        if (F.tid < 128) { const int i = blk * 128 + F.tid; const int e = toke[i]; const int row = base[e] + off[e] + tokp[i]; rt[row] = i >> 1; rd[row] = i; rw[row] = tokw[i]; }
        __syncthreads();
    }
}

DI void phase_final(Frame& F, const Params& P) {
    const int lane = F.lane, gw = F.bid * NWAVES + F.wave, NGW = F.G * NWAVES;
    const bf16_t* X1 = WSP(bf16_t, WS_X1); const bf16_t* Y2 = WSP(bf16_t, WS_Y2); const float* mod = WSP(float, WS_MOD);
    const float* g2p = mod + 5 * D; const float* lg = P.in[23]; const float* lb = P.in[24];
    for (int m = gw; m < S; m += NGW) {
        const u32x2* xr = (const u32x2*)(X1 + (size_t)m * D) + lane;
        const u32x2* ya = (const u32x2*)(Y2 + (size_t)(2 * m) * D) + lane; const u32x2* yb = (const u32x2*)(Y2 + (size_t)(2 * m + 1) * D) + lane;
        f32x4 v[8]; float s = 0.f;
#pragma unroll
        for (int j = 0; j < 8; ++j) { const int col = 4 * lane + 256 * j; const u32x2 a = ya[64 * j], b = yb[64 * j];
            f32x4 y; y[0] = __builtin_bit_cast(float, a.x << 16) + __builtin_bit_cast(float, b.x << 16); y[1] = __builtin_bit_cast(float, a.x & 0xffff0000u) + __builtin_bit_cast(float, b.x & 0xffff0000u);
            y[2] = __builtin_bit_cast(float, a.y << 16) + __builtin_bit_cast(float, b.y << 16); y[3] = __builtin_bit_cast(float, a.y & 0xffff0000u) + __builtin_bit_cast(float, b.y & 0xffff0000u);
            const u32x2 xw = xr[64 * j]; const f32x4 x1v = (f32x4){__builtin_bit_cast(float, xw.x << 16), __builtin_bit_cast(float, xw.x & 0xffff0000u), __builtin_bit_cast(float, xw.y << 16), __builtin_bit_cast(float, xw.y & 0xffff0000u)};
            v[j] = x1v * ALPHA + (*(const f32x4*)(g2p + col) + 1.0f) * y; s += (v[j][0] + v[j][1]) + (v[j][2] + v[j][3]); }
        const float mean = wave_sum(s) * (1.f / D); float s2 = 0.f;
#pragma unroll
        for (int j = 0; j < 8; ++j) { v[j] = v[j] - mean; s2 += (v[j][0] * v[j][0] + v[j][1] * v[j][1]) + (v[j][2] * v[j][2] + v[j][3] * v[j][3]); }
        const float rstd = 1.f / sqrtf(wave_sum(s2) * (1.f / D) + LN_EPS);
        f32x4* o = (f32x4*)(P.out + (size_t)m * D) + lane;
#pragma unroll
        for (int j = 0; j < 8; ++j) { const int col = 4 * lane + 256 * j; o[64 * j] = v[j] * rstd * *(const f32x4*)(lg + col) + *(const f32x4*)(lb + col); }
    }
}

constexpr int NPHASE = 14;
__global__ void __launch_bounds__(NTHREADS, 2) fwd_kernel(Params P) {
    extern __shared__ __attribute__((aligned(16))) unsigned char lds_raw[];
    Frame F;
    F.lds = (LAS unsigned char*)lds_raw; F.ws = P.ws; F.ctl = (unsigned*)(P.ws + WS_CTL);
    F.tid = threadIdx.x; F.lane = F.tid & 63; F.wave = __builtin_amdgcn_readfirstlane(F.tid >> 6); F.G = gridDim.x; F.bid = blockIdx.x;
    volatile LAS unsigned* misc = (volatile LAS unsigned*)(F.lds + LDS_MISC);
    if (F.tid < 16) misc[F.tid] = 0u;
    __syncthreads();
    const int lo = P.ph_lo, hi = P.ph_hi;
    XcdBarrier bar; bar.bar = F.ctl + CW_BAR; bar.x = 0; bar.st = nullptr;
    if (hi - lo > 1) bar = xcd_barrier_post(F.ctl + CW_BAR, misc + 8);
#ifndef PHMASK
#define PHMASK 0xffff
#endif
#define IN(k) (((PHMASK >> (k)) & 1) && lo <= (k) && (k) < hi)
#define RUN(k, ...) do { __VA_ARGS__; if (REPS(k) > 1) { __VA_ARGS__; } } while (0)
#define SEAM(k) do { if (IN(k) && IN((k) + 1)) xcd_barrier(bar); } while (0)
    LAS unsigned char* glds = F.lds;

    if (IN(0)) { RUN(0, phase_prologue<0>(F, P)); }
    SEAM(0);
    if (IN(1)) { RUN(1, phase_ln1(F, P)); }
    SEAM(1);
    if (IN(2)) {
        pg8::Gemm g{WSP(bf16_t, WS_U), WSP(bf16_t, WS_WINT), D, D, D, nullptr}; pg8::SchedGrid Sd; Sd.init(S, NIN, D, D, F.G, F.bid);
        EpiIn E{F.ws, P.in[5]};
        if (WCO) { const int a = F.bid & 7; using SR = pg8::SchedRange<pg8::SchedGrid>; SR r0{Sd, 0, a}, r1{Sd, a, 1 << 30};
            pg8::gemm_phase<EpiIn, SR, false>(glds, g, r0, E); __syncthreads();
            phase_prologue<1>(F, P); __syncthreads();
            pg8::gemm_phase<EpiIn, SR, false>(glds, g, r1, E); }
        else RUN(2, pg8::gemm_phase<EpiIn, pg8::SchedGrid, false>(glds, g, Sd, E));
    }
    SEAM(2);
    if (IN(3)) {
        pg8::Gemm g{WSP(bf16_t, WS_CKV), WSP(bf16_t, WS_W1T), 1024, 2048, 512, nullptr}; SchedCmp Sd{F.G, F.bid};
        EpiCmp E{WSP(float, WS_HC)};
        RUN(3, pg8::gemm_phase<EpiCmp, SchedCmp, false>(glds, g, Sd, E));
    }
    SEAM(3);
    if (IN(4)) { RUN(4, phase_cmp2_scan(F, P)); }
    SEAM(4);
    if (IN(5)) { { phase_attn(F, P, 0); if (REPS(5) > 1) phase_attn(F, P, 1); } }
#if BMS
    if (IN(5)) { if (hi - lo > 1) xcd_barrier(bar); phase_bms_sort(F, P); if (BMSREP & 1) phase_bms_sort(F, P);
                 if (hi - lo > 1) xcd_barrier(bar); phase_bms_attn(F, P); if (BMSREP & 2) phase_bms_attn(F, P);
                 if (hi - lo > 1) xcd_barrier(bar); phase_bms_combine(F, P); if (BMSREP & 4) phase_bms_combine(F, P); }
#endif
    SEAM(5);
    if (IN(6)) {
        pg8::Gemm g{WSP(bf16_t, WS_O), WSP(bf16_t, WS_BRT1), 1024, 512, 512, nullptr}; pg8::SchedGrid Sd; Sd.init(S, D, 1024, 512, F.G, F.bid);
        EpiMerge<1> E{WSP(bf16_t, WS_GM), WSP(bf16_t, WS_MG)};
        RUN(6, pg8::gemm_phase<EpiMerge<1>, pg8::SchedGrid, false>(glds, g, Sd, E));
    }
    if (IN(6) && IN(7)) __syncthreads();
    if (IN(7)) {
        pg8::Gemm g{WSP(bf16_t, WS_O) + 512, WSP(bf16_t, WS_BRT2), 1024, 512, 512, nullptr}; pg8::SchedGrid Sd; Sd.init(S, D, 1024, 512, F.G, F.bid);
        EpiMerge<2> E{WSP(bf16_t, WS_GM), WSP(bf16_t, WS_MG)};
        pg8::gemm_phase<EpiMerge<2>, pg8::SchedGrid, false>(glds, g, Sd, E);
    }
    SEAM(7);
    if (IN(8)) {
        pg8::Gemm g{WSP(bf16_t, WS_MG), WSP(bf16_t, WS_WOT), D, D, D, nullptr}; pg8::SchedGrid Sd; Sd.init(S, D, D, D, F.G, F.bid);
        EpiWo E{WSP(float, WS_MOD), WSP(bf16_t, WS_X1)};
        RUN(8, pg8::gemm_phase<EpiWo, pg8::SchedGrid, false>(glds, g, Sd, E));
    }
    SEAM(8);
    if (IN(9)) { phase_lnmid_route(F, P, 0); if (REPS(9) > 1) phase_lnmid_route(F, P, 1); }
    SEAM(9);
    if (IN(10)) { RUN(10, phase_scatter(F, P)); }
    SEAM(10);
    if (IN(11)) {
        LAS int* lpane = (LAS int*)(F.lds + 131072); if (F.tid < 256) lpane[F.tid] = WSP(int, WS_PANE)[F.tid]; __syncthreads();
        pg8::Gemm g{WSP(bf16_t, WS_U), WSP(bf16_t, WS_WGUT), D, D, D, WSP(int, WS_ROWTOK)}; SchedMoe Sd{lpane, 4, F.G, F.bid, 0, (size_t)256 * D * 2};
        EpiGU E{WSP(bf16_t, WS_H)};
        RUN(11, pg8::gemm_phase<EpiGU, SchedMoe, true>(glds, g, Sd, E));
    }
    SEAM(11);
    if (IN(12)) {
        LAS int* lpane = (LAS int*)(F.lds + 131072); if (F.tid < 256) lpane[F.tid] = WSP(int, WS_PANE)[F.tid]; __syncthreads();
        pg8::Gemm g{WSP(bf16_t, WS_H), WSP(bf16_t, WS_WDT), DEXP, DEXP, DEXP, nullptr}; SchedMoe Sd{lpane, 8, F.G, F.bid, (size_t)256 * DEXP * 2, (size_t)256 * DEXP * 2};
        EpiDown E{WSP(int, WS_ROWDST), WSP(float, WS_ROWW), WSP(bf16_t, WS_Y2)};
        RUN(12, pg8::gemm_phase<EpiDown, SchedMoe, false>(glds, g, Sd, E));
    }
    SEAM(12);
    if (IN(13)) { RUN(13, phase_final(F, P)); }
#undef IN
#undef SEAM
}

extern "C" void kernel_launch(void* const* d_in, const int* in_sizes, int n_in, void* d_out, int out_size, void* d_ws, size_t ws_size, hipStream_t stream) {
    static int grid = 0;
    if (grid == 0) {
        if (n_in != 25 || out_size != S * D || ws_size < WS_END) { fprintf(stderr, "kernel_launch: unexpected problem (n_in %d, out %d, ws %zu < %zu)\n", n_in, out_size, ws_size, (size_t)WS_END); grid = -1; return; }
        int dev = 0, cus = 0, per_cu = 0;
        if (hipGetDevice(&dev) != hipSuccess || hipDeviceGetAttribute(&cus, hipDeviceAttributeMultiprocessorCount, dev) != hipSuccess) { grid = -1; return; }
        if (hipFuncSetAttribute((const void*)fwd_kernel, hipFuncAttributeMaxDynamicSharedMemorySize, LDS_BYTES) != hipSuccess) { fprintf(stderr, "kernel_launch: hipFuncSetAttribute failed\n"); grid = -1; return; }
        if (hipOccupancyMaxActiveBlocksPerMultiprocessor(&per_cu, (const void*)fwd_kernel, NTHREADS, LDS_BYTES) != hipSuccess || per_cu < 1) fprintf(stderr, "kernel_launch: occupancy query says %d\n", per_cu);
        (void)hipGetLastError();
        grid = cus;
    }
    if (grid < 0) return;
    (void)hipMemsetAsync((char*)d_ws + WS_CTL, 0, CTL_BYTES, stream);
    Params p{};
    for (int i = 0; i < 25; ++i) p.in[i] = (const float*)d_in[i];
    p.out = (float*)d_out; p.ws = (unsigned char*)d_ws;
#if N_LAUNCH_SPLIT
    for (int k = 0; k < NPHASE; ++k) { p.ph_lo = k; p.ph_hi = k + 1; hipLaunchKernelGGL(fwd_kernel, dim3(grid), dim3(NTHREADS), LDS_BYTES, stream, p); }
#else
    p.ph_lo = 0; p.ph_hi = NPHASE; hipLaunchKernelGGL(fwd_kernel, dim3(grid), dim3(NTHREADS), LDS_BYTES, stream, p);
#endif
}
```

```cpp
#include <hip/hip_runtime.h>
#include <cstdint>
#include <cstdio>

#ifndef N_LAUNCH_SPLIT
#define N_LAUNCH_SPLIT 0
#endif

#ifndef PHREP
#define PHREP 0
#endif
#ifndef WCO
#define WCO 1
#endif
#ifndef BMSREP
#define BMSREP 0
#endif
#ifndef NSAP
#define NSAP 0
#endif
#ifndef BMS
#define BMS 1
#endif
#define REPS(k) (1 + ((PHREP >> (k)) & 1))
#define DI __device__ __forceinline__
#define LAS __attribute__((address_space(3)))
#define GAS __attribute__((address_space(1)))

typedef unsigned short bf16_t;
typedef short bf16x8 __attribute__((ext_vector_type(8)));
typedef float f32x4 __attribute__((ext_vector_type(4)));
typedef float f32x2 __attribute__((ext_vector_type(2)));
typedef float f32x16 __attribute__((ext_vector_type(16)));
typedef unsigned u32x4 __attribute__((ext_vector_type(4)));
typedef unsigned u32x2 __attribute__((ext_vector_type(2)));

constexpr int S = 16384, D = 2048, HD = 64;
constexpr int IN_COLS = 6944, OFF_GATE = 1280, OFF_FGT = 2840;
constexpr int NIN = 7168;
constexpr int NCMP = 1023, NCMP_P = 1024;
constexpr int NEXP = 64, DEXP = 512;
constexpr int MAXROWS = 2 * S + NEXP * 256;
constexpr int MAXPAN = MAXROWS / 256;
constexpr float LN_EPS = 1e-5f;
constexpr float LOG2E = 1.4426950408889634f;
constexpr float C2 = 0.125f * LOG2E;
constexpr float ALPHA = 1.189207115002721f;
constexpr int CKROWS = S + 64;
constexpr int NWAVES = 8, NTHREADS = 512;

constexpr size_t MiB = 1u << 20;
constexpr size_t al(size_t x) { return (x + 4095) & ~(size_t)4095; }
constexpr size_t WS_CTL = 0, CTL_BYTES = 1 * MiB;
constexpr size_t WS_MODP = WS_CTL + CTL_BYTES;
constexpr size_t WS_MOD = WS_MODP + al(32 * 12288 * 4);
constexpr size_t WS_PEWP = WS_MOD + al(12288 * 4);
constexpr size_t WS_BIASC = WS_PEWP + al(2 * 32 * 256 * 4);
constexpr size_t WS_WINT = WS_BIASC + al(2 * 256 * 4);
constexpr size_t WS_W1T = WS_WINT + al((size_t)NIN * D * 2);
constexpr size_t WS_BRT1 = WS_W1T + al(2 * 256 * 2048 * 2);
constexpr size_t WS_BRT2 = WS_BRT1 + al(2048 * 512 * 2);
constexpr size_t WS_WOT = WS_BRT2 + al(2048 * 512 * 2);
constexpr size_t WS_WGUT = WS_WOT + al((size_t)D * D * 2);
constexpr size_t WS_WDT = WS_WGUT + al((size_t)NEXP * 1024 * D * 2);
constexpr size_t WS_U = WS_WDT + al((size_t)NEXP * D * DEXP * 2);
constexpr size_t WS_QN = WS_U + al((size_t)S * D * 2);
constexpr size_t WS_CKV = WS_QN + al((size_t)8 * S * 64 * 2);
constexpr size_t WS_SK = WS_CKV + al((size_t)4 * CKROWS * 64 * 2);
constexpr size_t WS_SVT = WS_SK + al((size_t)2 * S * 64 * 2);
constexpr size_t WS_WK = WS_SVT + al((size_t)2 * S * 64 * 2);
constexpr size_t WS_WVT = WS_WK + al((size_t)2 * S * 64 * 2);
constexpr size_t WS_FQ = WS_WVT + al((size_t)2 * S * 64 * 2);
constexpr size_t WS_FK = WS_FQ + al((size_t)8 * S * 64 * 2);
constexpr size_t WS_FVT = WS_FK + al((size_t)8 * S * 64 * 2);
constexpr size_t WS_GM = WS_FVT + al((size_t)8 * S * 64 * 2);
constexpr size_t WS_GN = WS_GM + al((size_t)S * 4096 * 2);
constexpr size_t WS_LOGF = WS_GN + al((size_t)S * 24 * 4);
constexpr size_t WS_FC = WS_LOGF + al((size_t)S * 8 * 4);
constexpr size_t WS_HC = WS_FC + al((size_t)S * 8 * 4);
constexpr size_t WS_KC = WS_HC + al((size_t)4 * 4 * 1024 * 256 * 4);
constexpr size_t WS_VCT = WS_KC + al((size_t)2 * 1024 * 64 * 2);
constexpr size_t WS_O = WS_VCT + al((size_t)2 * 1024 * 64 * 2);
constexpr size_t WS_MG = WS_O + al((size_t)S * 1024 * 2);
constexpr size_t WS_X1 = WS_MG + al((size_t)S * D * 2);
constexpr size_t WS_TOKE = WS_X1 + al((size_t)S * D * 4);
constexpr size_t WS_TOKP = WS_TOKE + al((size_t)S * 2 * 4);
constexpr size_t WS_TOKW = WS_TOKP + al((size_t)S * 2 * 4);
constexpr size_t WS_ROWTOK = WS_TOKW + al((size_t)S * 2 * 4);
constexpr size_t WS_ROWDST = WS_ROWTOK + al((size_t)MAXROWS * 4);
constexpr size_t WS_ROWW = WS_ROWDST + al((size_t)MAXROWS * 4);
constexpr size_t WS_PANE = WS_ROWW + al((size_t)MAXROWS * 4);
constexpr size_t WS_KMAX = WS_PANE + al(1024 * 4);
constexpr size_t WS_HIST = WS_KMAX + al(256 * 8 * 4);
constexpr size_t WS_WRT = WS_HIST + al(256 * 64 * 4);
constexpr size_t WS_SELMG = WS_WRT + al(2 * 80 * 2048 * 2);
constexpr size_t WS_HISTB = WS_SELMG + al((size_t)S * 2 * 8 * 4);
constexpr int BMS_MAXU = 4352;
constexpr size_t WS_TOKL = WS_HISTB + al(2 * 256 * 256 * 4);
constexpr size_t WS_UT = WS_TOKL + al((size_t)2 * BMS_MAXU * 64 * 4);
constexpr size_t WS_END = WS_UT + al(2 * (BMS_MAXU + 8) * 4);
constexpr size_t WS_PML = WS_MG;
constexpr size_t WS_U2L = WS_MG;
constexpr size_t WS_H = WS_QN;
constexpr size_t WS_Y2 = WS_GM;
static_assert(WS_H + (size_t)MAXROWS * DEXP * 2 <= WS_FK, "H overlay");
static_assert(WS_Y2 + (size_t)2 * S * D * 2 <= WS_GN, "Y2 overlay");
static_assert(WS_END <= (size_t)1000 * MiB, "workspace budget");

constexpr int CW_BAR = 4096;
constexpr int CW_CNT = 16384;
constexpr int CW_QATT = 16384 + 256;
constexpr int CW_KMAX = 16384 + 512;

constexpr int LDS_BYTES = 147456;
constexpr int LDS_MISC = 144 * 1024 - 256;

typedef __bf16 bf16x2_t __attribute__((ext_vector_type(2)));
DI unsigned cvtpk(float lo, float hi) { f32x2 v = {lo, hi}; bf16x2_t b = __builtin_convertvector(v, bf16x2_t); return __builtin_bit_cast(unsigned, b); }
DI unsigned f2bf(float f) { unsigned u = __builtin_bit_cast(unsigned, f); return (u + 0x7fffu + ((u >> 16) & 1u)) >> 16; }
DI unsigned pk2(float lo, float hi) { return f2bf(lo) | (f2bf(hi) << 16); }
DI float bf2f(bf16_t b) { return __builtin_bit_cast(float, (unsigned)b << 16); }
DI float dpp_addf(float x, float y) { return x + y; }
template <int CTRL> DI float dpp_mov(float x) { return __builtin_bit_cast(float, __builtin_amdgcn_update_dpp(0, __builtin_bit_cast(int, x), CTRL, 0xF, 0xF, true)); }
DI float wave_sum(float v) {
    v += dpp_mov<0xB1>(v); v += dpp_mov<0x4E>(v); v += dpp_mov<0x124>(v); v += dpp_mov<0x128>(v);
    const float a = __int_as_float(__builtin_amdgcn_readlane(__float_as_int(v), 0)), b = __int_as_float(__builtin_amdgcn_readlane(__float_as_int(v), 16));
    const float c = __int_as_float(__builtin_amdgcn_readlane(__float_as_int(v), 32)), d = __int_as_float(__builtin_amdgcn_readlane(__float_as_int(v), 48));
    return (a + b) + (c + d);
}
DI float fexp2(float x) { return __builtin_amdgcn_exp2f(x); }
DI float sigmoidf_(float x) { return __builtin_amdgcn_rcpf(1.f + __builtin_amdgcn_exp2f(-1.4426950408889634f * x)); }
DI float logsigmoidf_(float x) { return fminf(x, 0.f) - log1pf(__expf(-fabsf(x))); }

#define XB_TMO      128
#define XB_XCNT(j)  (256  + 64 * (j))
#define XB_XSUB(j)  (1280 + 64 * (j))
#define XB_XGEN(j)  (2304 + 64 * (j))
#define XB_TOP      3328
#define XB_TOPGEN   3392
#define XCD_BAR_WORDS 3456
#define XB_SPIN_CAP (1u << 20)
DI unsigned xb_ld(unsigned* p)              { return __hip_atomic_load(p, __ATOMIC_RELAXED, __HIP_MEMORY_SCOPE_AGENT); }
DI unsigned xb_add(unsigned* p, unsigned v) { return __hip_atomic_fetch_add(p, v, __ATOMIC_RELAXED, __HIP_MEMORY_SCOPE_AGENT); }
DI unsigned xb_xcc_id() { return (unsigned)__builtin_amdgcn_s_getreg((3 << 11) | 20) & 0xFu; }
#define XB_SPIN(cond, bar) do { unsigned _sp = 0; while (cond) { __builtin_amdgcn_s_sleep(1); \
    if ((++_sp & 255u) == 0u) { if (xb_ld(&(bar)[XB_TMO])) break; if (_sp > XB_SPIN_CAP) { atomicAdd(&(bar)[XB_TMO], 1u); break; } } } } while (0)
struct XcdBarrier { unsigned* bar; unsigned x; volatile LAS unsigned* st; };
DI XcdBarrier xcd_barrier_post(unsigned* bar, volatile LAS unsigned* st) {
    XcdBarrier b; b.bar = bar; b.x = xb_xcc_id(); b.st = st;
    if (threadIdx.x == 0) (void)xb_add(&bar[XB_XCNT(b.x)], 1u);
    return b;
}
DI void xcd_barrier_complete(unsigned* bar, unsigned x, unsigned& nloc, unsigned& nx) {
    const unsigned G = gridDim.x * gridDim.y * gridDim.z;
    unsigned sum, cnt, mine, sp = 0u;
    for (;;) {
        sum = 0u; cnt = 0u; mine = 0u;
#pragma unroll
        for (unsigned j = 0; j < 16; ++j) { const unsigned c = xb_ld(&bar[XB_XCNT(j)]); sum += c; cnt += (c > 0u) ? 1u : 0u; mine = (j == x) ? c : mine; }
        if (sum == G) break;
        __builtin_amdgcn_s_sleep(1);
        if ((++sp & 255u) == 0u) { if (xb_ld(&bar[XB_TMO])) break; if (sp > XB_SPIN_CAP) { atomicAdd(&bar[XB_TMO], 1u); break; } }
    }
    nloc = mine > 0u ? mine : 1u; nx = cnt > 0u ? cnt : 1u;
}
DI void xcd_barrier(const XcdBarrier& b) {
    asm volatile("s_waitcnt vmcnt(0)" ::: "memory");
    __syncthreads();
    if (threadIdx.x == 0) {
        unsigned* bar = b.bar;
        __builtin_amdgcn_s_waitcnt(0);
        unsigned nloc = b.st[0], nx = b.st[1];
        if (nloc == 0u) { xcd_barrier_complete(bar, b.x, nloc, nx); b.st[0] = nloc; b.st[1] = nx; }
        const unsigned old = xb_add(&bar[XB_XSUB(b.x)], 1u);
        const unsigned gen = old / nloc;
        if (old + 1u == (gen + 1u) * nloc) {
            __builtin_amdgcn_fence(__ATOMIC_RELEASE, "agent");
            asm volatile("s_waitcnt vmcnt(0)" ::: "memory");
            const unsigned og = xb_add(&bar[XB_TOP], 1u);
            const unsigned tg = og / nx;
            if (og + 1u == (tg + 1u) * nx) xb_add(&bar[XB_TOPGEN], 1u);
            else XB_SPIN(xb_ld(&bar[XB_TOPGEN]) == tg, bar);
            __builtin_amdgcn_fence(__ATOMIC_ACQUIRE, "agent");
            xb_add(&bar[XB_XGEN(b.x)], 1u);
            asm volatile("s_waitcnt vmcnt(0)" ::: "memory");
        } else {
            XB_SPIN(xb_ld(&bar[XB_XGEN(b.x)]) == gen, bar);
            __builtin_amdgcn_fence(__ATOMIC_ACQUIRE, "agent");
            asm volatile("s_waitcnt vmcnt(0)" ::: "memory");
        }
    }
    __syncthreads();
}

namespace pg8 {
constexpr int BM = 256, BK = 64, HALF = 128, HTB = HALF * BK * 2, STAGE_BYTES = 8 * HTB, NXCD = 8, WGM = 8;
__host__ __device__ __forceinline__ int lds_byte(int r, int c) { const int st = (r >> 4) * 2 + (c >> 5), rr = r & 15, cc = c & 31, ob = rr * 64 + cc * 2; return st * 1024 + (ob ^ (((ob >> 9) & 1) << 5)); }
__host__ __device__ __forceinline__ void stage_rc(int b, int& R, int& C) { const int st = b / 1024, sb = b % 1024, swz = sb ^ (((sb >> 9) & 1) << 5); R = (st >> 1) * 16 + swz / 64; C = (st & 1) * 32 + (swz % 64) / 2; }
__host__ __device__ __forceinline__ int perm32(int rho) { const int n = rho >> 4, i = rho & 15; return 8 * (i >> 2) + 4 * n + (i & 3); }

struct Unit { int pm, pn, aux; size_t aoff, boff; };
struct Gemm { const bf16_t* A; const bf16_t* Bt; int lda, ldb, K; const int* rowtok; };

struct SchedGrid {
    int nM, nN, nwg, G, c; size_t ta, tb;
    DI void init(int M, int N, int lda, int ldb, int G_, int c_) { nM = M / BM; nN = N / BM; nwg = nM * nN; G = G_; c = c_; ta = (size_t)BM * lda * 2; tb = (size_t)BM * ldb * 2; }
    DI bool next(int i, Unit& u) const {
        const long L = (long)i * G + c; if (L >= nwg) return false;
        int wgid = (int)L; { const int q = nwg / NXCD, r = nwg % NXCD, xcd = wgid % NXCD, off = wgid / NXCD; wgid = (xcd < r ? xcd * (q + 1) : r * (q + 1) + (xcd - r) * q) + off; }
        const int nig = WGM * nN, gid = wgid / nig, fm = gid * WGM, gsz = (nM - fm) < WGM ? (nM - fm) : WGM;
        u.pm = fm + ((wgid % nig) % gsz); u.pn = (wgid % nig) / gsz; u.aux = 0; u.aoff = (size_t)u.pm * ta; u.boff = (size_t)u.pn * tb; return true;
    }
};

template <class Sched> struct SchedRange { const Sched& s; int i0, i1; DI bool next(int i, Unit& u) const { return (i0 + i < i1) && s.next(i0 + i, u); } };

DI unsigned cvt_pk_bf16(float lo, float hi) { return cvtpk(lo, hi); }

template <class Epi, class Sched, bool GATHER>
DI void gemm_phase(LAS unsigned char* lds, const Gemm g, const Sched& S, const Epi& E) {
    const int tid = threadIdx.x, wid = __builtin_amdgcn_readfirstlane(tid >> 6), lane = tid & 63, wr = wid >> 2, wc = wid & 3, fr = lane & 15, fq = lane >> 4;
    const int K = g.K, nt = K / BK;
    int Rr[2], Cc[2];
    unsigned voffA[2][2], voffB[2], nvoffA[2][2];
#pragma unroll
    for (int i = 0; i < 2; ++i) { int R, C; stage_rc(tid * 16 + i * 8192, R, C); const int Rb = Epi::PERM ? ((R & ~31) + perm32(R & 31)) : R; Rr[i] = R; Cc[i] = C;
        voffA[0][i] = (unsigned)(R * g.lda + C) * 2u; voffA[1][i] = (unsigned)((R + HALF) * g.lda + C) * 2u; voffB[i] = (unsigned)(Rb * g.ldb + C) * 2u;
        nvoffA[0][i] = voffA[0][i]; nvoffA[1][i] = voffA[1][i]; }
    const size_t kstep = (size_t)(BK * 2);
    const size_t hstepB = (size_t)HALF * g.ldb * 2;
    const unsigned ldsw = (unsigned)wid * 1024u;
    const int aoff = lds_byte(wr * 64 + fr, fq * 8), boff = lds_byte(wc * 32 + fr, fq * 8);
#define PG8_SA(b, h) (((b) * 2 + (h)) * HTB)
#define PG8_SB(b, h) ((4 + (b) * 2 + (h)) * HTB)
#define PG8_STAGE(bufoff, gbase, voff) do { _Pragma("unroll") for (int _i = 0; _i < 2; ++_i) \
        __builtin_amdgcn_global_load_lds((const unsigned*)((const char*)(gbase) + (voff)[_i]), (LAS unsigned*)(lds + (bufoff) + ldsw + _i * 8192), 16, 0, 0); } while (0)
#define PG8_LDA(dst, b, h) do { _Pragma("unroll") for (int m = 0; m < 4; ++m) _Pragma("unroll") for (int k = 0; k < 2; ++k) dst[m][k] = *(const LAS bf16x8*)(lds + PG8_SA(b, h) + aoff + m * 2048 + k * 1024); } while (0)
#define PG8_LDB(dst, b, h) do { _Pragma("unroll") for (int n = 0; n < 2; ++n) _Pragma("unroll") for (int k = 0; k < 2; ++k) dst[n][k] = *(const LAS bf16x8*)(lds + PG8_SB(b, h) + boff + n * 2048 + k * 1024); } while (0)
#define PG8_MMA(ai, bj, At, Bt) do { __builtin_amdgcn_s_setprio(1); _Pragma("unroll") for (int m = 0; m < 4; ++m) _Pragma("unroll") for (int n = 0; n < 2; ++n) _Pragma("unroll") for (int k = 0; k < 2; ++k) \
        acc[ai][bj][m][n] = __builtin_amdgcn_mfma_f32_16x16x32_bf16(Bt[n][k], At[m][k], acc[ai][bj][m][n], 0, 0, 0); __builtin_amdgcn_s_setprio(0); } while (0)
#define PG8_WAIT_V(n) asm volatile("s_waitcnt vmcnt(" #n ")" ::: "memory")
#define PG8_WAIT_L(n) asm volatile("s_waitcnt lgkmcnt(" #n ")" ::: "memory")
#define PG8_BAR __builtin_amdgcn_s_barrier()
#define PG8_SCHED __builtin_amdgcn_sched_barrier(0)
#define PG8_GATHER(dst, u) do { if constexpr (GATHER) { _Pragma("unroll") for (int _h = 0; _h < 2; ++_h) _Pragma("unroll") for (int _i = 0; _i < 2; ++_i) { \
        int _t = g.rowtok[(u).pm * BM + _h * HALF + Rr[_i]]; _t = _t < 0 ? 0 : _t; dst[_h][_i] = (unsigned)(_t * g.lda + Cc[_i]) * 2u; } } } while (0)
    Unit cur, nxt; int ui = 0;
    if (!S.next(0, cur)) return;
    f32x4 acc[2][2][4][2];
#pragma unroll
    for (int a = 0; a < 2; ++a)
#pragma unroll
        for (int b = 0; b < 2; ++b)
#pragma unroll
            for (int m = 0; m < 4; ++m)
#pragma unroll
                for (int n = 0; n < 2; ++n) acc[a][b][m][n] = (f32x4){0.f, 0.f, 0.f, 0.f};
    bf16x8 At[4][2], B0[2][2], B1[2][2];
    const char* cA = (const char*)g.A + cur.aoff; const char* cB = (const char*)g.Bt + cur.boff;
    PG8_GATHER(voffA, cur);
    PG8_STAGE(PG8_SB(0, 0), cB, voffB); PG8_STAGE(PG8_SB(0, 1), cB + hstepB, voffB); PG8_STAGE(PG8_SA(0, 0), cA, voffA[0]); PG8_STAGE(PG8_SA(0, 1), cA, voffA[1]);
    if (wr == 1) PG8_BAR;
    PG8_WAIT_V(2); PG8_BAR;
    PG8_STAGE(PG8_SB(1, 0), cB + kstep, voffB); PG8_STAGE(PG8_SA(1, 0), cA + kstep, voffA[0]); PG8_STAGE(PG8_SB(1, 1), cB + hstepB + kstep, voffB);
    PG8_WAIT_V(6); PG8_BAR;
    for (;;) {
        const bool has_next = S.next(ui + 1, nxt);
        const char* nA = has_next ? (const char*)g.A + nxt.aoff : cA; const char* nB = has_next ? (const char*)g.Bt + nxt.boff : cB;
        if constexpr (GATHER) { if (has_next) { PG8_GATHER(nvoffA, nxt); } else { _Pragma("unroll") for (int h = 0; h < 2; ++h) _Pragma("unroll") for (int i = 0; i < 2; ++i) nvoffA[h][i] = voffA[h][i]; } }
        for (int t = 0; t < nt; t += 2) {
            const bool last = (t == nt - 2);
            const char* a1 = cA + (size_t)(t + 1) * kstep;
            const char* a2 = last ? nA : cA + (size_t)(t + 2) * kstep; const char* b2 = last ? nB : cB + (size_t)(t + 2) * kstep;
            const char* a3 = a2 + kstep; const char* b3 = b2 + kstep;
            unsigned va2[2][2];
#pragma unroll
            for (int h = 0; h < 2; ++h)
#pragma unroll
                for (int i = 0; i < 2; ++i) va2[h][i] = (GATHER && last) ? nvoffA[h][i] : voffA[h][i];
            PG8_LDB(B0, 0, 0); PG8_LDB(B1, 0, 1); PG8_SCHED; PG8_LDA(At, 0, 0); PG8_STAGE(PG8_SA(1, 1), a1, voffA[1]);
            PG8_WAIT_V(8); PG8_WAIT_L(0); PG8_BAR; PG8_MMA(0, 0, At, B0); PG8_MMA(0, 1, At, B1); PG8_BAR; PG8_SCHED;
            PG8_LDA(At, 0, 1); PG8_STAGE(PG8_SB(0, 0), b2, voffB); PG8_STAGE(PG8_SB(0, 1), b2 + hstepB, voffB); PG8_STAGE(PG8_SA(0, 0), a2, va2[0]);
            PG8_WAIT_V(8); PG8_WAIT_L(0); PG8_BAR; PG8_MMA(1, 0, At, B0); PG8_MMA(1, 1, At, B1); PG8_BAR; PG8_SCHED;
            PG8_LDB(B0, 1, 0); PG8_LDB(B1, 1, 1); PG8_SCHED; PG8_LDA(At, 1, 0); PG8_STAGE(PG8_SA(0, 1), a2, va2[1]);
            PG8_WAIT_V(8); PG8_WAIT_L(0); PG8_BAR; PG8_MMA(0, 0, At, B0); PG8_MMA(0, 1, At, B1); PG8_BAR; PG8_SCHED;
            PG8_LDA(At, 1, 1); PG8_STAGE(PG8_SB(1, 0), b3, voffB); PG8_STAGE(PG8_SB(1, 1), b3 + hstepB, voffB); PG8_STAGE(PG8_SA(1, 0), a3, va2[0]);
            PG8_WAIT_V(8); PG8_WAIT_L(0); PG8_BAR; PG8_MMA(1, 0, At, B0); PG8_MMA(1, 1, At, B1); PG8_BAR; PG8_SCHED;
        }
        if (wr == 0) PG8_BAR;
        E(acc, cur, wr, wc, fr, fq);
        if (!has_next) break;
#pragma unroll
        for (int a = 0; a < 2; ++a)
#pragma unroll
            for (int b = 0; b < 2; ++b)
#pragma unroll
                for (int m = 0; m < 4; ++m)
#pragma unroll
                    for (int n = 0; n < 2; ++n) acc[a][b][m][n] = (f32x4){0.f, 0.f, 0.f, 0.f};
        cur = nxt; cA = nA; cB = nB; ++ui;
        if constexpr (GATHER) { _Pragma("unroll") for (int h = 0; h < 2; ++h) _Pragma("unroll") for (int i = 0; i < 2; ++i) voffA[h][i] = nvoffA[h][i]; }
        if (wr == 1) PG8_BAR;
    }
    PG8_WAIT_V(0);
    PG8_BAR;
#undef PG8_SA
#undef PG8_SB
#undef PG8_STAGE
#undef PG8_LDA
#undef PG8_LDB
#undef PG8_MMA
#undef PG8_WAIT_V
#undef PG8_WAIT_L
#undef PG8_BAR
#undef PG8_SCHED
#undef PG8_GATHER
}
}

struct Params {
    const float* in[25];
    float* out;
    unsigned char* ws;
    int ph_lo, ph_hi;
};
struct Frame {
    LAS unsigned char* lds;
    unsigned* ctl;
    int tid, lane, wave, G, bid;
    unsigned char* ws;
};
#define WSP(T, off) ((T*)(F.ws + (off)))

using pg8::Unit; using pg8::BM; using pg8::HALF; using pg8::cvt_pk_bf16;

struct EpiIn {
    static constexpr bool PERM = true;
    unsigned char* ws; const float* b_fgt;
    DI bf16_t* dest(int cg, bool& trans, float& sc) const {
        trans = false; sc = 1.f;
        if (cg < 8)  { sc = C2; return (bf16_t*)(ws + WS_QN) + (size_t)cg * S * 64; }
        if (cg < 12) { return (bf16_t*)(ws + WS_CKV) + (size_t)(cg - 8) * CKROWS * 64; }
        if (cg < 14) { return (bf16_t*)(ws + WS_SK) + (size_t)(cg - 12) * S * 64; }
        if (cg < 16) { trans = true; return (bf16_t*)(ws + WS_SVT) + (size_t)(cg - 14) * 64 * S; }
        if (cg < 18) { return (bf16_t*)(ws + WS_WK) + (size_t)(cg - 16) * S * 64; }
        if (cg < 20) { trans = true; return (bf16_t*)(ws + WS_WVT) + (size_t)(cg - 18) * 64 * S; }
        if (cg < 28) { sc = C2; return (bf16_t*)(ws + WS_FQ) + (size_t)(cg - 20) * S * 64; }
        if (cg < 36) { return (bf16_t*)(ws + WS_FK) + (size_t)(cg - 28) * S * 64; }
        trans = true; return (bf16_t*)(ws + WS_FVT) + (size_t)(cg - 36) * 64 * S;
    }
    DI void operator()(const f32x4 (&acc)[2][2][4][2], const Unit& u, int wr, int wc, int fr, int fq) const {
        asm volatile("" : "+v"(fr), "+v"(fq)); asm volatile("" : "+s"(wr), "+s"(wc));
        const int row0 = u.pm * BM + wr * 64 + fr;
        if (u.pn <= 10) {
#pragma unroll
            for (int bj = 0; bj < 2; ++bj) {
                const int cb = 128 * bj + 32 * wc, cg = u.pn * 4 + (cb >> 6), d0 = (cb & 63) + 8 * fq;
                bool trans; float sc; bf16_t* base = dest(cg, trans, sc);
#pragma unroll
                for (int ai = 0; ai < 2; ++ai)
#pragma unroll
                    for (int m = 0; m < 4; ++m) {
                        const int t = row0 + ai * HALF + m * 16;
                        const f32x4 v0 = acc[ai][bj][m][0] * sc, v1 = acc[ai][bj][m][1] * sc;
                        if (!trans) { u32x4 w; w.x = cvt_pk_bf16(v0[0], v0[1]); w.y = cvt_pk_bf16(v0[2], v0[3]); w.z = cvt_pk_bf16(v1[0], v1[1]); w.w = cvt_pk_bf16(v1[2], v1[3]);
                            *(u32x4*)(base + (size_t)t * 64 + d0) = w; }
                        else {
#pragma unroll
                            for (int j = 0; j < 4; ++j) { base[((size_t)(t >> 5) * 64 + d0 + j) * 32 + (t & 31)] = (bf16_t)f2bf(v0[j]); base[((size_t)(t >> 5) * 64 + d0 + 4 + j) * 32 + (t & 31)] = (bf16_t)f2bf(v1[j]); }
                        }
                    }
            }
        } else if (u.pn <= 26) {
            bf16_t* gm = (bf16_t*)(ws + WS_GM);
#pragma unroll
            for (int bj = 0; bj < 2; ++bj) {
                const int col = (u.pn - 11) * 256 + 128 * bj + 32 * wc + 8 * fq;
#pragma unroll
                for (int ai = 0; ai < 2; ++ai)
#pragma unroll
                    for (int m = 0; m < 4; ++m) {
                        const int t = row0 + ai * HALF + m * 16;
                        const f32x4 v0 = acc[ai][bj][m][0], v1 = acc[ai][bj][m][1];
                        u32x4 w; w.x = cvt_pk_bf16(sigmoidf_(v0[0]), sigmoidf_(v0[1])); w.y = cvt_pk_bf16(sigmoidf_(v0[2]), sigmoidf_(v0[3]));
                        w.z = cvt_pk_bf16(sigmoidf_(v1[0]), sigmoidf_(v1[1])); w.w = cvt_pk_bf16(sigmoidf_(v1[2]), sigmoidf_(v1[3]));
                        *(u32x4*)(gm + (size_t)t * 4096 + col) = w;
                    }
            }
        } else {
            if (wc == 0) {
                float* gn = (float*)(ws + WS_GN); float* lf = (float*)(ws + WS_LOGF);
#pragma unroll
                for (int ai = 0; ai < 2; ++ai)
#pragma unroll
                    for (int m = 0; m < 4; ++m) {
                        const int t = row0 + ai * HALF + m * 16;
#pragma unroll
                        for (int n = 0; n < 2; ++n)
#pragma unroll
                            for (int j = 0; j < 4; ++j) {
                                const int c = 8 * fq + 4 * n + j; const float v = acc[ai][0][m][n][j];
                                if (c < 24) gn[(size_t)t * 24 + c] = sigmoidf_(v);
                                else lf[(size_t)t * 8 + (c - 24)] = logsigmoidf_(v + b_fgt[c - 24]);
                            }
                    }
            }
        }
    }
};

DI float gelu_tanh(float x) { const float u = 0.7978845608028654f * (x + 0.044715f * x * x * x); return 0.5f * x * (1.f + tanhf(u)); }

struct EpiCmp {
    static constexpr bool PERM = false;
    float* hp;
    DI void operator()(const f32x4 (&acc)[2][2][4][2], const Unit& u, int wr, int wc, int fr, int fq) const {
        asm volatile("" : "+v"(fr), "+v"(fq)); asm volatile("" : "+s"(wr), "+s"(wc));
        const int row0 = u.pm * BM + wr * 64 + fr; float* base = hp + (size_t)u.aux * 1024 * 256;
#pragma unroll
        for (int bj = 0; bj < 2; ++bj)
#pragma unroll
            for (int n = 0; n < 2; ++n) { const int col = 128 * bj + 32 * wc + 16 * n + 4 * fq;
#pragma unroll
                for (int ai = 0; ai < 2; ++ai)
#pragma unroll
                    for (int m = 0; m < 4; ++m) *(f32x4*)(base + (size_t)(row0 + ai * HALF + m * 16) * 256 + col) = acc[ai][bj][m][n]; }
    }
};
struct SchedCmp {
    int G, c;
    DI bool next(int i, Unit& u) const { const int L = i * G + c; if (L >= 64) return false; const int ks = L & 3, zg = L >> 4; u.pm = (L >> 2) & 3; u.pn = 0; u.aux = ks * 4 + zg;
        u.aoff = ((size_t)zg * CKROWS * 64 + (size_t)u.pm * 256 * 1024 + ks * 512) * 2; u.boff = ((size_t)(zg >> 1) * 256 * 2048 + ks * 512) * 2; return true; }
};

template <int STEP> struct EpiMerge {
    static constexpr bool PERM = true;
    const bf16_t* gm; bf16_t* mg;
    DI void operator()(const f32x4 (&acc)[2][2][4][2], const Unit& u, int wr, int wc, int fr, int fq) const {
        asm volatile("" : "+v"(fr), "+v"(fq)); asm volatile("" : "+s"(wr), "+s"(wc));
        const int row0 = u.pm * BM + wr * 64 + fr;
#pragma unroll
        for (int bj = 0; bj < 2; ++bj) {
            const int col = u.pn * 256 + 128 * bj + 32 * wc + 8 * fq;
#pragma unroll
            for (int ai = 0; ai < 2; ++ai)
#pragma unroll
                for (int m = 0; m < 4; ++m) {
                    const int t = row0 + ai * HALF + m * 16;
                    const u32x4 gw = *(const u32x4*)(gm + (size_t)t * 4096 + (STEP - 1) * 2048 + col);
                    float gv[8], pv[8];
#pragma unroll
                    for (int j = 0; j < 4; ++j) { gv[2 * j] = __builtin_bit_cast(float, gw[j] << 16); gv[2 * j + 1] = __builtin_bit_cast(float, gw[j] & 0xffff0000u); }
                    if (STEP == 2) { const u32x4 pw = *(const u32x4*)(mg + (size_t)t * 2048 + col);
#pragma unroll
                        for (int j = 0; j < 4; ++j) { pv[2 * j] = __builtin_bit_cast(float, pw[j] << 16); pv[2 * j + 1] = __builtin_bit_cast(float, pw[j] & 0xffff0000u); } }
                    else {
#pragma unroll
                        for (int j = 0; j < 8; ++j) pv[j] = 0.f; }
                    const f32x4 v0 = acc[ai][bj][m][0], v1 = acc[ai][bj][m][1];
                    float o[8];
#pragma unroll
                    for (int j = 0; j < 4; ++j) { o[j] = pv[j] + gv[j] * v0[j]; o[4 + j] = pv[4 + j] + gv[4 + j] * v1[j]; }
                    u32x4 w; w.x = cvt_pk_bf16(o[0], o[1]); w.y = cvt_pk_bf16(o[2], o[3]); w.z = cvt_pk_bf16(o[4], o[5]); w.w = cvt_pk_bf16(o[6], o[7]);
                    *(u32x4*)(mg + (size_t)t * 2048 + col) = w;
                }
        }
    }
};

struct EpiWo {
    static constexpr bool PERM = true;
    const float* mod; bf16_t* yb;
    DI void operator()(const f32x4 (&acc)[2][2][4][2], const Unit& u, int wr, int wc, int fr, int fq) const {
        asm volatile("" : "+v"(fr), "+v"(fq)); asm volatile("" : "+s"(wr), "+s"(wc));
        const int row0 = u.pm * BM + wr * 64 + fr;
#pragma unroll
        for (int bj = 0; bj < 2; ++bj) {
            const int col = u.pn * BM + 128 * bj + 32 * wc + 8 * fq;
            const f32x4 ga = *(const f32x4*)(mod + 2 * D + col) + 1.0f, gb = *(const f32x4*)(mod + 2 * D + col + 4) + 1.0f;
#pragma unroll
            for (int ai = 0; ai < 2; ++ai)
#pragma unroll
                for (int m = 0; m < 4; ++m) {
                    const f32x4 v0 = acc[ai][bj][m][0] * ga, v1 = acc[ai][bj][m][1] * gb;
                    u32x4 w; w.x = cvt_pk_bf16(v0[0], v0[1]); w.y = cvt_pk_bf16(v0[2], v0[3]); w.z = cvt_pk_bf16(v1[0], v1[1]); w.w = cvt_pk_bf16(v1[2], v1[3]);
                    *(u32x4*)(yb + (size_t)(row0 + ai * HALF + m * 16) * D + col) = w;
                }
        }
    }
};

struct SchedMoe {
    const LAS int* pane; int npn, G, c; size_t arow_bytes, btile_bytes;
    DI bool next(int i, Unit& u) const {
        const int np = pane[0]; const int L = i * G + c; if (L >= np * npn) return false;
        const int p = L / npn, pn = L - p * npn, e = pane[1 + p];
        u.pm = p; u.pn = pn; u.aux = e; u.aoff = (size_t)p * arow_bytes; u.boff = (size_t)(e * npn + pn) * btile_bytes; return true;
    }
};
struct EpiGU {
    static constexpr bool PERM = true;
    bf16_t* h;
    DI void operator()(const f32x4 (&acc)[2][2][4][2], const Unit& u, int wr, int wc, int fr, int fq) const {
        asm volatile("" : "+v"(fr), "+v"(fq)); asm volatile("" : "+s"(wr), "+s"(wc));
        const int row0 = u.pm * BM + wr * 64 + fr; const int col = u.pn * 128 + 32 * wc + 8 * fq;
#pragma unroll
        for (int ai = 0; ai < 2; ++ai)
#pragma unroll
            for (int m = 0; m < 4; ++m) {
                const int r = row0 + ai * HALF + m * 16;
                float o[8];
#pragma unroll
                for (int n = 0; n < 2; ++n)
#pragma unroll
                    for (int j = 0; j < 4; ++j) { const float gt = acc[ai][0][m][n][j], up = acc[ai][1][m][n][j]; o[4 * n + j] = gt * sigmoidf_(gt) * up; }
                u32x4 w; w.x = cvt_pk_bf16(o[0], o[1]); w.y = cvt_pk_bf16(o[2], o[3]); w.z = cvt_pk_bf16(o[4], o[5]); w.w = cvt_pk_bf16(o[6], o[7]);
                *(u32x4*)(h + (size_t)r * DEXP + col) = w;
            }
    }
};
struct EpiDown {
    static constexpr bool PERM = true;
    const int* rowdst; const float* roww; bf16_t* y2;
    DI void operator()(const f32x4 (&acc)[2][2][4][2], const Unit& u, int wr, int wc, int fr, int fq) const {
        asm volatile("" : "+v"(fr), "+v"(fq)); asm volatile("" : "+s"(wr), "+s"(wc));
        const int row0 = u.pm * BM + wr * 64 + fr;
#pragma unroll
        for (int ai = 0; ai < 2; ++ai)
#pragma unroll
            for (int m = 0; m < 4; ++m) {
                const int r = row0 + ai * HALF + m * 16; const int dst = rowdst[r];
                if (dst >= 0) { const float w8 = roww[r];
#pragma unroll
                    for (int bj = 0; bj < 2; ++bj) { const int col = u.pn * 256 + 128 * bj + 32 * wc + 8 * fq;
                        const f32x4 v0 = acc[ai][bj][m][0] * w8, v1 = acc[ai][bj][m][1] * w8;
                        u32x4 w; w.x = cvt_pk_bf16(v0[0], v0[1]); w.y = cvt_pk_bf16(v0[2], v0[3]); w.z = cvt_pk_bf16(v1[0], v1[1]); w.w = cvt_pk_bf16(v1[2], v1[3]);
                        *(u32x4*)(y2 + (size_t)dst * D + col) = w; } }
            }
    }
};


template <int UNR = 4> DI void tr_item(const float* srcrow0, int ldsrc, int col4, bool colok, bf16_t* dst, int ldd, int nrows, LAS float* scr, int lane) {
#pragma unroll UNR
    for (int it = 0; it < 16; ++it) { const int k = it * 4 + (lane >> 4); f32x4 v = (f32x4){0.f, 0.f, 0.f, 0.f};
        if (colok) v = (UNR == 16) ? __builtin_nontemporal_load((const f32x4*)(srcrow0 + (size_t)k * ldsrc + col4)) : *(const f32x4*)(srcrow0 + (size_t)k * ldsrc + col4);
        LAS float* s = scr + k * 65 + (lane & 15) * 4; s[0] = v[0]; s[1] = v[1]; s[2] = v[2]; s[3] = v[3]; }
    asm volatile("s_waitcnt lgkmcnt(0)" ::: "memory");
    const int c = lane & 7;
#pragma unroll
    for (int it = 0; it < 8; ++it) { const int n = it * 8 + (lane >> 3); const LAS float* s = scr + (8 * c) * 65 + n;
        u32x4 o; o.x = cvtpk(s[0 * 65], s[1 * 65]); o.y = cvtpk(s[2 * 65], s[3 * 65]); o.z = cvtpk(s[4 * 65], s[5 * 65]); o.w = cvtpk(s[6 * 65], s[7 * 65]);
        if (n < nrows) { if (UNR == 16) __builtin_nontemporal_store(o, (u32x4*)(dst + (size_t)n * ldd + 8 * c)); else *(u32x4*)(dst + (size_t)n * ldd + 8 * c) = o; } }
    asm volatile("s_waitcnt lgkmcnt(0)" ::: "memory");
}

template <int PART> DI void phase_prologue(Frame& F, const Params& P) {
    LAS float* scr = (LAS float*)(F.lds + F.wave * 16640);
    const int gw = F.bid * NWAVES + F.wave, NGW = F.G * NWAVES, lane = F.lane;
    const int c4 = (lane & 15) * 4;
    constexpr int I_IN = 32 * 109, I_W1 = 2 * 32 * 4, I_BR = 8 * 32, I_WO = 32 * 32, I_G = NEXP * 32 * 8, I_D = NEXP * 8 * 32;
    constexpr int I_MOD = 48 * 32, I_PEW = 64, I_RT = 32;
    constexpr int NITEMS = I_IN + I_W1 + 2 * I_BR + I_WO + 2 * I_G + I_D + I_MOD + I_PEW + I_RT;
    constexpr int NTR = NITEMS - (I_MOD + I_PEW + I_RT);
    constexpr int I_MOE = 2 * I_G + I_D, R_MOE = I_IN + I_W1 + 2 * I_BR + I_WO;
    constexpr int NLOOP = !WCO ? NITEMS : (PART == 0 ? (I_MOD + I_PEW + I_RT) + R_MOE : I_MOE);
    for (int it = gw; it < NLOOP; it += NGW) {
        int r;
        if (!WCO) r = it < (I_MOD + I_PEW + I_RT) ? NTR + it : it - (I_MOD + I_PEW + I_RT);
        else if (PART == 1) r = R_MOE + it;
        else r = it < (I_MOD + I_PEW + I_RT) ? NTR + it : it - (I_MOD + I_PEW + I_RT);
        if (r < I_IN) {
            const int kb = r / 109, nb = r % 109, j0 = nb * 64; const float* w = P.in[4] + (size_t)(kb * 64) * IN_COLS;
            bf16_t* dst = WSP(bf16_t, WS_WINT) + (size_t)j0 * D + kb * 64;
            if (nb < 108) { const int oc = j0 < 1280 ? j0 : (j0 < 2816 ? j0 + 24 : j0 + 32); tr_item(w, IN_COLS, oc + c4, true, dst, D, 64, scr, lane); }
            else { const int oc = c4 < 24 ? OFF_GATE + c4 : OFF_FGT + (c4 - 24); tr_item(w, IN_COLS, oc, c4 < 32, dst, D, 32, scr, lane); }
            continue; } r -= I_IN;
        if (r < I_W1) { const int z = r / 128, q = r % 128, kb = q / 4, nb = q % 4;
            tr_item(P.in[8] + (size_t)z * 2048 * 256 + (size_t)(kb * 64) * 256, 256, nb * 64 + c4, true, WSP(bf16_t, WS_W1T) + ((size_t)z * 256 + nb * 64) * 2048 + kb * 64, 2048, 64, scr, lane);
            continue; } r -= I_W1;
        if (r < 2 * I_BR) { const int which = r / I_BR, q = r % I_BR, kb = q / 32, nb = q % 32;
            tr_item(P.in[11 + which] + (size_t)(kb * 64) * 2048, 2048, nb * 64 + c4, true, WSP(bf16_t, which ? WS_BRT2 : WS_BRT1) + (size_t)(nb * 64) * 512 + kb * 64, 512, 64, scr, lane);
            continue; } r -= 2 * I_BR;
        if (r < I_WO) { const int kb = r / 32, nb = r % 32;
            tr_item(P.in[13] + (size_t)(kb * 64) * 2048, 2048, nb * 64 + c4, true, WSP(bf16_t, WS_WOT) + (size_t)(nb * 64) * 2048 + kb * 64, 2048, 64, scr, lane);
            continue; } r -= I_WO;
        if (r < 2 * I_G) { const int up = r / I_G, q = r % I_G, e = q / 256, q2 = q % 256, kb = q2 / 8, nb = q2 % 8;
            const int n0 = nb * 64, drow = (n0 >> 7) * 256 + up * 128 + (n0 & 127);
            tr_item<(PART == 1 ? 16 : 4)>(P.in[20 + up] + (size_t)e * 2048 * 512 + (size_t)(kb * 64) * 512, 512, n0 + c4, true, WSP(bf16_t, WS_WGUT) + ((size_t)e * 1024 + drow) * 2048 + kb * 64, 2048, 64, scr, lane);
            continue; } r -= 2 * I_G;
        if (r < I_D) { const int e = r / 256, q2 = r % 256, kb = q2 / 32, nb = q2 % 32;
            tr_item<(PART == 1 ? 16 : 4)>(P.in[22] + (size_t)e * 512 * 2048 + (size_t)(kb * 64) * 2048, 2048, nb * 64 + c4, true, WSP(bf16_t, WS_WDT) + ((size_t)e * 2048 + nb * 64) * 512 + kb * 64, 512, 64, scr, lane);
            continue; } r -= I_D;
        if (r < I_MOD) {
            const int cc = r / 32, kc = r % 32; const float* c = P.in[1]; const float* w = P.in[2] + (size_t)(kc * 64) * 12288 + cc * 256 + lane * 4;
            f32x4 a = (f32x4){0.f, 0.f, 0.f, 0.f};
#pragma unroll 8
            for (int k = 0; k < 64; ++k) { const float cv = c[kc * 64 + k]; const float sv = cv / (1.f + __expf(-cv)); a += *(const f32x4*)(w + (size_t)k * 12288) * sv; }
            *(f32x4*)(WSP(float, WS_MODP) + (size_t)kc * 12288 + cc * 256 + lane * 4) = a;
            continue; } r -= I_MOD;
        if (r >= I_PEW) {
            const int k0 = (r - I_PEW) * 64; bf16_t* th = WSP(bf16_t, WS_WRT); bf16_t* tl = th + 80 * 2048;
#pragma unroll 4
            for (int kk = 0; kk < 64; ++kk) scr[kk * 65 + lane] = P.in[18][(size_t)(k0 + kk) * 64 + lane];
            asm volatile("s_waitcnt lgkmcnt(0)" ::: "memory");
#pragma unroll 4
            for (int n = 0; n < 64; ++n) { const float v = scr[lane * 65 + n]; const unsigned hb = f2bf(v);
                th[(size_t)(8 + n) * 2048 + k0 + lane] = (bf16_t)hb; tl[(size_t)(8 + n) * 2048 + k0 + lane] = (bf16_t)f2bf(v - __builtin_bit_cast(float, hb << 16)); }
#pragma unroll
            for (int n = 0; n < 8; ++n) { const float v = P.in[16][(size_t)(k0 + lane) * 8 + n]; const unsigned hb = f2bf(v);
                th[(size_t)n * 2048 + k0 + lane] = (bf16_t)hb; tl[(size_t)n * 2048 + k0 + lane] = (bf16_t)f2bf(v - __builtin_bit_cast(float, hb << 16));
                th[(size_t)(72 + n) * 2048 + k0 + lane] = 0; tl[(size_t)(72 + n) * 2048 + k0 + lane] = 0; }
            asm volatile("s_waitcnt lgkmcnt(0)" ::: "memory");
            continue; }
        {
            const int z = r / 32, fc = r % 32; const float* pe = P.in[7] + z * 2048 + fc * 64; const float* w = P.in[8] + (size_t)z * 2048 * 256 + (size_t)(fc * 64) * 256 + lane * 4;
            f32x4 a = (f32x4){0.f, 0.f, 0.f, 0.f};
#pragma unroll 8
            for (int k = 0; k < 64; ++k) a += *(const f32x4*)(w + (size_t)k * 256) * pe[k];
            *(f32x4*)(WSP(float, WS_PEWP) + ((size_t)z * 32 + fc) * 256 + lane * 4) = a;
        }
    }
    if (PART == 1) return;
    int* rt = WSP(int, WS_ROWTOK); int* rd = WSP(int, WS_ROWDST);
    for (int i = F.bid * NTHREADS + F.tid; i < MAXROWS; i += F.G * NTHREADS) { rt[i] = -1; rd[i] = -1; }
    { int* tk = WSP(int, WS_TOKL); for (int i = F.bid * NTHREADS + F.tid; i < 2 * BMS_MAXU * 64; i += F.G * NTHREADS) tk[i] = -1; }
}

DI void phase_ln1(Frame& F, const Params& P) {
    const int gid = F.bid * NTHREADS + F.tid;
    const float* modp = WSP(float, WS_MODP);
    if (gid < 12288) { float a = P.in[3][gid]; for (int kc = 0; kc < 32; ++kc) a += modp[(size_t)kc * 12288 + gid]; WSP(float, WS_MOD)[gid] = a; }
    else if (gid < 12288 + 512) { const int q = gid - 12288, z = q >> 8, col = q & 255; float a = P.in[9][q]; const float* pw = WSP(float, WS_PEWP);
        for (int fc = 0; fc < 32; ++fc) a += pw[((size_t)z * 32 + fc) * 256 + col]; WSP(float, WS_BIASC)[q] = a; }
    const int lane = F.lane;
    f32x4 sc[8], sh[8];
#pragma unroll
    for (int j = 0; j < 8; ++j) { const int col = 4 * lane + 256 * j; f32x4 a = *(const f32x4*)(P.in[3] + col), b = *(const f32x4*)(P.in[3] + D + col);
        for (int kc = 0; kc < 32; ++kc) { a += *(const f32x4*)(modp + (size_t)kc * 12288 + col); b += *(const f32x4*)(modp + (size_t)kc * 12288 + D + col); }
        sh[j] = a; sc[j] = b + 1.0f; }
    const int gw = F.bid * NWAVES + F.wave, NGW = F.G * NWAVES;
    const float* x = P.in[0]; bf16_t* U = WSP(bf16_t, WS_U);
    for (int m = gw; m < S; m += NGW) {
        const f32x4* xr = (const f32x4*)(x + (size_t)m * D) + lane;
        f32x4 v[8]; float s = 0.f;
#pragma unroll
        for (int j = 0; j < 8; ++j) { v[j] = xr[64 * j]; s += (v[j][0] + v[j][1]) + (v[j][2] + v[j][3]); }
        const float mean = wave_sum(s) * (1.f / D); float s2 = 0.f;
#pragma unroll
        for (int j = 0; j < 8; ++j) { v[j] = v[j] - mean; s2 += (v[j][0] * v[j][0] + v[j][1] * v[j][1]) + (v[j][2] * v[j][2] + v[j][3] * v[j][3]); }
        const float rstd = 1.f / sqrtf(wave_sum(s2) * (1.f / D) + LN_EPS);
        u32x2* o8 = (u32x2*)(U + (size_t)m * D) + lane;
#pragma unroll
        for (int j = 0; j < 8; ++j) { const f32x4 y = v[j] * rstd * sc[j] + sh[j]; u32x2 w; w.x = cvtpk(y[0], y[1]); w.y = cvtpk(y[2], y[3]); o8[64 * j] = w; }
    }
}

DI f32x16 mfma32(bf16x8 a, bf16x8 b, f32x16 c) { return __builtin_amdgcn_mfma_f32_32x32x16_bf16(a, b, c, 0, 0, 0); }
DI f32x4 mfma16(bf16x8 a, bf16x8 b, f32x4 c) { return __builtin_amdgcn_mfma_f32_16x16x32_bf16(a, b, c, 0, 0, 0); }
DI int perm23(int i) { return (i & ~12) | ((i & 4) << 1) | ((i & 8) >> 1); }
DI int crow(int r, int hi) { return (r & 3) + 8 * (r >> 2) + 4 * hi; }
constexpr float NEG_INF = -__builtin_inff();

template <int CTRL> DI float dppf(float x) { return __builtin_bit_cast(float, __builtin_amdgcn_update_dpp(0, __builtin_bit_cast(int, x), CTRL, 0xF, 0xF, true)); }
template <int CTRL> DI int dppi(int x) { return __builtin_amdgcn_update_dpp(0, x, CTRL, 0xF, 0xF, true); }
DI float xmax32(float x) { auto rr = __builtin_amdgcn_permlane32_swap(__float_as_uint(x), __float_as_uint(x), false, false); return fmaxf(__uint_as_float(rr[0]), __uint_as_float(rr[1])); }
DI float xadd32(float x) { auto rr = __builtin_amdgcn_permlane32_swap(__float_as_uint(x), __float_as_uint(x), false, false); return __uint_as_float(rr[0]) + __uint_as_float(rr[1]); }
DI float xmax16(float x) { auto rr = __builtin_amdgcn_permlane16_swap(__float_as_uint(x), __float_as_uint(x), false, false); return fmaxf(__uint_as_float(rr[0]), __uint_as_float(rr[1])); }
DI float xadd16(float x) { auto rr = __builtin_amdgcn_permlane16_swap(__float_as_uint(x), __float_as_uint(x), false, false); return __uint_as_float(rr[0]) + __uint_as_float(rr[1]); }
DI float quad_sum(float x) { x += dppf<0xB1>(x); x += dppf<0x4E>(x); return x; }
DI float row_maxf(float x) { x = fmaxf(x, dppf<0xB1>(x)); x = fmaxf(x, dppf<0x4E>(x)); x = fmaxf(x, dppf<0x124>(x)); x = fmaxf(x, dppf<0x128>(x)); return x; }
DI float row_minf(float x) { x = fminf(x, dppf<0xB1>(x)); x = fminf(x, dppf<0x4E>(x)); x = fminf(x, dppf<0x124>(x)); x = fminf(x, dppf<0x128>(x)); return x; }
DI int row_mini(int x) { int y; y = dppi<0xB1>(x); x = y < x ? y : x; y = dppi<0x4E>(x); x = y < x ? y : x; y = dppi<0x124>(x); x = y < x ? y : x; y = dppi<0x128>(x); x = y < x ? y : x; return x; }
DI float rdl(float x, int l) { return __int_as_float(__builtin_amdgcn_readlane(__float_as_int(x), l)); }
DI float wave_max_u(float x) { x = row_maxf(x); const float a = rdl(x, 0), b = rdl(x, 16), c = rdl(x, 32), d = rdl(x, 48); return fmaxf(fmaxf(a, b), fmaxf(c, d)); }
DI float wave_min_u(float x) { x = row_minf(x); const float a = rdl(x, 0), b = rdl(x, 16), c = rdl(x, 32), d = rdl(x, 48); return fminf(fminf(a, b), fminf(c, d)); }
DI int wave_min_ui(int x) { x = row_mini(x); const int a = __builtin_amdgcn_readlane(x, 0), b = __builtin_amdgcn_readlane(x, 16), c = __builtin_amdgcn_readlane(x, 32), d = __builtin_amdgcn_readlane(x, 48); const int ab = a < b ? a : b, cd = c < d ? c : d; return ab < cd ? ab : cd; }

DI void phase_cmp2_scan(Frame& F, const Params& P) {
    const int lane = F.lane;
    { const float* hp = WSP(float, WS_HC); const float* w2 = P.in[10];
      for (int row = F.bid * NWAVES + F.wave; row < 4 * 1024; row += F.G * NWAVES) {
        const int zg = row >> 10, n = row & 1023, z = zg >> 1, g = zg & 1;
        f32x4 hv = *(const f32x4*)(WSP(float, WS_BIASC) + z * 256 + 4 * lane);
#pragma unroll
        for (int ks = 0; ks < 4; ++ks) hv += *(const f32x4*)(hp + ((size_t)(ks * 4 + zg) * 1024 + n) * 256 + 4 * lane);
        const float h0 = gelu_tanh(hv[0]), h1 = gelu_tanh(hv[1]), h2 = gelu_tanh(hv[2]), h3 = gelu_tanh(hv[3]);
        const float* w = w2 + (size_t)z * 256 * 64 + lane;
        float a = 0.f;
#pragma unroll 8
        for (int q = 0; q < 64; ++q) { a += rdl(h0, q) * w[(4 * q) * 64]; a += rdl(h1, q) * w[(4 * q + 1) * 64]; a += rdl(h2, q) * w[(4 * q + 2) * 64]; a += rdl(h3, q) * w[(4 * q + 3) * 64]; }
        if (z == 0) WSP(bf16_t, WS_KC)[((size_t)g * 1024 + n) * 64 + lane] = (bf16_t)f2bf(a);
        else WSP(bf16_t, WS_VCT)[(size_t)g * 64 * 1024 + ((size_t)(n >> 5) * 64 + lane) * 32 + (n & 31)] = (bf16_t)f2bf(a);
      } }
    { const int h = F.wave;
      for (int kb = F.bid; kb < S / 64; kb += F.G) {
        const u32x4* kr = (const u32x4*)(WSP(bf16_t, WS_FK) + ((size_t)h * S + kb * 64 + lane) * 64); float a = 0.f;
#pragma unroll
        for (int c = 0; c < 8; ++c) { const u32x4 wv = kr[c];
#pragma unroll
            for (int q = 0; q < 4; ++q) { const float lo = __builtin_bit_cast(float, wv[q] << 16), hi2 = __builtin_bit_cast(float, wv[q] & 0xffff0000u); a += lo * lo + hi2 * hi2; } }
        a = wave_max_u(a);
        if (lane == 0) WSP(float, WS_KMAX)[kb * 8 + h] = a;
      } }
    const int hb = F.G - 1 - F.bid;
    if (hb >= 0 && hb < 8) {
        const int h = hb; const float* lf = WSP(float, WS_LOGF); float* fc = WSP(float, WS_FC) + (size_t)h * S;
        LAS double* red = (LAS double*)F.lds;
        double loc = 0.0; const int t0 = F.tid * 32; float v[32];
#pragma unroll
        for (int i = 0; i < 32; ++i) { v[i] = lf[(size_t)(t0 + i) * 8 + h]; loc += (double)v[i]; }
        double inc = loc;
#pragma unroll
        for (int o = 1; o < 64; o <<= 1) { const double up = __shfl_up(inc, o); if (lane >= o) inc += up; }
        if (lane == 63) red[F.wave] = inc;
        __syncthreads();
        double run = inc - loc;
        for (int w = 0; w < F.wave; ++w) run += red[w];
#pragma unroll
        for (int i = 0; i < 32; ++i) { run += (double)v[i]; fc[t0 + i] = (float)run; }
        __syncthreads();
    }
}


constexpr int PSLC_LD = 272, XLD = 65, TB_LD = 132;
constexpr int AW_SEL = 512;
constexpr int AW_PSLC = 8 * PSLC_LD * 4;
constexpr int KROW = 144, VROW = 80;
constexpr int ST_K = 0, ST_V = 64 * KROW, ST_B = ST_V + 2 * 64 * VROW, ST_BYTES = ST_B + 256;
constexpr int AL_SELM = 0, AL_PSLC = NWAVES * AW_SEL, AL_STAGE = AL_PSLC + NWAVES * AW_PSLC, AL_TB = 135 * 1024, AL_FLAG = AL_TB + 2 * 4 * TB_LD * 4, AL_END = AL_FLAG + 128;
constexpr int SEL_TB = 3;
constexpr int AL_SEL2 = AL_PSLC, SEL2_BYTES = SEL_TB * ST_B;
static_assert(AL_SEL2 + 2 * SEL2_BYTES <= AL_TB && AL_STAGE + 2 * ST_BYTES <= AL_TB, "stages fit below the bias tables");
static_assert(AL_END <= LDS_MISC, "attention LDS map");

template <int SD, bool HAS_V, bool HAS_F, int TB = 1, int BASE = AL_STAGE, class Body>
DI void stream_tiles(Frame& F, const bf16_t* __restrict__ K, const bf16_t* __restrict__ Vtb, const float* __restrict__ Fk, float fref, int kv_first, int kv_step, int nt, Body&& body) {
    constexpr int STG = TB == 1 ? ST_BYTES : TB * ST_B;
    LAS unsigned char* st0 = F.lds + BASE;
    volatile LAS unsigned* flags = (volatile LAS unsigned*)(F.lds + AL_FLAG);
    const int tid = F.tid;
    const int krow = tid >> 3, kc = tid & 7;
    const int vsub = tid >> 8, vd = (tid & 255) >> 2, vc = tid & 3;
    const unsigned kdst = krow * KROW + kc * 16, vdst = ST_V + vsub * 64 * VROW + vd * VROW + vc * 16;
    const bf16_t* kbase = K + (size_t)krow * 64 + kc * 8; const bf16_t* vbase = HAS_V ? Vtb + tid * 8 : nullptr;
    u32x4 rk[SD][TB], rv[SD][TB]; float rf[SD];
#define ST_GLOAD(slot, kv0_) do { const int _kv = (kv0_); _Pragma("unroll") for (int _b = 0; _b < TB; ++_b) { rk[slot][_b] = *(const u32x4*)(kbase + (size_t)(_kv + 64 * _b) * 64); \
        if (HAS_V) rv[slot][_b] = *(const u32x4*)(vbase + (size_t)((_kv >> 5) + 2 * _b) * 2048); } if (HAS_F) { if (tid < 64) rf[slot] = Fk[_kv + tid]; } } while (0)
#define ST_LSTORE(stp, slot) do { LAS unsigned char* _st = (stp); _Pragma("unroll") for (int _b = 0; _b < TB; ++_b) { *(LAS u32x4*)(_st + _b * ST_B + kdst) = rk[slot][_b]; if (HAS_V) *(LAS u32x4*)(_st + _b * ST_B + vdst) = rv[slot][_b]; } \
        if (HAS_F) { if (tid < 64) *(LAS float*)(_st + ST_B + tid * 4) = (fref - rf[slot]) * LOG2E; } } while (0)
    if (nt <= 0) return;
    if (HAS_F) { if (tid < 16) flags[tid] = 0u; }
    ST_GLOAD(0, kv_first);
#pragma unroll
    for (int d = 1; d < SD; ++d) if (d < nt) ST_GLOAD(d, kv_first + d * kv_step);
    ST_LSTORE(st0, 0);
    if (SD < nt) ST_GLOAD(0, kv_first + SD * kv_step);
    __syncthreads();
    bool stop = false;
    for (int it0 = 0; it0 < nt && !stop; it0 += SD) {
#pragma unroll
        for (int d = 0; d < SD; ++d) {
            const int it = it0 + d;
            if (it >= nt || stop) break;
            const int par = (SD % 2 == 0) ? (d & 1) : (it & 1);
            __builtin_amdgcn_sched_barrier(0);
            const bool done = body(kv_first + it * kv_step, st0 + par * STG);
            __builtin_amdgcn_sched_barrier(0);
            if (it + 1 < nt) { ST_LSTORE(st0 + (par ^ 1) * STG, (d + 1) % SD); if (it + 1 + SD < nt) ST_GLOAD((d + 1) % SD, kv_first + (it + 1 + SD) * kv_step); }
            if constexpr (HAS_F) { if (F.lane == 0) flags[par * 8 + F.wave] = done ? 1u : 0u; } else { (void)done; }
            __syncthreads();
            if constexpr (HAS_F) {
                const u32x4 fa = *(volatile LAS u32x4*)(F.lds + AL_FLAG + par * 32), fb = *(volatile LAS u32x4*)(F.lds + AL_FLAG + par * 32 + 16);
                if ((fa[0] & fa[1] & fa[2] & fa[3] & fb[0] & fb[1] & fb[2] & fb[3]) != 0u) stop = true; }
        }
    }
    asm volatile("s_waitcnt vmcnt(0)" ::: "memory");
    __syncthreads();
#undef ST_GLOAD
#undef ST_LSTORE
}

DI void lds_k(bf16x8 (&kf)[4], const LAS unsigned char* st, int sub, int lane) {
    const LAS unsigned char* p = st + ST_K + (32 * sub + perm23(lane & 31)) * KROW + 16 * (lane >> 5);
#pragma unroll
    for (int ks = 0; ks < 4; ++ks) kf[ks] = *(const LAS bf16x8*)(p + 32 * ks);
}
DI void lds_v(bf16x8 (&vf)[4], const LAS unsigned char* st, int sub, int lane) {
    const LAS unsigned char* p = st + ST_V + sub * 64 * VROW + (lane & 31) * VROW + 16 * (lane >> 5);
#pragma unroll
    for (int d0 = 0; d0 < 2; ++d0)
#pragma unroll
        for (int s2 = 0; s2 < 2; ++s2) vf[d0 * 2 + s2] = *(const LAS bf16x8*)(p + d0 * 32 * VROW + 32 * s2);
}
DI f32x16 qk32f(const bf16x8 (&qf)[4], const bf16x8 (&kf)[4]) {
    f32x16 s;
#pragma unroll
    for (int r = 0; r < 16; ++r) s[r] = 0.f;
#pragma unroll
    for (int ks = 0; ks < 4; ++ks) s = mfma32(kf[ks], qf[ks], s);
    return s;
}
DI void pv32f(f32x16 (&o)[2], const f32x16& p, const bf16x8 (&vf)[4]) {
    bf16x8 pf[2];
#pragma unroll
    for (int s2 = 0; s2 < 2; ++s2) { u32x4 w; w.x = cvtpk(p[8 * s2 + 0], p[8 * s2 + 1]); w.y = cvtpk(p[8 * s2 + 2], p[8 * s2 + 3]); w.z = cvtpk(p[8 * s2 + 4], p[8 * s2 + 5]); w.w = cvtpk(p[8 * s2 + 6], p[8 * s2 + 7]); pf[s2] = __builtin_bit_cast(bf16x8, w); }
#pragma unroll
    for (int d0 = 0; d0 < 2; ++d0)
#pragma unroll
        for (int s2 = 0; s2 < 2; ++s2) o[d0] = mfma32(vf[d0 * 2 + s2], pf[s2], o[d0]);
}
DI float max16(const f32x16& s) {
    float mx = fmaxf(fmaxf(s[0], s[1]), fmaxf(s[2], s[3]));
#pragma unroll
    for (int r = 4; r < 16; r += 4) mx = fmaxf(mx, fmaxf(fmaxf(s[r], s[r + 1]), fmaxf(s[r + 2], s[r + 3])));
    return mx;
}
DI float online_upd(float mx, float& m, float& l, float& mu_out) {
    mx = xmax32(mx);
    const float mn = fmaxf(m, mx), mu = (mn == NEG_INF) ? 0.f : mn;
    const float alpha = fexp2(m - mu);
    l *= alpha; m = mn; mu_out = mu;
    return alpha;
}
DI void exp16(f32x16& s, float mu, float& l) {
    float ps = 0.f;
#pragma unroll
    for (int r = 0; r < 16; ++r) { s[r] = fexp2(s[r] - mu); ps += s[r]; }
    l += ps;
}

DI void fox_task(Frame& F, int h, int qb) {
    const int lane = F.lane, i = lane & 31, hi = lane >> 5, w = F.wave;
    const bf16_t* Q = WSP(bf16_t, WS_FQ) + (size_t)h * S * 64;
    const bf16_t* K = WSP(bf16_t, WS_FK) + (size_t)h * S * 64;
    const bf16_t* Vt = WSP(bf16_t, WS_FVT) + (size_t)h * 64 * S;
    const float* Fc = WSP(float, WS_FC) + (size_t)h * S;
    const int q0 = qb * 256, r0 = q0 + 32 * w, t = r0 + i;
    bf16x8 qf[4];
#pragma unroll
    for (int ks = 0; ks < 4; ++ks) qf[ks] = *(const bf16x8*)(Q + (size_t)t * 64 + 16 * ks + 8 * hi);
    asm volatile("" : "+v"(qf[0]), "+v"(qf[1]), "+v"(qf[2]), "+v"(qf[3]));
    const float fref = Fc[q0];
    float qn2 = 0.f;
#pragma unroll
    for (int ks = 0; ks < 4; ++ks)
#pragma unroll
        for (int j = 0; j < 8; ++j) { const float qv = bf2f((bf16_t)qf[ks][j]); qn2 += qv * qv; }
    qn2 = xadd32(qn2);
    float km2 = 0.f; { const float* kp = WSP(float, WS_KMAX) + h;
#pragma unroll
      for (int c = 0; c < 4; ++c) km2 = fmaxf(km2, kp[(lane + 64 * c) * 8]); }
    const float qkb = sqrtf(wave_max_u(qn2) * wave_max_u(km2)) * 1.01f;
    float m = NEG_INF, l = 0.f; f32x16 o[2];
#pragma unroll
    for (int r = 0; r < 16; ++r) { o[0][r] = 0.f; o[1][r] = 0.f; }
    constexpr float FOX_SKIP = 44.f;
    bool wdone = false;
    stream_tiles<4, true, true>(F, K, Vt, Fc, fref, q0 + 192, -64, qb * 4 + 4, [&](int kv0, const LAS unsigned char* st) __attribute__((always_inline)) -> bool {
        if (wdone) return true;
        if (kv0 > r0) return false;
        const bool two = (kv0 + 32 <= r0);
        bf16x8 kf[4]; f32x16 s0, s1;
        lds_k(kf, st, 0, lane); s0 = qk32f(qf, kf);
        { const LAS float* bp = (const LAS float*)(st + ST_B) + 8 * hi; const f32x4 b0 = *(const LAS f32x4*)(bp), b1 = *(const LAS f32x4*)(bp + 4), b2 = *(const LAS f32x4*)(bp + 16), b3 = *(const LAS f32x4*)(bp + 20);
#pragma unroll
          for (int r = 0; r < 16; ++r) s0[r] += (r < 4) ? b0[r & 3] : (r < 8) ? b1[r & 3] : (r < 12) ? b2[r & 3] : b3[r & 3]; }
        if (kv0 == r0) {
#pragma unroll
            for (int r = 0; r < 16; ++r) { const int key = kv0 + 16 * (r >> 3) + 8 * hi + (r & 7); s0[r] = (key <= t) ? s0[r] : NEG_INF; } }
        float mx = max16(s0);
        if (two) {
            lds_k(kf, st, 1, lane); s1 = qk32f(qf, kf);
            const LAS float* bp = (const LAS float*)(st + ST_B) + 32 + 8 * hi; const f32x4 b0 = *(const LAS f32x4*)(bp), b1 = *(const LAS f32x4*)(bp + 4), b2 = *(const LAS f32x4*)(bp + 16), b3 = *(const LAS f32x4*)(bp + 20);
#pragma unroll
            for (int r = 0; r < 16; ++r) s1[r] += (r < 4) ? b0[r & 3] : (r < 8) ? b1[r & 3] : (r < 12) ? b2[r & 3] : b3[r & 3];
            if (kv0 + 32 == r0) {
#pragma unroll
                for (int r = 0; r < 16; ++r) { const int key = kv0 + 32 + 16 * (r >> 3) + 8 * hi + (r & 7); s1[r] = (key <= t) ? s1[r] : NEG_INF; } }
            mx = fmaxf(mx, max16(s1));
        }
        float mu; const float alpha = online_upd(mx, m, l, mu);
        o[0] *= alpha; o[1] *= alpha;
        bf16x8 vf[4];
        exp16(s0, mu, l); lds_v(vf, st, 0, lane); pv32f(o, s0, vf);
        if (two) { exp16(s1, mu, l); lds_v(vf, st, 1, lane); pv32f(o, s1, vf); }
        const float b_first = *((const LAS float*)(st + ST_B));
        wdone = (qkb + b_first < wave_min_u(m) - FOX_SKIP);
        return wdone;
    });
    l = xadd32(l);
    const float inv = l > 0.f ? 1.f / l : 0.f;
    bf16_t* O = WSP(bf16_t, WS_O) + (size_t)t * 1024 + 512 + h * 64;
#pragma unroll
    for (int d0 = 0; d0 < 2; ++d0)
#pragma unroll
        for (int g4 = 0; g4 < 4; ++g4) { u32x2 wv; wv.x = cvtpk(o[d0][4 * g4] * inv, o[d0][4 * g4 + 1] * inv); wv.y = cvtpk(o[d0][4 * g4 + 2] * inv, o[d0][4 * g4 + 3] * inv);
            *(u32x2*)(O + 32 * d0 + 8 * g4 + 4 * hi) = wv; }
}

DI void t5_near(f32x16& s, const LAS float* tb, int dbase, int kstride, int key0, int hi, int dmax) {
#pragma unroll
    for (int r = 0; r < 16; ++r) { const int key = key0 + 16 * (r >> 3) + 8 * hi + (r & 7); const int dist = dbase - kstride * key;
        const int idx = dist < 0 ? 0 : (dist < 128 ? dist : 128); const float bv = tb[idx];
        s[r] = (dist >= 0 && dist < dmax) ? s[r] + bv : NEG_INF; }
}

DI void nsa_task(Frame& F, int g, int tg0, LAS float* pslc, LAS unsigned* selm, const LAS float* tbg) {
    const int lane = F.lane, i = lane & 31, hi = lane >> 5, tl = i >> 2, hh = i & 3, t0 = tg0 + 8 * F.wave, t = t0 + tl;
    const bf16_t* Q = WSP(bf16_t, WS_QN) + (size_t)(g * 4 + hh) * S * 64 + (size_t)t * 64;
    const bf16_t* Kc = WSP(bf16_t, WS_KC) + (size_t)g * 1024 * 64; const bf16_t* VcT = WSP(bf16_t, WS_VCT) + (size_t)g * 64 * 1024;
    const LAS float* tb = tbg + hh * TB_LD;
    const float tbfar = tb[128];
    bf16x8 qf[4];
#pragma unroll
    for (int ks = 0; ks < 4; ++ks) qf[ks] = *(const bf16x8*)(Q + 16 * ks + 8 * hi);
    asm volatile("" : "+v"(qf[0]), "+v"(qf[1]), "+v"(qf[2]), "+v"(qf[3]));
    const float* gn = WSP(float, WS_GN) + (size_t)t * 24 + g * 12 + hh * 3;
    const float g0 = gn[0], g2 = gn[2];
    const int tmax = t0 + 7;
    const int nt_c = (((tg0 + 63 - 31) >> 4) >> 6) + 1;
    float m = NEG_INF, l = 0.f;
    stream_tiles<2, false, false>(F, Kc, nullptr, nullptr, 0.f, 0, 64, nt_c, [&](int n0, const LAS unsigned char* st) __attribute__((always_inline)) -> bool {
#pragma unroll
        for (int sub = 0; sub < 2; ++sub) { const int ns = n0 + 32 * sub;
            if (16 * ns + 31 > tmax) continue;
            bf16x8 kf[4]; lds_k(kf, st, sub, lane); f32x16 s = qk32f(qf, kf);
            if (t0 - 16 * (ns + 31) - 31 >= 128) {
#pragma unroll
                for (int r = 0; r < 16; ++r) s[r] += tbfar; }
            else t5_near(s, tb, t - 31, 16, ns, hi, 1 << 30);
            float mu; (void)online_upd(max16(s), m, l, mu); exp16(s, mu, l);
        }
        return false; });
    l = xadd32(l);
    const float invl = l > 0.f ? 1.f / l : 0.f, mu = (m == NEG_INF) ? 0.f : m;
    float carry = 0.f;
    f32x16 oc[2];
#pragma unroll
    for (int r = 0; r < 16; ++r) { oc[0][r] = 0.f; oc[1][r] = 0.f; }
    stream_tiles<2, true, false>(F, Kc, VcT, nullptr, 0.f, 0, 64, nt_c, [&](int n0, const LAS unsigned char* st) __attribute__((always_inline)) -> bool {
#pragma unroll
        for (int sub = 0; sub < 2; ++sub) { const int ns = n0 + 32 * sub;
            if (16 * ns + 31 > tmax) continue;
            bf16x8 kf[4]; lds_k(kf, st, sub, lane); f32x16 s = qk32f(qf, kf);
            if (t0 - 16 * (ns + 31) - 31 >= 128) {
#pragma unroll
                for (int r = 0; r < 16; ++r) s[r] += tbfar; }
            else t5_near(s, tb, t - 31, 16, ns, hi, 1 << 30);
#pragma unroll
            for (int r = 0; r < 16; ++r) s[r] = fexp2(s[r] - mu) * invl;
            bf16x8 vf[4]; lds_v(vf, st, sub, lane); pv32f(oc, s, vf);
            { float a[4], b[4];
#pragma unroll
              for (int G4 = 0; G4 < 4; ++G4) { a[G4] = quad_sum(s[4 * G4] + s[4 * G4 + 1] + s[4 * G4 + 2] + 0.5f * s[4 * G4 + 3]); b[G4] = quad_sum(0.5f * s[4 * G4 + 3]); }
              const auto r1 = __builtin_amdgcn_permlane32_swap(__float_as_uint(b[1]), __float_as_uint(b[1]), false, false), r3 = __builtin_amdgcn_permlane32_swap(__float_as_uint(b[3]), __float_as_uint(b[3]), false, false);
              const float x1 = __uint_as_float(hi ? r1[0] : r1[1]), x3 = __uint_as_float(hi ? r3[0] : r3[1]);
              if (hh == 0) { LAS float* pr = pslc + tl * PSLC_LD + (ns >> 2) + 2 * hi;
                  pr[0] = a[0] + (hi ? x1 : carry); pr[1] = a[1] + b[0]; pr[4] = a[2] + (hi ? x3 : x1); pr[5] = a[3] + b[2]; }
              carry = x3; }
        }
        return false; });
    asm volatile("s_waitcnt lgkmcnt(0)" ::: "memory"); __builtin_amdgcn_wave_barrier();
    { const int cur = t0 >> 6;
      if (cur <= 15) { if (lane < 64) selm[lane] = ((lane & 7) == 0) ? ((2u << cur) - 1u) : 0u; }
      else {
#pragma unroll 1
        for (int k8 = 0; k8 < 8; ++k8) {
            float v[4];
#pragma unroll
            for (int k = 0; k < 4; ++k) { const int j = lane + 64 * k; v[k] = (j >= 1 && j <= cur - 2) ? pslc[k8 * PSLC_LD + j] : -1.f; }
            unsigned tb_ = 0u;
#pragma unroll 1
            for (int bit = 30; bit >= 0; --bit) { const float th = __uint_as_float(tb_ | (1u << bit));
                const int c = __builtin_popcountll(__ballot(v[0] >= th)) + __builtin_popcountll(__ballot(v[1] >= th)) + __builtin_popcountll(__ballot(v[2] >= th)) + __builtin_popcountll(__ballot(v[3] >= th));
                if (c >= 13) tb_ |= (1u << bit);
                if (c == 13) break; }
            const float T = __uint_as_float(tb_);
            unsigned long long sel[4]; int ngt = 0;
#pragma unroll
            for (int k = 0; k < 4; ++k) { sel[k] = __ballot(v[k] > T); ngt += __builtin_popcountll(sel[k]); }
            int need = 13 - ngt;
#pragma unroll
            for (int k = 0; k < 4; ++k) { unsigned long long eq = __ballot(v[k] == T); while (need > 0 && eq) { const unsigned long long low = eq & (0ull - eq); sel[k] |= low; eq ^= low; --need; } }
            unsigned mk[8];
#pragma unroll
            for (int k = 0; k < 4; ++k) { mk[2 * k] = (unsigned)sel[k]; mk[2 * k + 1] = (unsigned)(sel[k] >> 32); }
#pragma unroll
            for (int w = 0; w < 8; ++w) { if (w == 0) mk[w] |= 1u; if ((cur >> 5) == w) mk[w] |= 1u << (cur & 31); if (((cur - 1) >> 5) == w) mk[w] |= 1u << ((cur - 1) & 31); }
#pragma unroll
            for (int w = 0; w < 8; ++w) if (lane == w) selm[k8 * 8 + w] = mk[w];
        } } }
    asm volatile("s_waitcnt lgkmcnt(0)" ::: "memory"); __builtin_amdgcn_wave_barrier();
    const bf16_t* Sk = WSP(bf16_t, WS_SK) + (size_t)g * S * 64; const bf16_t* SvT = WSP(bf16_t, WS_SVT) + (size_t)g * 64 * S;
    const int n16 = lane & 15, kq = lane >> 4;
    LAS float* xch = pslc;
    float* XG = WSP(float, WS_U) + (size_t)t * 512 + g * 256 + hh * 64;
#pragma unroll
    for (int d0 = 0; d0 < 2; ++d0)
#pragma unroll
        for (int g4 = 0; g4 < 4; ++g4) *(f32x4*)(XG + 32 * d0 + 8 * g4 + 4 * hi) = (f32x4){g0 * oc[d0][4 * g4], g0 * oc[d0][4 * g4 + 1], g0 * oc[d0][4 * g4 + 2], g0 * oc[d0][4 * g4 + 3]};
    const bf16_t* Wk = WSP(bf16_t, WS_WK) + (size_t)g * S * 64; const bf16_t* WvT = WSP(bf16_t, WS_WVT) + (size_t)g * 64 * S;
    float mw = NEG_INF, lw = 0.f; f32x16 ow[2];
#pragma unroll
    for (int r = 0; r < 16; ++r) { ow[0][r] = 0.f; ow[1][r] = 0.f; }
    { const int lo = tg0 - 511 > 0 ? tg0 - 511 : 0; const int kvs = lo & ~63; const int nt_w = ((tg0 - kvs) >> 6) + 1;
      if (!(NSAP & 2)) stream_tiles<2, true, false>(F, Wk, WvT, nullptr, 0.f, kvs, 64, nt_w, [&](int kv0, const LAS unsigned char* st) __attribute__((always_inline)) -> bool {
#pragma unroll
        for (int sub = 0; sub < 2; ++sub) { const int ks0 = kv0 + 32 * sub;
            if (!((ks0 <= tmax) && (t0 - (ks0 + 31) < 512))) continue;
            __builtin_amdgcn_sched_barrier(0);
            bf16x8 kf[4]; lds_k(kf, st, sub, lane); f32x16 sw = qk32f(qf, kf);
            if (t0 - ks0 - 31 >= 128 && tmax - ks0 < 512) {
#pragma unroll
                for (int r = 0; r < 16; ++r) sw[r] += tbfar; }
            else t5_near(sw, tb, t, 1, ks0, hi, 512);
            float mu2; const float alpha = online_upd(max16(sw), mw, lw, mu2);
            ow[0] *= alpha; ow[1] *= alpha;
            exp16(sw, mu2, lw); bf16x8 vf[4]; lds_v(vf, st, sub, lane); pv32f(ow, sw, vf);
            __builtin_amdgcn_sched_barrier(0);
        }
        return false; }); }
    lw = xadd32(lw);
    { const float invw = lw > 0.f ? g2 / lw : 0.f;
      asm volatile("s_waitcnt vmcnt(0)" ::: "memory");
#pragma unroll
      for (int d0 = 0; d0 < 2; ++d0)
#pragma unroll
        for (int g4 = 0; g4 < 4; ++g4) { f32x4 v = *(const f32x4*)(XG + 32 * d0 + 8 * g4 + 4 * hi);
            v[0] += invw * ow[d0][4 * g4]; v[1] += invw * ow[d0][4 * g4 + 1]; v[2] += invw * ow[d0][4 * g4 + 2]; v[3] += invw * ow[d0][4 * g4 + 3];
            *(f32x4*)(XG + 32 * d0 + 8 * g4 + 4 * hi) = v; } }
#if BMS
    { unsigned* SG = WSP(unsigned, WS_SELMG);
      SG[((size_t)(t0 + (lane >> 3)) * 2 + g) * 8 + (lane & 7)] = selm[lane];
      if (F.tid < 256) { const int j = F.tid; int c = 0;
#pragma unroll
          for (int w8 = 0; w8 < 8; ++w8) { const LAS unsigned* sw = (const LAS unsigned*)(F.lds + AL_SELM + w8 * AW_SEL);
#pragma unroll
              for (int k8 = 0; k8 < 8; ++k8) c += (int)((sw[k8 * 8 + (j >> 5)] >> (j & 31)) & 1u); }
          WSP(int, WS_HISTB)[((size_t)g * 256 + (tg0 >> 6)) * 256 + j] = c; } }
}

#else
    {
        LAS unsigned* um = selm + 64;
        if (lane < 16) { const int qd = lane >> 3, w = lane & 7; um[lane] = selm[(4 * qd + 0) * 8 + w] | selm[(4 * qd + 1) * 8 + w] | selm[(4 * qd + 2) * 8 + w] | selm[(4 * qd + 3) * 8 + w]; }
        asm volatile("s_waitcnt lgkmcnt(0)" ::: "memory"); __builtin_amdgcn_wave_barrier();
        const int hq = n16 & 3;
        const LAS float* tb2 = tbg + hq * TB_LD; const float tbfar2 = tb2[128];
        bf16x8 q2[2][2]; float m2[2], l2[2], gs[2]; f32x4 o2[2][4];
#pragma unroll
        for (int qd = 0; qd < 2; ++qd) { const int ts = t0 + 4 * qd + (n16 >> 2);
            const bf16_t* Q2 = WSP(bf16_t, WS_QN) + (size_t)(g * 4 + hq) * S * 64 + (size_t)ts * 64;
            q2[qd][0] = *(const bf16x8*)(Q2 + 8 * kq); q2[qd][1] = *(const bf16x8*)(Q2 + 32 + 8 * kq);
            asm volatile("" : "+v"(q2[qd][0]), "+v"(q2[qd][1]));
            gs[qd] = WSP(float, WS_GN)[(size_t)ts * 24 + g * 12 + hq * 3 + 1];
            m2[qd] = NEG_INF; l2[qd] = 0.f;
#pragma unroll
            for (int dt = 0; dt < 4; ++dt) o2[qd][dt] = (f32x4){0.f, 0.f, 0.f, 0.f}; }
        const unsigned kfo = ST_K + (8 * (n16 >> 2) + (n16 & 3)) * KROW + 16 * kq, vfo = ST_V + n16 * VROW + 16 * kq;
        unsigned umw[2] = {0u, 0u}, ownw[2] = {0u, 0u};
        if (!(NSAP & 1)) stream_tiles<1, true, false, SEL_TB, AL_SEL2>(F, Sk, SvT, nullptr, 0.f, 0, 64 * SEL_TB, ((tg0 >> 6) + SEL_TB) / SEL_TB, [&](int kvt, const LAS unsigned char* stt) __attribute__((always_inline)) -> bool {
#pragma unroll 1
          for (int bb = 0; bb < SEL_TB; ++bb) { const int kv0 = kvt + 64 * bb; const LAS unsigned char* st = stt + bb * ST_B;
            const int j = kv0 >> 6;
            if (j > (tg0 >> 6)) break;
            if ((j & 31) == 0) {
#pragma unroll
                for (int qd = 0; qd < 2; ++qd) { umw[qd] = __builtin_amdgcn_readfirstlane(um[qd * 8 + (j >> 5)]); ownw[qd] = selm[(4 * qd + (n16 >> 2)) * 8 + (j >> 5)]; } }
#pragma unroll
            for (int qd = 0; qd < 2; ++qd) {
                __builtin_amdgcn_sched_barrier(0);
                if (!((umw[qd] >> (j & 31)) & 1u)) continue;
                const int tq = 4 * qd + (n16 >> 2), ts = t0 + tq, tsmin = t0 + 4 * qd;
                const bool selok = (ownw[qd] >> (j & 31)) & 1u;
                f32x4 sc[2][2];
#pragma unroll
                for (int gq = 0; gq < 2; ++gq)
#pragma unroll
                    for (int ab = 0; ab < 2; ++ab) { const LAS unsigned char* kp = st + kfo + (32 * gq + 4 * ab) * KROW;
                        f32x4 a = (f32x4){0.f, 0.f, 0.f, 0.f}; a = mfma16(*(const LAS bf16x8*)(kp), q2[qd][0], a); a = mfma16(*(const LAS bf16x8*)(kp + 64), q2[qd][1], a); sc[gq][ab] = a; }
                float mx = NEG_INF;
                if (tsmin - (kv0 + 63) >= 128) {
                    const float add = selok ? tbfar2 : NEG_INF;
#pragma unroll
                    for (int gq = 0; gq < 2; ++gq)
#pragma unroll
                        for (int ab = 0; ab < 2; ++ab)
#pragma unroll
                            for (int r = 0; r < 4; ++r) { const float v = sc[gq][ab][r] + add; sc[gq][ab][r] = v; mx = fmaxf(mx, v); }
                } else {
#pragma unroll
                    for (int gq = 0; gq < 2; ++gq)
#pragma unroll
                        for (int ab = 0; ab < 2; ++ab)
#pragma unroll
                            for (int r = 0; r < 4; ++r) { const int key = kv0 + 32 * gq + 8 * kq + 4 * ab + r; const int dist = ts - key;
                                const int idx = dist < 0 ? 0 : (dist < 128 ? dist : 128); const float bv = tb2[idx];
                                const float v = (selok && dist >= 0) ? sc[gq][ab][r] + bv : NEG_INF; sc[gq][ab][r] = v; mx = fmaxf(mx, v); }
                }
                mx = xmax16(mx); mx = xmax32(mx);
                const float mn = fmaxf(m2[qd], mx), mu2 = (mn == NEG_INF) ? 0.f : mn; const float alpha = fexp2(m2[qd] - mu2);
                float ps = 0.f;
#pragma unroll
                for (int gq = 0; gq < 2; ++gq)
#pragma unroll
                    for (int ab = 0; ab < 2; ++ab)
#pragma unroll
                        for (int r = 0; r < 4; ++r) { const float p = fexp2(sc[gq][ab][r] - mu2); sc[gq][ab][r] = p; ps += p; }
                l2[qd] = l2[qd] * alpha + ps; m2[qd] = mn;
#pragma unroll
                for (int dt = 0; dt < 4; ++dt) o2[qd][dt] *= alpha;
#pragma unroll
                for (int gq = 0; gq < 2; ++gq) {
                    u32x4 pw; pw.x = cvtpk(sc[gq][0][0], sc[gq][0][1]); pw.y = cvtpk(sc[gq][0][2], sc[gq][0][3]); pw.z = cvtpk(sc[gq][1][0], sc[gq][1][1]); pw.w = cvtpk(sc[gq][1][2], sc[gq][1][3]);
                    const bf16x8 pf = __builtin_bit_cast(bf16x8, pw);
#pragma unroll
                    for (int dt = 0; dt < 4; ++dt) o2[qd][dt] = mfma16(*(const LAS bf16x8*)(st + vfo + gq * 64 * VROW + 16 * dt * VROW), pf, o2[qd][dt]);
                }
            }
          }
            return false; });
#pragma unroll
        for (int qd = 0; qd < 2; ++qd) {
            float lt = xadd16(l2[qd]); lt = xadd32(lt);
            const float inv2 = lt > 0.f ? gs[qd] / lt : 0.f;
#pragma unroll
            for (int dt = 0; dt < 4; ++dt)
#pragma unroll
                for (int r = 0; r < 4; ++r) xch[(16 * qd + n16) * XLD + 16 * dt + 4 * kq + r] = inv2 * o2[qd][dt][r];
        }
        asm volatile("s_waitcnt lgkmcnt(0)" ::: "memory"); __builtin_amdgcn_wave_barrier();
    }
    { bf16_t* O = WSP(bf16_t, WS_O) + (size_t)t * 1024 + g * 256 + hh * 64;
#pragma unroll
      for (int d0 = 0; d0 < 2; ++d0)
#pragma unroll
        for (int g4 = 0; g4 < 4; ++g4) { const f32x4 a = *(const f32x4*)(XG + 32 * d0 + 8 * g4 + 4 * hi); float v[4];
#pragma unroll
            for (int q = 0; q < 4; ++q) v[q] = a[q] + xch[i * XLD + 32 * d0 + 8 * g4 + 4 * hi + q];
            u32x2 wv; wv.x = cvtpk(v[0], v[1]); wv.y = cvtpk(v[2], v[3]); *(u32x2*)(O + 32 * d0 + 8 * g4 + 4 * hi) = wv; } }
    asm volatile("s_waitcnt lgkmcnt(0)" ::: "memory"); __builtin_amdgcn_wave_barrier();
}

#endif
constexpr int NT_FOX = 8 * 64, NT_NSA = 2 * 256, NT_ATT = NT_FOX + NT_NSA;
DI void phase_attn(Frame& F, const Params& P, int rep) {
    LAS float* tball = (LAS float*)(F.lds + AL_TB);
    for (int q = F.tid; q < 2 * 4 * 129; q += NTHREADS) { const int dist = q % 129, gh = q / 129;
        int bucket; if (dist < 16) bucket = dist; else { const float rr = logf((float)dist / 16.f) / 2.0794415416798357f * 16.f; const int big = 16 + (int)rr; bucket = big < 31 ? big : 31; }
        tball[gh * TB_LD + dist] = P.in[6][bucket * 8 + gh] * LOG2E; }
    LAS float* pslc = (LAS float*)(F.lds + AL_PSLC + F.wave * AW_PSLC); LAS unsigned* selm = (LAS unsigned*)(F.lds + AL_SELM + F.wave * AW_SEL);
    volatile LAS int* tslot = (volatile LAS int*)(F.lds + AL_FLAG + 64);
    bool first = true;
    for (;;) {
        __syncthreads();
        if (F.tid == 0) *tslot = first ? F.bid : F.G + (int)atomicAdd(F.ctl + CW_QATT + 64 * rep, 1u);
        first = false;
        __syncthreads();
        const int task = __builtin_amdgcn_readfirstlane(*tslot);
        if (task >= (BMS ? NT_NSA : NT_ATT)) break;
        if (task < NT_NSA) { const int g = task & 1, tt = 255 - (task >> 1); nsa_task(F, g, tt * 64, pslc, selm, tball + g * 4 * TB_LD); }
        else { const int q = task - NT_NSA; fox_task(F, 7 - (q >> 6), 63 - (q & 63)); }
    }
}

#if BMS
DI void phase_bms_sort(Frame& F, const Params& P) {
    LAS unsigned* masks = (LAS unsigned*)F.lds;
    LAS int* pw = (LAS int*)(F.lds + 2048);
    LAS int* wsum = (LAS int*)(F.lds + 4096);
    const int* hist = WSP(int, WS_HISTB);
    for (int item = F.bid; item < 512; item += F.G) { const int g = item >> 8, T = item & 255;
        __syncthreads();
        masks[F.tid] = WSP(unsigned, WS_SELMG)[((size_t)(T * 64 + (F.tid >> 3)) * 2 + g) * 8 + (F.tid & 7)];
        int tot = 0, off = 0;
        { const int j = F.tid & 255, b0 = (F.tid >> 8) * 128; const int* hc = hist + (size_t)g * 256 * 256 + (size_t)b0 * 256 + j;
#pragma unroll 32
          for (int b = 0; b < 128; ++b) { const int hv = hc[b * 256]; tot += hv; off += (b0 + b < T) ? hv : 0; }
          LAS int* psum = (LAS int*)(F.lds + 8192);
          if (F.tid >= 256) { psum[j] = tot; psum[256 + j] = off; tot = 0; off = 0; }
          __syncthreads();
          if (F.tid < 256) { tot += psum[j]; off += psum[256 + j]; } }
        const int nu = (tot + 63) >> 6; int inc = nu;
#pragma unroll
        for (int o = 1; o < 64; o <<= 1) { const int up = __shfl_up(inc, o); if (F.lane >= o) inc += up; }
        if (F.lane == 63 && F.wave < 4) wsum[F.wave] = inc;
        __syncthreads();
        { const int tok = F.tid >> 3, w = F.tid & 7; int c = 0;
#pragma unroll
          for (int q = 0; q < 8; ++q) c += (q < w) ? __builtin_popcount(masks[tok * 8 + q]) : 0;
          pw[F.tid] = c; }
        const int w0 = wsum[0], w1 = wsum[1], w2 = wsum[2], w3 = wsum[3];
        const int ub_ = inc - nu + (F.wave > 0 ? w0 : 0) + (F.wave > 1 ? w1 : 0) + (F.wave > 2 ? w2 : 0);
        __syncthreads();
        if (F.tid < 256) { const int j = F.tid;
            if (T == 0) { int* ut = WSP(int, WS_UT) + g * (BMS_MAXU + 8); if (j == 0) ut[0] = w0 + w1 + w2 + w3; for (int c = 0; c < nu; ++c) ut[1 + ub_ + c] = j | (c << 16); }
            int* tk = WSP(int, WS_TOKL) + (size_t)g * BMS_MAXU * 64 + (size_t)ub_ * 64 + off; int run = 0;
            const unsigned bitm = 1u << (j & 31), lowm = bitm - 1u;
            for (int tok = 0; tok < 64; ++tok) { const unsigned wv = masks[tok * 8 + (j >> 5)];
                if (wv & bitm) { const int slot = pw[tok * 8 + (j >> 5)] + __builtin_popcount(wv & lowm); tk[run] = (T * 64 + tok) | (slot << 16); ++run; } } }
    }
    __syncthreads();
}

DI void lds_v_T(bf16x8 (&vf)[4], const LAS unsigned char* st, int sub, int lane) {
    const LAS unsigned char* p = st + ST_V + sub * 64 * VROW + 2 * (lane & 31) * VROW + 16 * (lane >> 5);
#pragma unroll
    for (int d0 = 0; d0 < 2; ++d0)
#pragma unroll
        for (int s2 = 0; s2 < 2; ++s2) vf[d0 * 2 + s2] = *(const LAS bf16x8*)(p + d0 * VROW + 32 * s2);
}
DI void pv32f_T(f32x16 (&o)[2], const f32x16& p, const bf16x8 (&vf)[4]) {
    bf16x8 pf[2];
#pragma unroll
    for (int s2 = 0; s2 < 2; ++s2) { u32x4 w; w.x = cvtpk(p[8 * s2 + 0], p[8 * s2 + 1]); w.y = cvtpk(p[8 * s2 + 2], p[8 * s2 + 3]); w.z = cvtpk(p[8 * s2 + 4], p[8 * s2 + 5]); w.w = cvtpk(p[8 * s2 + 6], p[8 * s2 + 7]); pf[s2] = __builtin_bit_cast(bf16x8, w); }
#pragma unroll
    for (int d0 = 0; d0 < 2; ++d0)
#pragma unroll
        for (int s2 = 0; s2 < 2; ++s2) o[d0] = mfma32(pf[s2], vf[d0 * 2 + s2], o[d0]);
}
constexpr int BMS_WGU = 36;
constexpr int BL_CODE = 0, BL_ENT = 256;
static_assert(BL_ENT + BMS_WGU * 256 <= AL_STAGE && 2 * BMS_MAXU <= 256 * (BMS_WGU - 2), "block-major unit lists");
DI void phase_bms_attn(Frame& F, const Params& P) {
    const int lane = F.lane, i = lane & 31, hi = lane >> 5, tl = i >> 2, hh = i & 3;
    LAS float* tball = (LAS float*)(F.lds + AL_TB);
    LAS int* lcode = (LAS int*)(F.lds + BL_CODE); LAS int* lent = (LAS int*)(F.lds + BL_ENT);
    __syncthreads();
    for (int q = F.tid; q < 2 * 4 * 129; q += NTHREADS) { const int dist = q % 129, gh = q / 129;
        int bucket; if (dist < 16) bucket = dist; else { const float rr = logf((float)dist / 16.f) / 2.0794415416798357f * 16.f; const int big = 16 + (int)rr; bucket = big < 31 ? big : 31; }
        tball[gh * TB_LD + dist] = P.in[6][bucket * 8 + gh] * LOG2E; }
    const int* ut = WSP(int, WS_UT); const int U0 = ut[0], U1 = ut[BMS_MAXU + 8], UT_ = U0 + U1;
    const int u_lo = (int)(((long)F.bid * UT_) / F.G), u_hi = (int)(((long)(F.bid + 1) * UT_) / F.G), nu = u_hi - u_lo;
    for (int q = F.tid; q < nu * 64; q += NTHREADS) { const int u = u_lo + (q >> 6), g = u >= U0, ug = g ? u - U0 : u; lent[q] = WSP(int, WS_TOKL)[(size_t)g * BMS_MAXU * 64 + (size_t)ug * 64 + (q & 63)]; }
    for (int q = F.tid; q < nu; q += NTHREADS) { const int u = u_lo + q, g = u >= U0, ug = g ? u - U0 : u; lcode[q] = g * 256 + (ut[g * (BMS_MAXU + 8) + 1 + ug] & 0xffff); }
    __syncthreads();
    LAS unsigned char* st = F.lds + AL_STAGE;
    const int tid = F.tid, krow = tid >> 3, kc = tid & 7, vsub = tid >> 8, vd = (tid & 255) >> 2, vc = tid & 3;
    auto ent = [&](int k) -> int { return lent[k * 64 + 8 * F.wave + tl]; };
    auto loadq = [&](int k, bf16x8 (&q)[4]) { const int e = ent(k), g = lcode[k] >> 8; const int t = e < 0 ? 0 : (e & 0xffff);
        const bf16_t* Q = WSP(bf16_t, WS_QN) + (size_t)(g * 4 + hh) * S * 64 + (size_t)t * 64 + 8 * hi;
#pragma unroll
        for (int ks = 0; ks < 4; ++ks) q[ks] = *(const bf16x8*)(Q + 16 * ks); };
    auto loadkv = [&](int gj, u32x4& rk, u32x4& rv) { const int g = gj >> 8, j = gj & 255;
        rk = *(const u32x4*)(WSP(bf16_t, WS_SK) + (size_t)g * S * 64 + (size_t)(64 * j + krow) * 64 + kc * 8); rv = *(const u32x4*)(WSP(bf16_t, WS_SVT) + (size_t)g * 64 * S + (size_t)(2 * j) * 2048 + tid * 8); };
    bf16x8 qr[3][4];
    if (nu > 0) loadq(0, qr[0]);
    if (nu > 1) loadq(1, qr[1]);
    int prev = -1; bool havepf = false; u32x4 rk, rv;
    for (int k0 = 0; k0 < nu; k0 += 3) {
#pragma unroll
      for (int d = 0; d < 3; ++d) { const int k = k0 + d; if (k >= nu) break;
        const int gj = __builtin_amdgcn_readfirstlane(lcode[k]); const int g = gj >> 8, j = gj & 255;
        if (k + 2 < nu) loadq(k + 2, qr[(d + 2) % 3]);
        if (gj != prev) {
            if (!havepf) loadkv(gj, rk, rv);
            __syncthreads();
            *(LAS u32x4*)(st + krow * KROW + kc * 16) = rk; *(LAS u32x4*)(st + ST_V + vsub * 64 * VROW + vd * VROW + vc * 16) = rv;
            __syncthreads(); prev = gj; havepf = false; }
        if (k + 1 < nu) { const int nx = __builtin_amdgcn_readfirstlane(lcode[k + 1]); if (nx != gj) { loadkv(nx, rk, rv); havepf = true; } }
        const int e_cur = ent(k);
        const bool valid = e_cur >= 0; const int t = valid ? (e_cur & 0xffff) : 0, slot = valid ? (e_cur >> 16) : 0;
        const LAS float* tb = tball + (g * 4 + hh) * TB_LD;
        int tmin = valid ? t : 0x7fffffff; tmin = wave_min_ui(tmin);
        const bool far = (tmin - (64 * j + 63) >= 128);
        f32x16 sv[2];
#pragma unroll
        for (int sub = 0; sub < 2; ++sub) { bf16x8 kf[4]; lds_k(kf, st, sub, lane); sv[sub] = qk32f(qr[d], kf);
            if (!far) t5_near(sv[sub], tb, t, 1, 64 * j + 32 * sub, hi, 1 << 30); }
        const float mx = xmax32(fmaxf(max16(sv[0]), max16(sv[1])));
        const float mu = (mx == NEG_INF) ? 0.f : mx;
        float l = 0.f; f32x16 o[2];
#pragma unroll
        for (int r = 0; r < 16; ++r) { o[0][r] = 0.f; o[1][r] = 0.f; }
#pragma unroll
        for (int sub = 0; sub < 2; ++sub) { exp16(sv[sub], mu, l); bf16x8 vf[4]; lds_v_T(vf, st, sub, lane); pv32f_T(o, sv[sub], vf); }
        l = xadd32(l);
        if (valid && hi == 0) *(f32x2*)(WSP(float, WS_PML) + ((((size_t)t * 2 + g) * 16 + slot) * 4 + hh) * 2) = (f32x2){far ? mx + tb[128] : mx, l};
        bf16_t* pbase = (g ? WSP(bf16_t, WS_X1) : (bf16_t*)P.out) + 2 * i;
#pragma unroll
        for (int rg = 0; rg < 4; ++rg) { const int e2 = lent[k * 64 + 8 * F.wave + 2 * rg + hi];
            if (e2 >= 0) { bf16_t* po = pbase + ((size_t)(e2 & 0xffff) * 16 + (e2 >> 16)) * 256;
#pragma unroll
                for (int h2 = 0; h2 < 4; ++h2) __builtin_nontemporal_store(cvtpk(o[0][4 * rg + h2], o[1][4 * rg + h2]), (unsigned*)(po + h2 * 64)); } }
      }
    }
    { volatile LAS int* tslot = (volatile LAS int*)(F.lds + AL_FLAG + 64);
      for (;;) {
        __syncthreads();
        if (F.tid == 0) *tslot = (int)atomicAdd(F.ctl + CW_QATT + 64, 1u);
        __syncthreads();
        const int q = __builtin_amdgcn_readfirstlane(*tslot);
        if (q >= NT_FOX) break;
        fox_task(F, 7 - (q >> 6), 63 - (q & 63));
      } }
    __syncthreads();
}

DI void phase_bms_combine(Frame& F, const Params& P) {
    const int lane = F.lane, gw = F.bid * NWAVES + F.wave, NGW = F.G * NWAVES;
    const int slotL = lane >> 2, hhL = lane & 3;
    const int sub = lane & 7, hhO = (lane >> 3) & 3, par = lane >> 5;
    struct Item { u32x4 pv[8]; f32x2 ml; float gate; f32x4 x0, x1; };
    auto load = [&](int it, Item& I) __attribute__((always_inline)) { const int t = it >> 1, g = it & 1; const int cur = t >> 6, nsel = cur < 15 ? cur + 1 : 16;
        const bf16_t* po = (g ? WSP(bf16_t, WS_X1) : (const bf16_t*)P.out) + (size_t)t * 4096 + hhO * 64 + 8 * sub;
#pragma unroll
        for (int k = 0; k < 8; ++k) { const int slot = 2 * k + par; I.pv[k] = __builtin_nontemporal_load((const u32x4*)(po + (slot < nsel ? slot : 0) * 256)); }
        I.ml = *(const f32x2*)(WSP(float, WS_PML) + ((size_t)it * 64 + lane) * 2);
        I.gate = WSP(float, WS_GN)[(size_t)t * 24 + g * 12 + hhL * 3 + 1];
        const float* XG = WSP(float, WS_U) + (size_t)t * 512 + g * 256 + hhO * 64 + 8 * sub;
        I.x0 = (f32x4){0.f, 0.f, 0.f, 0.f}; I.x1 = I.x0; if (par == 0) { I.x0 = *(const f32x4*)XG; I.x1 = *(const f32x4*)(XG + 4); } };
    auto compute = [&](int it, const Item& I) __attribute__((always_inline)) { const int t = it >> 1, g = it & 1; const int cur = t >> 6, nsel = cur < 15 ? cur + 1 : 16;
        const bool ok = slotL < nsel;
        const float m = ok ? I.ml[0] : NEG_INF;
        float M = m; M = fmaxf(M, dppf<0x124>(M)); M = fmaxf(M, dppf<0x128>(M)); M = xmax16(M); M = xmax32(M);
        const float wgt = (m == NEG_INF) ? 0.f : fexp2(m - M);
        float den = ok ? wgt * I.ml[1] : 0.f; den += dppf<0x124>(den); den += dppf<0x128>(den); den = xadd16(den); den = xadd32(den);
        const float sc = (den > 0.f) ? wgt * I.gate / den : 0.f;
        float acc[8];
#pragma unroll
        for (int q = 0; q < 8; ++q) acc[q] = 0.f;
#pragma unroll
        for (int k = 0; k < 8; ++k) { const int slot = 2 * k + par;
            const float w = __int_as_float(__builtin_amdgcn_ds_bpermute(4 * (slot * 4 + hhO), __float_as_int(sc)));
#pragma unroll
            for (int q = 0; q < 4; ++q) { acc[2 * q] += w * __builtin_bit_cast(float, I.pv[k][q] << 16); acc[2 * q + 1] += w * __builtin_bit_cast(float, I.pv[k][q] & 0xffff0000u); } }
#pragma unroll
        for (int q = 0; q < 8; ++q) acc[q] = xadd32(acc[q]);
        if (par == 0) { u32x4 wv; wv.x = cvtpk(I.x0[0] + acc[0], I.x0[1] + acc[1]); wv.y = cvtpk(I.x0[2] + acc[2], I.x0[3] + acc[3]); wv.z = cvtpk(I.x1[0] + acc[4], I.x1[1] + acc[5]); wv.w = cvtpk(I.x1[2] + acc[6], I.x1[3] + acc[7]);
            *(u32x4*)(WSP(bf16_t, WS_O) + (size_t)t * 1024 + g * 256 + hhO * 64 + 8 * sub) = wv; } };
    for (int it = gw; it < 2 * S; it += 4 * NGW) { Item A, B, C, D2; const bool h1 = it + NGW < 2 * S, h2 = it + 2 * NGW < 2 * S, h3 = it + 3 * NGW < 2 * S;
        load(it, A); if (h1) load(it + NGW, B); if (h2) load(it + 2 * NGW, C); if (h3) load(it + 3 * NGW, D2);
        compute(it, A); if (h1) compute(it + NGW, B); if (h2) compute(it + 2 * NGW, C); if (h3) compute(it + 3 * NGW, D2); }
}
#endif

DI void phase_lnmid_route(Frame& F, const Params& P, int rep) {
    const int lane = F.lane, w = F.wave;
    const float* XI = P.in[0]; const bf16_t* YB = WSP(bf16_t, WS_X1); bf16_t* X1 = WSP(bf16_t, WS_X1); bf16_t* U2 = WSP(bf16_t, WS_U); bf16_t* U2L = WSP(bf16_t, WS_U2L); const float* mod = WSP(float, WS_MOD);
    const float* ln1g = P.in[14]; const float* ln1b = P.in[15]; const float* brg = P.in[17]; const float* bre = P.in[19];
    int* toke = WSP(int, WS_TOKE); int* tokp = WSP(int, WS_TOKP); float* tokw = WSP(float, WS_TOKW);
    const bf16_t* WTh = WSP(bf16_t, WS_WRT); const bf16_t* WTl = WTh + 80 * 2048;
    LAS float* part = (LAS float*)F.lds;
    LAS unsigned* lhist = (LAS unsigned*)(F.lds + 4 * 64 * 84 * 4);
    constexpr int PLD = 84;
    for (int blk = F.bid; blk < S / 64; blk += F.G) {
        const int base = blk * 64;
        if (F.tid < 64) lhist[F.tid] = 0u;
        { f32x4 vn[8];
          u32x2 yn[8];
          { const f32x4* rr = (const f32x4*)(XI + (size_t)(base + 8 * w) * D) + lane; const u32x2* yr = (const u32x2*)(YB + (size_t)(base + 8 * w) * D) + lane;
#pragma unroll
            for (int j = 0; j < 8; ++j) { vn[j] = rr[64 * j]; yn[j] = yr[64 * j]; } }
          for (int i8 = 0; i8 < (rep ? 0 : 8); ++i8) { const int m = base + 8 * w + i8;
            u32x2* xr = (u32x2*)(X1 + (size_t)m * D) + lane;
            f32x4 v[8]; float s = 0.f;
#pragma unroll
            for (int j = 0; j < 8; ++j) { const u32x2 yw = yn[j];
                v[j][0] = vn[j][0] * ALPHA + __builtin_bit_cast(float, yw.x << 16); v[j][1] = vn[j][1] * ALPHA + __builtin_bit_cast(float, yw.x & 0xffff0000u);
                v[j][2] = vn[j][2] * ALPHA + __builtin_bit_cast(float, yw.y << 16); v[j][3] = vn[j][3] * ALPHA + __builtin_bit_cast(float, yw.y & 0xffff0000u);
                s += (v[j][0] + v[j][1]) + (v[j][2] + v[j][3]); }
            if (i8 < 7) { const f32x4* rr = (const f32x4*)(XI + (size_t)(m + 1) * D) + lane; const u32x2* yr = (const u32x2*)(YB + (size_t)(m + 1) * D) + lane;
#pragma unroll
                for (int j = 0; j < 8; ++j) { vn[j] = rr[64 * j]; yn[j] = yr[64 * j]; } }
            float mean = wave_sum(s) * (1.f / D), s2 = 0.f;
#pragma unroll
            for (int j = 0; j < 8; ++j) { v[j] = v[j] - mean; s2 += (v[j][0] * v[j][0] + v[j][1] * v[j][1]) + (v[j][2] * v[j][2] + v[j][3] * v[j][3]); }
            float rstd = 1.f / sqrtf(wave_sum(s2) * (1.f / D) + LN_EPS);
            s = 0.f;
#pragma unroll
            for (int j = 0; j < 8; ++j) { const int col = 4 * lane + 256 * j; v[j] = v[j] * rstd * *(const f32x4*)(ln1g + col) + *(const f32x4*)(ln1b + col); { u32x2 xw; xw.x = cvtpk(v[j][0], v[j][1]); xw.y = cvtpk(v[j][2], v[j][3]); xr[64 * j] = xw; } s += (v[j][0] + v[j][1]) + (v[j][2] + v[j][3]); }
            mean = wave_sum(s) * (1.f / D); s2 = 0.f;
#pragma unroll
            for (int j = 0; j < 8; ++j) { v[j] = v[j] - mean; s2 += (v[j][0] * v[j][0] + v[j][1] * v[j][1]) + (v[j][2] * v[j][2] + v[j][3] * v[j][3]); }
            rstd = 1.f / sqrtf(wave_sum(s2) * (1.f / D) + LN_EPS);
            u32x2* oh = (u32x2*)(U2 + (size_t)m * D) + lane; u32x2* ol = (u32x2*)(U2L + (size_t)m * D) + lane;
#pragma unroll
            for (int j = 0; j < 8; ++j) { const int col = 4 * lane + 256 * j; const f32x4 y = v[j] * rstd * (*(const f32x4*)(mod + 4 * D + col) + 1.0f) + *(const f32x4*)(mod + 3 * D + col);
                u32x2 wh; wh.x = cvtpk(y[0], y[1]); wh.y = cvtpk(y[2], y[3]); oh[64 * j] = wh;
                const float r0 = y[0] - __builtin_bit_cast(float, wh.x << 16), r1 = y[1] - __builtin_bit_cast(float, wh.x & 0xffff0000u), r2 = y[2] - __builtin_bit_cast(float, wh.y << 16), r3 = y[3] - __builtin_bit_cast(float, wh.y & 0xffff0000u);
                u32x2 wl; wl.x = cvtpk(r0, r1); wl.y = cvtpk(r2, r3); ol[64 * j] = wl; }
          } }
        asm volatile("s_waitcnt vmcnt(0)" ::: "memory");
        __syncthreads();
        { const int n16 = lane & 15, kq = lane >> 4;
          const bf16_t* uh = U2 + (size_t)(base + n16) * D + w * 256 + 8 * kq; const bf16_t* ul = U2L + (size_t)(base + n16) * D + w * 256 + 8 * kq;
          const bf16_t* wh0 = WTh + (size_t)n16 * 2048 + w * 256 + 8 * kq; const bf16_t* wl0 = WTl + (size_t)n16 * 2048 + w * 256 + 8 * kq;
          f32x4 acc[4][5];
#pragma unroll
          for (int rt = 0; rt < 4; ++rt)
#pragma unroll
              for (int nt = 0; nt < 5; ++nt) acc[rt][nt] = (f32x4){0.f, 0.f, 0.f, 0.f};
#pragma unroll 1
          for (int ks = 0; ks < 8; ++ks) {
              bf16x8 a_h[4], a_l[4], b_h[5], b_l[5];
#pragma unroll
              for (int rt = 0; rt < 4; ++rt) { a_h[rt] = *(const bf16x8*)(uh + (size_t)rt * 16 * D + 32 * ks); a_l[rt] = *(const bf16x8*)(ul + (size_t)rt * 16 * D + 32 * ks); }
#pragma unroll
              for (int nt = 0; nt < 5; ++nt) { b_h[nt] = *(const bf16x8*)(wh0 + (size_t)nt * 16 * 2048 + 32 * ks); b_l[nt] = *(const bf16x8*)(wl0 + (size_t)nt * 16 * 2048 + 32 * ks); }
#pragma unroll
              for (int rt = 0; rt < 4; ++rt)
#pragma unroll
                  for (int nt = 0; nt < 5; ++nt) { acc[rt][nt] = mfma16(b_h[nt], a_h[rt], acc[rt][nt]); acc[rt][nt] = mfma16(b_l[nt], a_h[rt], acc[rt][nt]); acc[rt][nt] = mfma16(b_h[nt], a_l[rt], acc[rt][nt]); }
          }
          LAS float* slot = part + (w & 3) * 64 * PLD;
          if (w < 4) {
#pragma unroll
              for (int rt = 0; rt < 4; ++rt)
#pragma unroll
                  for (int nt = 0; nt < 5; ++nt)
#pragma unroll
                      for (int r = 0; r < 4; ++r) slot[(16 * rt + n16) * PLD + 16 * nt + 4 * kq + r] = acc[rt][nt][r]; }
          __syncthreads();
          if (w >= 4) {
#pragma unroll
              for (int rt = 0; rt < 4; ++rt)
#pragma unroll
                  for (int nt = 0; nt < 5; ++nt)
#pragma unroll
                      for (int r = 0; r < 4; ++r) slot[(16 * rt + n16) * PLD + 16 * nt + 4 * kq + r] += acc[rt][nt][r]; }
        }
        __syncthreads();
        if (F.tid < 64) { const int row = F.tid, m = base + row; const LAS float* p0 = part + row * PLD;
            float lg[8]; int grp = 0; float gmax = NEG_INF;
#pragma unroll
            for (int e = 0; e < 8; ++e) { lg[e] = ((p0[e] + p0[64 * PLD + e]) + (p0[2 * 64 * PLD + e] + p0[3 * 64 * PLD + e])) + brg[e]; if (lg[e] > gmax) { gmax = lg[e]; grp = e; } }
            float gden = 0.f;
#pragma unroll
            for (int e = 0; e < 8; ++e) gden += __expf(lg[e] - gmax);
            const float pgrp = 1.f / gden;
            int e0 = 0; float m0 = NEG_INF, le[8];
#pragma unroll
            for (int e = 0; e < 8; ++e) { { const int c = 8 + grp * 8 + e; le[e] = ((p0[c] + p0[64 * PLD + c]) + (p0[2 * 64 * PLD + c] + p0[3 * 64 * PLD + c])) + bre[grp * 8 + e]; } if (le[e] > m0) { m0 = le[e]; e0 = e; } }
            int e1 = 0; float m1 = NEG_INF;
#pragma unroll
            for (int e = 0; e < 8; ++e) if (e != e0 && le[e] > m1) { m1 = le[e]; e1 = e; }
            const float r1 = __expf(m1 - m0); const float w0 = pgrp / (1.f + r1), w1 = pgrp * r1 / (1.f + r1);
            const int ea = grp * 8 + e0, eb = grp * 8 + e1;
            const int pa = (int)__hip_atomic_fetch_add(lhist + ea, 1u, __ATOMIC_RELAXED, __HIP_MEMORY_SCOPE_WORKGROUP), pb = (int)__hip_atomic_fetch_add(lhist + eb, 1u, __ATOMIC_RELAXED, __HIP_MEMORY_SCOPE_WORKGROUP);
            toke[2 * m] = ea; toke[2 * m + 1] = eb; tokp[2 * m] = pa; tokp[2 * m + 1] = pb; tokw[2 * m] = w0; tokw[2 * m + 1] = w1;
        }
        __syncthreads();
        if (F.tid < 64) WSP(int, WS_HIST)[blk * 64 + F.tid] = (int)lhist[F.tid];
        __syncthreads();
    }
}

DI void phase_scatter(Frame& F, const Params& P) {
    LAS int* base = (LAS int*)F.lds;
    LAS int* tot = base + 64; LAS int* off = base + 128;
    LAS int* ptot = base + 192; LAS int* poff = base + 192 + 512;
    const int* hist = WSP(int, WS_HIST);
    const int* toke = WSP(int, WS_TOKE); const int* tokp = WSP(int, WS_TOKP); const float* tokw = WSP(float, WS_TOKW);
    int* rt = WSP(int, WS_ROWTOK); int* rd = WSP(int, WS_ROWDST); float* rw = WSP(float, WS_ROWW);
    for (int blk = F.bid; blk < S / 64; blk += F.G) {
        { const int e = F.tid & 63, part = F.tid >> 6; int t = 0, o = 0;
#pragma unroll 8
          for (int b = part * 32; b < part * 32 + 32; ++b) { const int hv = hist[b * 64 + e]; t += hv; o += (b < blk) ? hv : 0; }
          ptot[part * 64 + e] = t; poff[part * 64 + e] = o; }
        __syncthreads();
        if (F.tid < 64) { int t = 0, o = 0;
#pragma unroll
            for (int p = 0; p < 8; ++p) { t += ptot[p * 64 + F.tid]; o += poff[p * 64 + F.tid]; }
            tot[F.tid] = t; off[F.tid] = o; }
        __syncthreads();
        if (F.tid == 0) { int run = 0; int* pane = WSP(int, WS_PANE); int np = 0;
            for (int e = 0; e < NEXP; ++e) { const int c = tot[e]; base[e] = run; const int npan = (c + 255) >> 8;
                if (blk == 0) for (int q = 0; q < npan; ++q) pane[1 + np + q] = e;
                np += npan; run += npan * 256; }
            if (blk == 0) pane[0] = np; }
        __syncthreads();
        if (F.tid < 128) { const int i = blk * 128 + F.tid; const int e = toke[i]; const int row = base[e] + off[e] + tokp[i]; rt[row] = i >> 1; rd[row] = i; rw[row] = tokw[i]; }
        __syncthreads();
    }
}

DI void phase_final(Frame& F, const Params& P) {
    const int lane = F.lane, gw = F.bid * NWAVES + F.wave, NGW = F.G * NWAVES;
    const bf16_t* X1 = WSP(bf16_t, WS_X1); const bf16_t* Y2 = WSP(bf16_t, WS_Y2); const float* mod = WSP(float, WS_MOD);
    const float* g2p = mod + 5 * D; const float* lg = P.in[23]; const float* lb = P.in[24];
    for (int m = gw; m < S; m += NGW) {
        const u32x2* xr = (const u32x2*)(X1 + (size_t)m * D) + lane;
        const u32x2* ya = (const u32x2*)(Y2 + (size_t)(2 * m) * D) + lane; const u32x2* yb = (const u32x2*)(Y2 + (size_t)(2 * m + 1) * D) + lane;
        f32x4 v[8]; float s = 0.f;
#pragma unroll
        for (int j = 0; j < 8; ++j) { const int col = 4 * lane + 256 * j; const u32x2 a = ya[64 * j], b = yb[64 * j];
            f32x4 y; y[0] = __builtin_bit_cast(float, a.x << 16) + __builtin_bit_cast(float, b.x << 16); y[1] = __builtin_bit_cast(float, a.x & 0xffff0000u) + __builtin_bit_cast(float, b.x & 0xffff0000u);
            y[2] = __builtin_bit_cast(float, a.y << 16) + __builtin_bit_cast(float, b.y << 16); y[3] = __builtin_bit_cast(float, a.y & 0xffff0000u) + __builtin_bit_cast(float, b.y & 0xffff0000u);
            const u32x2 xw = xr[64 * j]; const f32x4 x1v = (f32x4){__builtin_bit_cast(float, xw.x << 16), __builtin_bit_cast(float, xw.x & 0xffff0000u), __builtin_bit_cast(float, xw.y << 16), __builtin_bit_cast(float, xw.y & 0xffff0000u)};
            v[j] = x1v * ALPHA + (*(const f32x4*)(g2p + col) + 1.0f) * y; s += (v[j][0] + v[j][1]) + (v[j][2] + v[j][3]); }
        const float mean = wave_sum(s) * (1.f / D); float s2 = 0.f;
#pragma unroll
        for (int j = 0; j < 8; ++j) { v[j] = v[j] - mean; s2 += (v[j][0] * v[j][0] + v[j][1] * v[j][1]) + (v[j][2] * v[j][2] + v[j][3] * v[j][3]); }
        const float rstd = 1.f / sqrtf(wave_sum(s2) * (1.f / D) + LN_EPS);
        f32x4* o = (f32x4*)(P.out + (size_t)m * D) + lane;
#pragma unroll
        for (int j = 0; j < 8; ++j) { const int col = 4 * lane + 256 * j; o[64 * j] = v[j] * rstd * *(const f32x4*)(lg + col) + *(const f32x4*)(lb + col); }
    }
}

constexpr int NPHASE = 14;
__global__ void __launch_bounds__(NTHREADS, 2) fwd_kernel(Params P) {
    extern __shared__ __attribute__((aligned(16))) unsigned char lds_raw[];
    Frame F;
    F.lds = (LAS unsigned char*)lds_raw; F.ws = P.ws; F.ctl = (unsigned*)(P.ws + WS_CTL);
    F.tid = threadIdx.x; F.lane = F.tid & 63; F.wave = __builtin_amdgcn_readfirstlane(F.tid >> 6); F.G = gridDim.x; F.bid = blockIdx.x;
    volatile LAS unsigned* misc = (volatile LAS unsigned*)(F.lds + LDS_MISC);
    if (F.tid < 16) misc[F.tid] = 0u;
    __syncthreads();
    const int lo = P.ph_lo, hi = P.ph_hi;
    XcdBarrier bar; bar.bar = F.ctl + CW_BAR; bar.x = 0; bar.st = nullptr;
    if (hi - lo > 1) bar = xcd_barrier_post(F.ctl + CW_BAR, misc + 8);
#ifndef PHMASK
#define PHMASK 0xffff
#endif
#define IN(k) (((PHMASK >> (k)) & 1) && lo <= (k) && (k) < hi)
#define RUN(k, ...) do { __VA_ARGS__; if (REPS(k) > 1) { __VA_ARGS__; } } while (0)
#define SEAM(k) do { if (IN(k) && IN((k) + 1)) xcd_barrier(bar); } while (0)
    LAS unsigned char* glds = F.lds;

    if (IN(0)) { RUN(0, phase_prologue<0>(F, P)); }
    SEAM(0);
    if (IN(1)) { RUN(1, phase_ln1(F, P)); }
    SEAM(1);
    if (IN(2)) {
        pg8::Gemm g{WSP(bf16_t, WS_U), WSP(bf16_t, WS_WINT), D, D, D, nullptr}; pg8::SchedGrid Sd; Sd.init(S, NIN, D, D, F.G, F.bid);
        EpiIn E{F.ws, P.in[5]};
        if (WCO) { const int a = F.bid & 7; using SR = pg8::SchedRange<pg8::SchedGrid>; SR r0{Sd, 0, a}, r1{Sd, a, 1 << 30};
            pg8::gemm_phase<EpiIn, SR, false>(glds, g, r0, E); __syncthreads();
            phase_prologue<1>(F, P); __syncthreads();
            pg8::gemm_phase<EpiIn, SR, false>(glds, g, r1, E); }
        else RUN(2, pg8::gemm_phase<EpiIn, pg8::SchedGrid, false>(glds, g, Sd, E));
    }
    SEAM(2);
    if (IN(3)) {
        pg8::Gemm g{WSP(bf16_t, WS_CKV), WSP(bf16_t, WS_W1T), 1024, 2048, 512, nullptr}; SchedCmp Sd{F.G, F.bid};
        EpiCmp E{WSP(float, WS_HC)};
        RUN(3, pg8::gemm_phase<EpiCmp, SchedCmp, false>(glds, g, Sd, E));
    }
    SEAM(3);
    if (IN(4)) { RUN(4, phase_cmp2_scan(F, P)); }
    SEAM(4);
    if (IN(5)) { { phase_attn(F, P, 0); if (REPS(5) > 1) phase_attn(F, P, 1); } }
#if BMS
    if (IN(5)) { if (hi - lo > 1) xcd_barrier(bar); phase_bms_sort(F, P); if (BMSREP & 1) phase_bms_sort(F, P);
                 if (hi - lo > 1) xcd_barrier(bar); phase_bms_attn(F, P); if (BMSREP & 2) phase_bms_attn(F, P);
                 if (hi - lo > 1) xcd_barrier(bar); phase_bms_combine(F, P); if (BMSREP & 4) phase_bms_combine(F, P); }
#endif
    SEAM(5);
    if (IN(6)) {
        pg8::Gemm g{WSP(bf16_t, WS_O), WSP(bf16_t, WS_BRT1), 1024, 512, 512, nullptr}; pg8::SchedGrid Sd; Sd.init(S, D, 1024, 512, F.G, F.bid);
        EpiMerge<1> E{WSP(bf16_t, WS_GM), WSP(bf16_t, WS_MG)};
        RUN(6, pg8::gemm_phase<EpiMerge<1>, pg8::SchedGrid, false>(glds, g, Sd, E));
    }
    if (IN(6) && IN(7)) __syncthreads();
    if (IN(7)) {
        pg8::Gemm g{WSP(bf16_t, WS_O) + 512, WSP(bf16_t, WS_BRT2), 1024, 512, 512, nullptr}; pg8::SchedGrid Sd; Sd.init(S, D, 1024, 512, F.G, F.bid);
        EpiMerge<2> E{WSP(bf16_t, WS_GM), WSP(bf16_t, WS_MG)};
        pg8::gemm_phase<EpiMerge<2>, pg8::SchedGrid, false>(glds, g, Sd, E);
    }
    SEAM(7);
    if (IN(8)) {
        pg8::Gemm g{WSP(bf16_t, WS_MG), WSP(bf16_t, WS_WOT), D, D, D, nullptr}; pg8::SchedGrid Sd; Sd.init(S, D, D, D, F.G, F.bid);
        EpiWo E{WSP(float, WS_MOD), WSP(bf16_t, WS_X1)};
        RUN(8, pg8::gemm_phase<EpiWo, pg8::SchedGrid, false>(glds, g, Sd, E));
    }
    SEAM(8);
    if (IN(9)) { phase_lnmid_route(F, P, 0); if (REPS(9) > 1) phase_lnmid_route(F, P, 1); }
    SEAM(9);
    if (IN(10)) { RUN(10, phase_scatter(F, P)); }
    SEAM(10);
    if (IN(11)) {
        LAS int* lpane = (LAS int*)(F.lds + 131072); if (F.tid < 256) lpane[F.tid] = WSP(int, WS_PANE)[F.tid]; __syncthreads();
        pg8::Gemm g{WSP(bf16_t, WS_U), WSP(bf16_t, WS_WGUT), D, D, D, WSP(int, WS_ROWTOK)}; SchedMoe Sd{lpane, 4, F.G, F.bid, 0, (size_t)256 * D * 2};
        EpiGU E{WSP(bf16_t, WS_H)};
        RUN(11, pg8::gemm_phase<EpiGU, SchedMoe, true>(glds, g, Sd, E));
    }
    SEAM(11);
    if (IN(12)) {
        LAS int* lpane = (LAS int*)(F.lds + 131072); if (F.tid < 256) lpane[F.tid] = WSP(int, WS_PANE)[F.tid]; __syncthreads();
        pg8::Gemm g{WSP(bf16_t, WS_H), WSP(bf16_t, WS_WDT), DEXP, DEXP, DEXP, nullptr}; SchedMoe Sd{lpane, 8, F.G, F.bid, (size_t)256 * DEXP * 2, (size_t)256 * DEXP * 2};
        EpiDown E{WSP(int, WS_ROWDST), WSP(float, WS_ROWW), WSP(bf16_t, WS_Y2)};
        RUN(12, pg8::gemm_phase<EpiDown, SchedMoe, false>(glds, g, Sd, E));
    }
    SEAM(12);
    if (IN(13)) { RUN(13, phase_final(F, P)); }
#undef IN
#undef SEAM
}

extern "C" void kernel_launch(void* const* d_in, const int* in_sizes, int n_in, void* d_out, int out_size, void* d_ws, size_t ws_size, hipStream_t stream) {
    static int grid = 0;
    if (grid == 0) {
        if (n_in != 25 || out_size != S * D || ws_size < WS_END) { fprintf(stderr, "kernel_launch: unexpected problem (n_in %d, out %d, ws %zu < %zu)\n", n_in, out_size, ws_size, (size_t)WS_END); grid = -1; return; }
        int dev = 0, cus = 0, per_cu = 0;
        if (hipGetDevice(&dev) != hipSuccess || hipDeviceGetAttribute(&cus, hipDeviceAttributeMultiprocessorCount, dev) != hipSuccess) { grid = -1; return; }
        if (hipFuncSetAttribute((const void*)fwd_kernel, hipFuncAttributeMaxDynamicSharedMemorySize, LDS_BYTES) != hipSuccess) { fprintf(stderr, "kernel_launch: hipFuncSetAttribute failed\n"); grid = -1; return; }
        if (hipOccupancyMaxActiveBlocksPerMultiprocessor(&per_cu, (const void*)fwd_kernel, NTHREADS, LDS_BYTES) != hipSuccess || per_cu < 1) fprintf(stderr, "kernel_launch: occupancy query says %d\n", per_cu);
        (void)hipGetLastError();
        grid = cus;
    }
    if (grid < 0) return;
    (void)hipMemsetAsync((char*)d_ws + WS_CTL, 0, CTL_BYTES, stream);
    Params p{};
    for (int i = 0; i < 25; ++i) p.in[i] = (const float*)d_in[i];
    p.out = (float*)d_out; p.ws = (unsigned char*)d_ws;
#if N_LAUNCH_SPLIT
    for (int k = 0; k < NPHASE; ++k) { p.ph_lo = k; p.ph_hi = k + 1; hipLaunchKernelGGL(fwd_kernel, dim3(grid), dim3(NTHREADS), LDS_BYTES, stream, p); }
#else
    p.ph_lo = 0; p.ph_hi = NPHASE; hipLaunchKernelGGL(fwd_kernel, dim3(grid), dim3(NTHREADS), LDS_BYTES, stream, p);
#endif
}
```

```cpp
#include <hip/hip_runtime.h>
#include <cstdint>
#include <cstdio>

#ifndef N_LAUNCH_SPLIT
#define N_LAUNCH_SPLIT 0
#endif

#ifndef PHREP
#define PHREP 0
#endif
#ifndef WCO
#define WCO 1
#endif
#ifndef BMSREP
#define BMSREP 0
#endif
#ifndef NSAP
#define NSAP 0
#endif
#ifndef BMS
#define BMS 1
#endif
#define REPS(k) (1 + ((PHREP >> (k)) & 1))
#define DI __device__ __forceinline__
#define LAS __attribute__((address_space(3)))
#define GAS __attribute__((address_space(1)))

typedef unsigned short bf16_t;
typedef short bf16x8 __attribute__((ext_vector_type(8)));
typedef float f32x4 __attribute__((ext_vector_type(4)));
typedef float f32x2 __attribute__((ext_vector_type(2)));
typedef float f32x16 __attribute__((ext_vector_type(16)));
typedef unsigned u32x4 __attribute__((ext_vector_type(4)));
typedef unsigned u32x2 __attribute__((ext_vector_type(2)));

constexpr int S = 16384, D = 2048, HD = 64;
constexpr int IN_COLS = 6944, OFF_GATE = 1280, OFF_FGT = 2840;
constexpr int NIN = 7168;
constexpr int NCMP = 1023, NCMP_P = 1024;
constexpr int NEXP = 64, DEXP = 512;
constexpr int MAXROWS = 2 * S + NEXP * 256;
constexpr int MAXPAN = MAXROWS / 256;
constexpr float LN_EPS = 1e-5f;
constexpr float LOG2E = 1.4426950408889634f;
constexpr float C2 = 0.125f * LOG2E;
constexpr float ALPHA = 1.189207115002721f;
constexpr int CKROWS = S + 64;
constexpr int NWAVES = 8, NTHREADS = 512;

constexpr size_t MiB = 1u << 20;
constexpr size_t al(size_t x) { return (x + 4095) & ~(size_t)4095; }
constexpr size_t WS_CTL = 0, CTL_BYTES = 1 * MiB;
constexpr size_t WS_MODP = WS_CTL + CTL_BYTES;
constexpr size_t WS_MOD = WS_MODP + al(32 * 12288 * 4);
constexpr size_t WS_PEWP = WS_MOD + al(12288 * 4);
constexpr size_t WS_BIASC = WS_PEWP + al(2 * 32 * 256 * 4);
constexpr size_t WS_WINT = WS_BIASC + al(2 * 256 * 4);
constexpr size_t WS_W1T = WS_WINT + al((size_t)NIN * D * 2);
constexpr size_t WS_BRT1 = WS_W1T + al(2 * 256 * 2048 * 2);
constexpr size_t WS_BRT2 = WS_BRT1 + al(2048 * 512 * 2);
constexpr size_t WS_WOT = WS_BRT2 + al(2048 * 512 * 2);
constexpr size_t WS_WGUT = WS_WOT + al((size_t)D * D * 2);
constexpr size_t WS_WDT = WS_WGUT + al((size_t)NEXP * 1024 * D * 2);
constexpr size_t WS_U = WS_WDT + al((size_t)NEXP * D * DEXP * 2);
constexpr size_t WS_QN = WS_U + al((size_t)S * D * 2);
constexpr size_t WS_CKV = WS_QN + al((size_t)8 * S * 64 * 2);
constexpr size_t WS_SK = WS_CKV + al((size_t)4 * CKROWS * 64 * 2);
constexpr size_t WS_SVT = WS_SK + al((size_t)2 * S * 64 * 2);
constexpr size_t WS_WK = WS_SVT + al((size_t)2 * S * 64 * 2);
constexpr size_t WS_WVT = WS_WK + al((size_t)2 * S * 64 * 2);
constexpr size_t WS_FQ = WS_WVT + al((size_t)2 * S * 64 * 2);
constexpr size_t WS_FK = WS_FQ + al((size_t)8 * S * 64 * 2);
constexpr size_t WS_FVT = WS_FK + al((size_t)8 * S * 64 * 2);
constexpr size_t WS_GM = WS_FVT + al((size_t)8 * S * 64 * 2);
constexpr size_t WS_GN = WS_GM + al((size_t)S * 4096 * 2);
constexpr size_t WS_LOGF = WS_GN + al((size_t)S * 24 * 4);
constexpr size_t WS_FC = WS_LOGF + al((size_t)S * 8 * 4);
constexpr size_t WS_HC = WS_FC + al((size_t)S * 8 * 4);
constexpr size_t WS_KC = WS_HC + al((size_t)4 * 4 * 1024 * 256 * 4);
constexpr size_t WS_VCT = WS_KC + al((size_t)2 * 1024 * 64 * 2);
constexpr size_t WS_O = WS_VCT + al((size_t)2 * 1024 * 64 * 2);
constexpr size_t WS_MG = WS_O + al((size_t)S * 1024 * 2);
constexpr size_t WS_X1 = WS_MG + al((size_t)S * D * 2);
constexpr size_t WS_TOKE = WS_X1 + al((size_t)S * D * 4);
constexpr size_t WS_TOKP = WS_TOKE + al((size_t)S * 2 * 4);
constexpr size_t WS_TOKW = WS_TOKP + al((size_t)S * 2 * 4);
constexpr size_t WS_ROWTOK = WS_TOKW + al((size_t)S * 2 * 4);
constexpr size_t WS_ROWDST = WS_ROWTOK + al((size_t)MAXROWS * 4);
constexpr size_t WS_ROWW = WS_ROWDST + al((size_t)MAXROWS * 4);
constexpr size_t WS_PANE = WS_ROWW + al((size_t)MAXROWS * 4);
constexpr size_t WS_KMAX = WS_PANE + al(1024 * 4);
constexpr size_t WS_HIST = WS_KMAX + al(256 * 8 * 4);
constexpr size_t WS_WRT = WS_HIST + al(256 * 64 * 4);
constexpr size_t WS_SELMG = WS_WRT + al(2 * 80 * 2048 * 2);
constexpr size_t WS_HISTB = WS_SELMG + al((size_t)S * 2 * 8 * 4);
constexpr int BMS_MAXU = 4352;
constexpr size_t WS_TOKL = WS_HISTB + al(2 * 256 * 256 * 4);
constexpr size_t WS_UT = WS_TOKL + al((size_t)2 * BMS_MAXU * 64 * 4);
constexpr size_t WS_END = WS_UT + al(2 * (BMS_MAXU + 8) * 4);
constexpr size_t WS_PML = WS_MG;
constexpr size_t WS_U2L = WS_MG;
constexpr size_t WS_H = WS_QN;
constexpr size_t WS_Y2 = WS_GM;
static_assert(WS_H + (size_t)MAXROWS * DEXP * 2 <= WS_FK, "H overlay");
static_assert(WS_Y2 + (size_t)2 * S * D * 2 <= WS_GN, "Y2 overlay");
static_assert(WS_END <= (size_t)1000 * MiB, "workspace budget");

constexpr int CW_BAR = 4096;
constexpr int CW_CNT = 16384;
constexpr int CW_QATT = 16384 + 256;
constexpr int CW_KMAX = 16384 + 512;

constexpr int LDS_BYTES = 147456;
constexpr int LDS_MISC = 144 * 1024 - 256;

typedef __bf16 bf16x2_t __attribute__((ext_vector_type(2)));
DI unsigned cvtpk(float lo, float hi) { f32x2 v = {lo, hi}; bf16x2_t b = __builtin_convertvector(v, bf16x2_t); return __builtin_bit_cast(unsigned, b); }
DI unsigned f2bf(float f) { unsigned u = __builtin_bit_cast(unsigned, f); return (u + 0x7fffu + ((u >> 16) & 1u)) >> 16; }
DI unsigned pk2(float lo, float hi) { return f2bf(lo) | (f2bf(hi) << 16); }
DI float bf2f(bf16_t b) { return __builtin_bit_cast(float, (unsigned)b << 16); }
DI float dpp_addf(float x, float y) { return x + y; }
template <int CTRL> DI float dpp_mov(float x) { return __builtin_bit_cast(float, __builtin_amdgcn_update_dpp(0, __builtin_bit_cast(int, x), CTRL, 0xF, 0xF, true)); }
DI float wave_sum(float v) {
    v += dpp_mov<0xB1>(v); v += dpp_mov<0x4E>(v); v += dpp_mov<0x124>(v); v += dpp_mov<0x128>(v);
    const float a = __int_as_float(__builtin_amdgcn_readlane(__float_as_int(v), 0)), b = __int_as_float(__builtin_amdgcn_readlane(__float_as_int(v), 16));
    const float c = __int_as_float(__builtin_amdgcn_readlane(__float_as_int(v), 32)), d = __int_as_float(__builtin_amdgcn_readlane(__float_as_int(v), 48));
    return (a + b) + (c + d);
}
DI float fexp2(float x) { return __builtin_amdgcn_exp2f(x); }
DI float sigmoidf_(float x) { return __builtin_amdgcn_rcpf(1.f + __builtin_amdgcn_exp2f(-1.4426950408889634f * x)); }
DI float logsigmoidf_(float x) { return fminf(x, 0.f) - log1pf(__expf(-fabsf(x))); }

#define XB_TMO      128
#define XB_XCNT(j)  (256  + 64 * (j))
#define XB_XSUB(j)  (1280 + 64 * (j))
#define XB_XGEN(j)  (2304 + 64 * (j))
#define XB_TOP      3328
#define XB_TOPGEN   3392
#define XCD_BAR_WORDS 3456
#define XB_SPIN_CAP (1u << 20)
DI unsigned xb_ld(unsigned* p)              { return __hip_atomic_load(p, __ATOMIC_RELAXED, __HIP_MEMORY_SCOPE_AGENT); }
DI unsigned xb_add(unsigned* p, unsigned v) { return __hip_atomic_fetch_add(p, v, __ATOMIC_RELAXED, __HIP_MEMORY_SCOPE_AGENT); }
DI unsigned xb_xcc_id() { return (unsigned)__builtin_amdgcn_s_getreg((3 << 11) | 20) & 0xFu; }
#define XB_SPIN(cond, bar) do { unsigned _sp = 0; while (cond) { __builtin_amdgcn_s_sleep(1); \
    if ((++_sp & 255u) == 0u) { if (xb_ld(&(bar)[XB_TMO])) break; if (_sp > XB_SPIN_CAP) { atomicAdd(&(bar)[XB_TMO], 1u); break; } } } } while (0)
struct XcdBarrier { unsigned* bar; unsigned x; volatile LAS unsigned* st; };
DI XcdBarrier xcd_barrier_post(unsigned* bar, volatile LAS unsigned* st) {
    XcdBarrier b; b.bar = bar; b.x = xb_xcc_id(); b.st = st;
    if (threadIdx.x == 0) (void)xb_add(&bar[XB_XCNT(b.x)], 1u);
    return b;
}
DI void xcd_barrier_complete(unsigned* bar, unsigned x, unsigned& nloc, unsigned& nx) {
    const unsigned G = gridDim.x * gridDim.y * gridDim.z;
    unsigned sum, cnt, mine, sp = 0u;
    for (;;) {
        sum = 0u; cnt = 0u; mine = 0u;
#pragma unroll
        for (unsigned j = 0; j < 16; ++j) { const unsigned c = xb_ld(&bar[XB_XCNT(j)]); sum += c; cnt += (c > 0u) ? 1u : 0u; mine = (j == x) ? c : mine; }
        if (sum == G) break;
        __builtin_amdgcn_s_sleep(1);
        if ((++sp & 255u) == 0u) { if (xb_ld(&bar[XB_TMO])) break; if (sp > XB_SPIN_CAP) { atomicAdd(&bar[XB_TMO], 1u); break; } }
    }
    nloc = mine > 0u ? mine : 1u; nx = cnt > 0u ? cnt : 1u;
}
DI void xcd_barrier(const XcdBarrier& b) {
    asm volatile("s_waitcnt vmcnt(0)" ::: "memory");
    __syncthreads();
    if (threadIdx.x == 0) {
        unsigned* bar = b.bar;
        __builtin_amdgcn_s_waitcnt(0);
        unsigned nloc = b.st[0], nx = b.st[1];
        if (nloc == 0u) { xcd_barrier_complete(bar, b.x, nloc, nx); b.st[0] = nloc; b.st[1] = nx; }
        const unsigned old = xb_add(&bar[XB_XSUB(b.x)], 1u);
        const unsigned gen = old / nloc;
        if (old + 1u == (gen + 1u) * nloc) {
            __builtin_amdgcn_fence(__ATOMIC_RELEASE, "agent");
            asm volatile("s_waitcnt vmcnt(0)" ::: "memory");
            const unsigned og = xb_add(&bar[XB_TOP], 1u);
            const unsigned tg = og / nx;
            if (og + 1u == (tg + 1u) * nx) xb_add(&bar[XB_TOPGEN], 1u);
            else XB_SPIN(xb_ld(&bar[XB_TOPGEN]) == tg, bar);
            __builtin_amdgcn_fence(__ATOMIC_ACQUIRE, "agent");
            xb_add(&bar[XB_XGEN(b.x)], 1u);
            asm volatile("s_waitcnt vmcnt(0)" ::: "memory");
        } else {
            XB_SPIN(xb_ld(&bar[XB_XGEN(b.x)]) == gen, bar);
            __builtin_amdgcn_fence(__ATOMIC_ACQUIRE, "agent");
            asm volatile("s_waitcnt vmcnt(0)" ::: "memory");
        }
    }
    __syncthreads();
}

namespace pg8 {
constexpr int BM = 256, BK = 64, HALF = 128, HTB = HALF * BK * 2, STAGE_BYTES = 8 * HTB, NXCD = 8, WGM = 8;
__host__ __device__ __forceinline__ int lds_byte(int r, int c) { const int st = (r >> 4) * 2 + (c >> 5), rr = r & 15, cc = c & 31, ob = rr * 64 + cc * 2; return st * 1024 + (ob ^ (((ob >> 9) & 1) << 5)); }
__host__ __device__ __forceinline__ void stage_rc(int b, int& R, int& C) { const int st = b / 1024, sb = b % 1024, swz = sb ^ (((sb >> 9) & 1) << 5); R = (st >> 1) * 16 + swz / 64; C = (st & 1) * 32 + (swz % 64) / 2; }
__host__ __device__ __forceinline__ int perm32(int rho) { const int n = rho >> 4, i = rho & 15; return 8 * (i >> 2) + 4 * n + (i & 3); }

struct Unit { int pm, pn, aux; size_t aoff, boff; };
struct Gemm { const bf16_t* A; const bf16_t* Bt; int lda, ldb, K; const int* rowtok; };

struct SchedGrid {
    int nM, nN, nwg, G, c; size_t ta, tb;
    DI void init(int M, int N, int lda, int ldb, int G_, int c_) { nM = M / BM; nN = N / BM; nwg = nM * nN; G = G_; c = c_; ta = (size_t)BM * lda * 2; tb = (size_t)BM * ldb * 2; }
    DI bool next(int i, Unit& u) const {
        const long L = (long)i * G + c; if (L >= nwg) return false;
        int wgid = (int)L; { const int q = nwg / NXCD, r = nwg % NXCD, xcd = wgid % NXCD, off = wgid / NXCD; wgid = (xcd < r ? xcd * (q + 1) : r * (q + 1) + (xcd - r) * q) + off; }
        const int nig = WGM * nN, gid = wgid / nig, fm = gid * WGM, gsz = (nM - fm) < WGM ? (nM - fm) : WGM;
        u.pm = fm + ((wgid % nig) % gsz); u.pn = (wgid % nig) / gsz; u.aux = 0; u.aoff = (size_t)u.pm * ta; u.boff = (size_t)u.pn * tb; return true;
    }
};

template <class Sched> struct SchedRange { const Sched& s; int i0, i1; DI bool next(int i, Unit& u) const { return (i0 + i < i1) && s.next(i0 + i, u); } };

DI unsigned cvt_pk_bf16(float lo, float hi) { return cvtpk(lo, hi); }

template <class Epi, class Sched, bool GATHER>
DI void gemm_phase(LAS unsigned char* lds, const Gemm g, const Sched& S, const Epi& E) {
    const int tid = threadIdx.x, wid = __builtin_amdgcn_readfirstlane(tid >> 6), lane = tid & 63, wr = wid >> 2, wc = wid & 3, fr = lane & 15, fq = lane >> 4;
    const int K = g.K, nt = K / BK;
    int Rr[2], Cc[2];
    unsigned voffA[2][2], voffB[2], nvoffA[2][2];
#pragma unroll
    for (int i = 0; i < 2; ++i) { int R, C; stage_rc(tid * 16 + i * 8192, R, C); const int Rb = Epi::PERM ? ((R & ~31) + perm32(R & 31)) : R; Rr[i] = R; Cc[i] = C;
        voffA[0][i] = (unsigned)(R * g.lda + C) * 2u; voffA[1][i] = (unsigned)((R + HALF) * g.lda + C) * 2u; voffB[i] = (unsigned)(Rb * g.ldb + C) * 2u;
        nvoffA[0][i] = voffA[0][i]; nvoffA[1][i] = voffA[1][i]; }
    const size_t kstep = (size_t)(BK * 2);
    const size_t hstepB = (size_t)HALF * g.ldb * 2;
    const unsigned ldsw = (unsigned)wid * 1024u;
    const int aoff = lds_byte(wr * 64 + fr, fq * 8), boff = lds_byte(wc * 32 + fr, fq * 8);
#define PG8_SA(b, h) (((b) * 2 + (h)) * HTB)
#define PG8_SB(b, h) ((4 + (b) * 2 + (h)) * HTB)
#define PG8_STAGE(bufoff, gbase, voff) do { _Pragma("unroll") for (int _i = 0; _i < 2; ++_i) \
        __builtin_amdgcn_global_load_lds((const unsigned*)((const char*)(gbase) + (voff)[_i]), (LAS unsigned*)(lds + (bufoff) + ldsw + _i * 8192), 16, 0, 0); } while (0)
#define PG8_LDA(dst, b, h) do { _Pragma("unroll") for (int m = 0; m < 4; ++m) _Pragma("unroll") for (int k = 0; k < 2; ++k) dst[m][k] = *(const LAS bf16x8*)(lds + PG8_SA(b, h) + aoff + m * 2048 + k * 1024); } while (0)
#define PG8_LDB(dst, b, h) do { _Pragma("unroll") for (int n = 0; n < 2; ++n) _Pragma("unroll") for (int k = 0; k < 2; ++k) dst[n][k] = *(const LAS bf16x8*)(lds + PG8_SB(b, h) + boff + n * 2048 + k * 1024); } while (0)
#define PG8_MMA(ai, bj, At, Bt) do { __builtin_amdgcn_s_setprio(1); _Pragma("unroll") for (int m = 0; m < 4; ++m) _Pragma("unroll") for (int n = 0; n < 2; ++n) _Pragma("unroll") for (int k = 0; k < 2; ++k) \
        acc[ai][bj][m][n] = __builtin_amdgcn_mfma_f32_16x16x32_bf16(Bt[n][k], At[m][k], acc[ai][bj][m][n], 0, 0, 0); __builtin_amdgcn_s_setprio(0); } while (0)
#define PG8_WAIT_V(n) asm volatile("s_waitcnt vmcnt(" #n ")" ::: "memory")
#define PG8_WAIT_L(n) asm volatile("s_waitcnt lgkmcnt(" #n ")" ::: "memory")
#define PG8_BAR __builtin_amdgcn_s_barrier()
#define PG8_SCHED __builtin_amdgcn_sched_barrier(0)
#define PG8_GATHER(dst, u) do { if constexpr (GATHER) { _Pragma("unroll") for (int _h = 0; _h < 2; ++_h) _Pragma("unroll") for (int _i = 0; _i < 2; ++_i) { \
        int _t = g.rowtok[(u).pm * BM + _h * HALF + Rr[_i]]; _t = _t < 0 ? 0 : _t; dst[_h][_i] = (unsigned)(_t * g.lda + Cc[_i]) * 2u; } } } while (0)
    Unit cur, nxt; int ui = 0;
    if (!S.next(0, cur)) return;
    f32x4 acc[2][2][4][2];
#pragma unroll
    for (int a = 0; a < 2; ++a)
#pragma unroll
        for (int b = 0; b < 2; ++b)
#pragma unroll
            for (int m = 0; m < 4; ++m)
#pragma unroll
                for (int n = 0; n < 2; ++n) acc[a][b][m][n] = (f32x4){0.f, 0.f, 0.f, 0.f};
    bf16x8 At[4][2], B0[2][2], B1[2][2];
    const char* cA = (const char*)g.A + cur.aoff; const char* cB = (const char*)g.Bt + cur.boff;
    PG8_GATHER(voffA, cur);
    PG8_STAGE(PG8_SB(0, 0), cB, voffB); PG8_STAGE(PG8_SB(0, 1), cB + hstepB, voffB); PG8_STAGE(PG8_SA(0, 0), cA, voffA[0]); PG8_STAGE(PG8_SA(0, 1), cA, voffA[1]);
    if (wr == 1) PG8_BAR;
    PG8_WAIT_V(2); PG8_BAR;
    PG8_STAGE(PG8_SB(1, 0), cB + kstep, voffB); PG8_STAGE(PG8_SA(1, 0), cA + kstep, voffA[0]); PG8_STAGE(PG8_SB(1, 1), cB + hstepB + kstep, voffB);
    PG8_WAIT_V(6); PG8_BAR;
    for (;;) {
        const bool has_next = S.next(ui + 1, nxt);
        const char* nA = has_next ? (const char*)g.A + nxt.aoff : cA; const char* nB = has_next ? (const char*)g.Bt + nxt.boff : cB;
        if constexpr (GATHER) { if (has_next) { PG8_GATHER(nvoffA, nxt); } else { _Pragma("unroll") for (int h = 0; h < 2; ++h) _Pragma("unroll") for (int i = 0; i < 2; ++i) nvoffA[h][i] = voffA[h][i]; } }
        for (int t = 0; t < nt; t += 2) {
            const bool last = (t == nt - 2);
            const char* a1 = cA + (size_t)(t + 1) * kstep;
            const char* a2 = last ? nA : cA + (size_t)(t + 2) * kstep; const char* b2 = last ? nB : cB + (size_t)(t + 2) * kstep;
            const char* a3 = a2 + kstep; const char* b3 = b2 + kstep;
            unsigned va2[2][2];
#pragma unroll
            for (int h = 0; h < 2; ++h)
#pragma unroll
                for (int i = 0; i < 2; ++i) va2[h][i] = (GATHER && last) ? nvoffA[h][i] : voffA[h][i];
            PG8_LDB(B0, 0, 0); PG8_LDB(B1, 0, 1); PG8_SCHED; PG8_LDA(At, 0, 0); PG8_STAGE(PG8_SA(1, 1), a1, voffA[1]);
            PG8_WAIT_V(8); PG8_WAIT_L(0); PG8_BAR; PG8_MMA(0, 0, At, B0); PG8_MMA(0, 1, At, B1); PG8_BAR; PG8_SCHED;
            PG8_LDA(At, 0, 1); PG8_STAGE(PG8_SB(0, 0), b2, voffB); PG8_STAGE(PG8_SB(0, 1), b2 + hstepB, voffB); PG8_STAGE(PG8_SA(0, 0), a2, va2[0]);
            PG8_WAIT_V(8); PG8_WAIT_L(0); PG8_BAR; PG8_MMA(1, 0, At, B0); PG8_MMA(1, 1, At, B1); PG8_BAR; PG8_SCHED;
            PG8_LDB(B0, 1, 0); PG8_LDB(B1, 1, 1); PG8_SCHED; PG8_LDA(At, 1, 0); PG8_STAGE(PG8_SA(0, 1), a2, va2[1]);
            PG8_WAIT_V(8); PG8_WAIT_L(0); PG8_BAR; PG8_MMA(0, 0, At, B0); PG8_MMA(0, 1, At, B1); PG8_BAR; PG8_SCHED;
            PG8_LDA(At, 1, 1); PG8_STAGE(PG8_SB(1, 0), b3, voffB); PG8_STAGE(PG8_SB(1, 1), b3 + hstepB, voffB); PG8_STAGE(PG8_SA(1, 0), a3, va2[0]);
            PG8_WAIT_V(8); PG8_WAIT_L(0); PG8_BAR; PG8_MMA(1, 0, At, B0); PG8_MMA(1, 1, At, B1); PG8_BAR; PG8_SCHED;
        }
        if (wr == 0) PG8_BAR;
        E(acc, cur, wr, wc, fr, fq);
        if (!has_next) break;
#pragma unroll
        for (int a = 0; a < 2; ++a)
#pragma unroll
            for (int b = 0; b < 2; ++b)
#pragma unroll
                for (int m = 0; m < 4; ++m)
#pragma unroll
                    for (int n = 0; n < 2; ++n) acc[a][b][m][n] = (f32x4){0.f, 0.f, 0.f, 0.f};
        cur = nxt; cA = nA; cB = nB; ++ui;
        if constexpr (GATHER) { _Pragma("unroll") for (int h = 0; h < 2; ++h) _Pragma("unroll") for (int i = 0; i < 2; ++i) voffA[h][i] = nvoffA[h][i]; }
        if (wr == 1) PG8_BAR;
    }
    PG8_WAIT_V(0);
    PG8_BAR;
#undef PG8_SA
#undef PG8_SB
#undef PG8_STAGE
#undef PG8_LDA
#undef PG8_LDB
#undef PG8_MMA
#undef PG8_WAIT_V
#undef PG8_WAIT_L
#undef PG8_BAR
#undef PG8_SCHED
#undef PG8_GATHER
}
}

struct Params {
    const float* in[25];
    float* out;
    unsigned char* ws;
    int ph_lo, ph_hi;
};
struct Frame {
    LAS unsigned char* lds;
    unsigned* ctl;
    int tid, lane, wave, G, bid;
    unsigned char* ws;
};
#define WSP(T, off) ((T*)(F.ws + (off)))

using pg8::Unit; using pg8::BM; using pg8::HALF; using pg8::cvt_pk_bf16;

struct EpiIn {
    static constexpr bool PERM = true;
    unsigned char* ws; const float* b_fgt;
    DI bf16_t* dest(int cg, bool& trans, float& sc) const {
        trans = false; sc = 1.f;
        if (cg < 8)  { sc = C2; return (bf16_t*)(ws + WS_QN) + (size_t)cg * S * 64; }
        if (cg < 12) { return (bf16_t*)(ws + WS_CKV) + (size_t)(cg - 8) * CKROWS * 64; }
        if (cg < 14) { return (bf16_t*)(ws + WS_SK) + (size_t)(cg - 12) * S * 64; }
        if (cg < 16) { trans = true; return (bf16_t*)(ws + WS_SVT) + (size_t)(cg - 14) * 64 * S; }
        if (cg < 18) { return (bf16_t*)(ws + WS_WK) + (size_t)(cg - 16) * S * 64; }
        if (cg < 20) { trans = true; return (bf16_t*)(ws + WS_WVT) + (size_t)(cg - 18) * 64 * S; }
        if (cg < 28) { sc = C2; return (bf16_t*)(ws + WS_FQ) + (size_t)(cg - 20) * S * 64; }
        if (cg < 36) { return (bf16_t*)(ws + WS_FK) + (size_t)(cg - 28) * S * 64; }
        trans = true; return (bf16_t*)(ws + WS_FVT) + (size_t)(cg - 36) * 64 * S;
    }
    DI void operator()(const f32x4 (&acc)[2][2][4][2], const Unit& u, int wr, int wc, int fr, int fq) const {
        asm volatile("" : "+v"(fr), "+v"(fq)); asm volatile("" : "+s"(wr), "+s"(wc));
        const int row0 = u.pm * BM + wr * 64 + fr;
        if (u.pn <= 10) {
#pragma unroll
            for (int bj = 0; bj < 2; ++bj) {
                const int cb = 128 * bj + 32 * wc, cg = u.pn * 4 + (cb >> 6), d0 = (cb & 63) + 8 * fq;
                bool trans; float sc; bf16_t* base = dest(cg, trans, sc);
#pragma unroll
                for (int ai = 0; ai < 2; ++ai)
#pragma unroll
                    for (int m = 0; m < 4; ++m) {
                        const int t = row0 + ai * HALF + m * 16;
                        const f32x4 v0 = acc[ai][bj][m][0] * sc, v1 = acc[ai][bj][m][1] * sc;
                        if (!trans) { u32x4 w; w.x = cvt_pk_bf16(v0[0], v0[1]); w.y = cvt_pk_bf16(v0[2], v0[3]); w.z = cvt_pk_bf16(v1[0], v1[1]); w.w = cvt_pk_bf16(v1[2], v1[3]);
                            *(u32x4*)(base + (size_t)t * 64 + d0) = w; }
                        else {
#pragma unroll
                            for (int j = 0; j < 4; ++j) { base[((size_t)(t >> 5) * 64 + d0 + j) * 32 + (t & 31)] = (bf16_t)f2bf(v0[j]); base[((size_t)(t >> 5) * 64 + d0 + 4 + j) * 32 + (t & 31)] = (bf16_t)f2bf(v1[j]); }
                        }
                    }
            }
        } else if (u.pn <= 26) {
            bf16_t* gm = (bf16_t*)(ws + WS_GM);
#pragma unroll
            for (int bj = 0; bj < 2; ++bj) {
                const int col = (u.pn - 11) * 256 + 128 * bj + 32 * wc + 8 * fq;
#pragma unroll
                for (int ai = 0; ai < 2; ++ai)
#pragma unroll
                    for (int m = 0; m < 4; ++m) {
                        const int t = row0 + ai * HALF + m * 16;
                        const f32x4 v0 = acc[ai][bj][m][0], v1 = acc[ai][bj][m][1];
                        u32x4 w; w.x = cvt_pk_bf16(sigmoidf_(v0[0]), sigmoidf_(v0[1])); w.y = cvt_pk_bf16(sigmoidf_(v0[2]), sigmoidf_(v0[3]));
                        w.z = cvt_pk_bf16(sigmoidf_(v1[0]), sigmoidf_(v1[1])); w.w = cvt_pk_bf16(sigmoidf_(v1[2]), sigmoidf_(v1[3]));
                        *(u32x4*)(gm + (size_t)t * 4096 + col) = w;
                    }
            }
        } else {
            if (wc == 0) {
                float* gn = (float*)(ws + WS_GN); float* lf = (float*)(ws + WS_LOGF);
#pragma unroll
                for (int ai = 0; ai < 2; ++ai)
#pragma unroll
                    for (int m = 0; m < 4; ++m) {
                        const int t = row0 + ai * HALF + m * 16;
#pragma unroll
                        for (int n = 0; n < 2; ++n)
#pragma unroll
                            for (int j = 0; j < 4; ++j) {
                                const int c = 8 * fq + 4 * n + j; const float v = acc[ai][0][m][n][j];
                                if (c < 24) gn[(size_t)t * 24 + c] = sigmoidf_(v);
                                else lf[(size_t)t * 8 + (c - 24)] = logsigmoidf_(v + b_fgt[c - 24]);
                            }
                    }
            }
        }
    }
};

DI float gelu_tanh(float x) { const float u = 0.7978845608028654f * (x + 0.044715f * x * x * x); return 0.5f * x * (1.f + tanhf(u)); }

struct EpiCmp {
    static constexpr bool PERM = false;
    float* hp;
    DI void operator()(const f32x4 (&acc)[2][2][4][2], const Unit& u, int wr, int wc, int fr, int fq) const {
        asm volatile("" : "+v"(fr), "+v"(fq)); asm volatile("" : "+s"(wr), "+s"(wc));
        const int row0 = u.pm * BM + wr * 64 + fr; float* base = hp + (size_t)u.aux * 1024 * 256;
#pragma unroll
        for (int bj = 0; bj < 2; ++bj)
#pragma unroll
            for (int n = 0; n < 2; ++n) { const int col = 128 * bj + 32 * wc + 16 * n + 4 * fq;
#pragma unroll
                for (int ai = 0; ai < 2; ++ai)
#pragma unroll
                    for (int m = 0; m < 4; ++m) *(f32x4*)(base + (size_t)(row0 + ai * HALF + m * 16) * 256 + col) = acc[ai][bj][m][n]; }
    }
};
struct SchedCmp {
    int G, c;
    DI bool next(int i, Unit& u) const { const int L = i * G + c; if (L >= 64) return false; const int ks = L & 3, zg = L >> 4; u.pm = (L >> 2) & 3; u.pn = 0; u.aux = ks * 4 + zg;
        u.aoff = ((size_t)zg * CKROWS * 64 + (size_t)u.pm * 256 * 1024 + ks * 512) * 2; u.boff = ((size_t)(zg >> 1) * 256 * 2048 + ks * 512) * 2; return true; }
};

template <int STEP> struct EpiMerge {
    static constexpr bool PERM = true;
    const bf16_t* gm; bf16_t* mg;
    DI void operator()(const f32x4 (&acc)[2][2][4][2], const Unit& u, int wr, int wc, int fr, int fq) const {
        asm volatile("" : "+v"(fr), "+v"(fq)); asm volatile("" : "+s"(wr), "+s"(wc));
        const int row0 = u.pm * BM + wr * 64 + fr;
#pragma unroll
        for (int bj = 0; bj < 2; ++bj) {
            const int col = u.pn * 256 + 128 * bj + 32 * wc + 8 * fq;
#pragma unroll
            for (int ai = 0; ai < 2; ++ai)
#pragma unroll
                for (int m = 0; m < 4; ++m) {
                    const int t = row0 + ai * HALF + m * 16;
                    const u32x4 gw = *(const u32x4*)(gm + (size_t)t * 4096 + (STEP - 1) * 2048 + col);
                    float gv[8], pv[8];
#pragma unroll
                    for (int j = 0; j < 4; ++j) { gv[2 * j] = __builtin_bit_cast(float, gw[j] << 16); gv[2 * j + 1] = __builtin_bit_cast(float, gw[j] & 0xffff0000u); }
                    if (STEP == 2) { const u32x4 pw = *(const u32x4*)(mg + (size_t)t * 2048 + col);
#pragma unroll
                        for (int j = 0; j < 4; ++j) { pv[2 * j] = __builtin_bit_cast(float, pw[j] << 16); pv[2 * j + 1] = __builtin_bit_cast(float, pw[j] & 0xffff0000u); } }
                    else {
#pragma unroll
                        for (int j = 0; j < 8; ++j) pv[j] = 0.f; }
                    const f32x4 v0 = acc[ai][bj][m][0], v1 = acc[ai][bj][m][1];
                    float o[8];
#pragma unroll
                    for (int j = 0; j < 4; ++j) { o[j] = pv[j] + gv[j] * v0[j]; o[4 + j] = pv[4 + j] + gv[4 + j] * v1[j]; }
                    u32x4 w; w.x = cvt_pk_bf16(o[0], o[1]); w.y = cvt_pk_bf16(o[2], o[3]); w.z = cvt_pk_bf16(o[4], o[5]); w.w = cvt_pk_bf16(o[6], o[7]);
                    *(u32x4*)(mg + (size_t)t * 2048 + col) = w;
                }
        }
    }
};

struct EpiWo {
    static constexpr bool PERM = true;
    const float* mod; bf16_t* yb;
    DI void operator()(const f32x4 (&acc)[2][2][4][2], const Unit& u, int wr, int wc, int fr, int fq) const {
        asm volatile("" : "+v"(fr), "+v"(fq)); asm volatile("" : "+s"(wr), "+s"(wc));
        const int row0 = u.pm * BM + wr * 64 + fr;
#pragma unroll
        for (int bj = 0; bj < 2; ++bj) {
            const int col = u.pn * BM + 128 * bj + 32 * wc + 8 * fq;
            const f32x4 ga = *(const f32x4*)(mod + 2 * D + col) + 1.0f, gb = *(const f32x4*)(mod + 2 * D + col + 4) + 1.0f;
#pragma unroll
            for (int ai = 0; ai < 2; ++ai)
#pragma unroll
                for (int m = 0; m < 4; ++m) {
                    const f32x4 v0 = acc[ai][bj][m][0] * ga, v1 = acc[ai][bj][m][1] * gb;
                    u32x4 w; w.x = cvt_pk_bf16(v0[0], v0[1]); w.y = cvt_pk_bf16(v0[2], v0[3]); w.z = cvt_pk_bf16(v1[0], v1[1]); w.w = cvt_pk_bf16(v1[2], v1[3]);
                    *(u32x4*)(yb + (size_t)(row0 + ai * HALF + m * 16) * D + col) = w;
                }
        }
    }
};

struct SchedMoe {
    const LAS int* pane; int npn, G, c; size_t arow_bytes, btile_bytes;
    DI bool next(int i, Unit& u) const {
        const int np = pane[0]; const int L = i * G + c; if (L >= np * npn) return false;
        const int p = L / npn, pn = L - p * npn, e = pane[1 + p];
        u.pm = p; u.pn = pn; u.aux = e; u.aoff = (size_t)p * arow_bytes; u.boff = (size_t)(e * npn + pn) * btile_bytes; return true;
    }
};
struct EpiGU {
    static constexpr bool PERM = true;
    bf16_t* h;
    DI void operator()(const f32x4 (&acc)[2][2][4][2], const Unit& u, int wr, int wc, int fr, int fq) const {
        asm volatile("" : "+v"(fr), "+v"(fq)); asm volatile("" : "+s"(wr), "+s"(wc));
        const int row0 = u.pm * BM + wr * 64 + fr; const int col = u.pn * 128 + 32 * wc + 8 * fq;
#pragma unroll
        for (int ai = 0; ai < 2; ++ai)
#pragma unroll
            for (int m = 0; m < 4; ++m) {
                const int r = row0 + ai * HALF + m * 16;
                float o[8];
#pragma unroll
                for (int n = 0; n < 2; ++n)
#pragma unroll
                    for (int j = 0; j < 4; ++j) { const float gt = acc[ai][0][m][n][j], up = acc[ai][1][m][n][j]; o[4 * n + j] = gt * sigmoidf_(gt) * up; }
                u32x4 w; w.x = cvt_pk_bf16(o[0], o[1]); w.y = cvt_pk_bf16(o[2], o[3]); w.z = cvt_pk_bf16(o[4], o[5]); w.w = cvt_pk_bf16(o[6], o[7]);
                *(u32x4*)(h + (size_t)r * DEXP + col) = w;
            }
    }
};
struct EpiDown {
    static constexpr bool PERM = true;
    const int* rowdst; const float* roww; bf16_t* y2;
    DI void operator()(const f32x4 (&acc)[2][2][4][2], const Unit& u, int wr, int wc, int fr, int fq) const {
        asm volatile("" : "+v"(fr), "+v"(fq)); asm volatile("" : "+s"(wr), "+s"(wc));
        const int row0 = u.pm * BM + wr * 64 + fr;
#pragma unroll
        for (int ai = 0; ai < 2; ++ai)
#pragma unroll
            for (int m = 0; m < 4; ++m) {
                const int r = row0 + ai * HALF + m * 16; const int dst = rowdst[r];
                if (dst >= 0) { const float w8 = roww[r];
#pragma unroll
                    for (int bj = 0; bj < 2; ++bj) { const int col = u.pn * 256 + 128 * bj + 32 * wc + 8 * fq;
                        const f32x4 v0 = acc[ai][bj][m][0] * w8, v1 = acc[ai][bj][m][1] * w8;
                        u32x4 w; w.x = cvt_pk_bf16(v0[0], v0[1]); w.y = cvt_pk_bf16(v0[2], v0[3]); w.z = cvt_pk_bf16(v1[0], v1[1]); w.w = cvt_pk_bf16(v1[2], v1[3]);
                        *(u32x4*)(y2 + (size_t)dst * D + col) = w; } }
            }
    }
};


template <int UNR = 8> DI void tr_item(const float* srcrow0, int ldsrc, int col4, bool colok, bf16_t* dst, int ldd, int nrows, LAS float* scr, int lane) {
#pragma unroll UNR
    for (int it = 0; it < 16; ++it) { const int k = it * 4 + (lane >> 4); f32x4 v = (f32x4){0.f, 0.f, 0.f, 0.f};
        if (colok) v = (UNR == 16) ? __builtin_nontemporal_load((const f32x4*)(srcrow0 + (size_t)k * ldsrc + col4)) : *(const f32x4*)(srcrow0 + (size_t)k * ldsrc + col4);
        LAS float* s = scr + k * 65 + (lane & 15) * 4; s[0] = v[0]; s[1] = v[1]; s[2] = v[2]; s[3] = v[3]; }
    asm volatile("s_waitcnt lgkmcnt(0)" ::: "memory");
    const int c = lane & 7;
#pragma unroll
    for (int it = 0; it < 8; ++it) { const int n = it * 8 + (lane >> 3); const LAS float* s = scr + (8 * c) * 65 + n;
        u32x4 o; o.x = cvtpk(s[0 * 65], s[1 * 65]); o.y = cvtpk(s[2 * 65], s[3 * 65]); o.z = cvtpk(s[4 * 65], s[5 * 65]); o.w = cvtpk(s[6 * 65], s[7 * 65]);
        if (n < nrows) { if (UNR == 16) __builtin_nontemporal_store(o, (u32x4*)(dst + (size_t)n * ldd + 8 * c)); else *(u32x4*)(dst + (size_t)n * ldd + 8 * c) = o; } }
    asm volatile("s_waitcnt lgkmcnt(0)" ::: "memory");
}

template <int PART> DI void phase_prologue(Frame& F, const Params& P) {
    LAS float* scr = (LAS float*)(F.lds + F.wave * 16640);
    const int gw = F.bid * NWAVES + F.wave, NGW = F.G * NWAVES, lane = F.lane;
    const int c4 = (lane & 15) * 4;
    constexpr int I_IN = 32 * 109, I_W1 = 2 * 32 * 4, I_BR = 8 * 32, I_WO = 32 * 32, I_G = NEXP * 32 * 8, I_D = NEXP * 8 * 32;
    constexpr int I_MOD = 48 * 32, I_PEW = 64, I_RT = 32;
    constexpr int NITEMS = I_IN + I_W1 + 2 * I_BR + I_WO + 2 * I_G + I_D + I_MOD + I_PEW + I_RT;
    constexpr int NTR = NITEMS - (I_MOD + I_PEW + I_RT);
    constexpr int I_MOE = 2 * I_G + I_D, R_MOE = I_IN + I_W1 + 2 * I_BR + I_WO;
    constexpr int NLOOP = !WCO ? NITEMS : (PART == 0 ? (I_MOD + I_PEW + I_RT) + R_MOE : I_MOE);
    for (int it = gw; it < NLOOP; it += NGW) {
        int r;
        if (!WCO) r = it < (I_MOD + I_PEW + I_RT) ? NTR + it : it - (I_MOD + I_PEW + I_RT);
        else if (PART == 1) r = R_MOE + it;
        else r = it < (I_MOD + I_PEW + I_RT) ? NTR + it : it - (I_MOD + I_PEW + I_RT);
        if (r < I_IN) {
            const int kb = r / 109, nb = r % 109, j0 = nb * 64; const float* w = P.in[4] + (size_t)(kb * 64) * IN_COLS;
            bf16_t* dst = WSP(bf16_t, WS_WINT) + (size_t)j0 * D + kb * 64;
            if (nb < 108) { const int oc = j0 < 1280 ? j0 : (j0 < 2816 ? j0 + 24 : j0 + 32); tr_item(w, IN_COLS, oc + c4, true, dst, D, 64, scr, lane); }
            else { const int oc = c4 < 24 ? OFF_GATE + c4 : OFF_FGT + (c4 - 24); tr_item(w, IN_COLS, oc, c4 < 32, dst, D, 32, scr, lane); }
            continue; } r -= I_IN;
        if (r < I_W1) { const int z = r / 128, q = r % 128, kb = q / 4, nb = q % 4;
            tr_item(P.in[8] + (size_t)z * 2048 * 256 + (size_t)(kb * 64) * 256, 256, nb * 64 + c4, true, WSP(bf16_t, WS_W1T) + ((size_t)z * 256 + nb * 64) * 2048 + kb * 64, 2048, 64, scr, lane);
            continue; } r -= I_W1;
        if (r < 2 * I_BR) { const int which = r / I_BR, q = r % I_BR, kb = q / 32, nb = q % 32;
            tr_item(P.in[11 + which] + (size_t)(kb * 64) * 2048, 2048, nb * 64 + c4, true, WSP(bf16_t, which ? WS_BRT2 : WS_BRT1) + (size_t)(nb * 64) * 512 + kb * 64, 512, 64, scr, lane);
            continue; } r -= 2 * I_BR;
        if (r < I_WO) { const int kb = r / 32, nb = r % 32;
            tr_item(P.in[13] + (size_t)(kb * 64) * 2048, 2048, nb * 64 + c4, true, WSP(bf16_t, WS_WOT) + (size_t)(nb * 64) * 2048 + kb * 64, 2048, 64, scr, lane);
            continue; } r -= I_WO;
        if (r < 2 * I_G) { const int up = r / I_G, q = r % I_G, e = q / 256, q2 = q % 256, kb = q2 / 8, nb = q2 % 8;
            const int n0 = nb * 64, drow = (n0 >> 7) * 256 + up * 128 + (n0 & 127);
            tr_item<(PART == 1 ? 16 : 4)>(P.in[20 + up] + (size_t)e * 2048 * 512 + (size_t)(kb * 64) * 512, 512, n0 + c4, true, WSP(bf16_t, WS_WGUT) + ((size_t)e * 1024 + drow) * 2048 + kb * 64, 2048, 64, scr, lane);
            continue; } r -= 2 * I_G;
        if (r < I_D) { const int e = r / 256, q2 = r % 256, kb = q2 / 32, nb = q2 % 32;
            tr_item<(PART == 1 ? 16 : 4)>(P.in[22] + (size_t)e * 512 * 2048 + (size_t)(kb * 64) * 2048, 2048, nb * 64 + c4, true, WSP(bf16_t, WS_WDT) + ((size_t)e * 2048 + nb * 64) * 512 + kb * 64, 512, 64, scr, lane);
            continue; } r -= I_D;
        if (r < I_MOD) {
            const int cc = r / 32, kc = r % 32; const float* c = P.in[1]; const float* w = P.in[2] + (size_t)(kc * 64) * 12288 + cc * 256 + lane * 4;
            f32x4 a = (f32x4){0.f, 0.f, 0.f, 0.f};
#pragma unroll 8
            for (int k = 0; k < 64; ++k) { const float cv = c[kc * 64 + k]; const float sv = cv / (1.f + __expf(-cv)); a += *(const f32x4*)(w + (size_t)k * 12288) * sv; }
            *(f32x4*)(WSP(float, WS_MODP) + (size_t)kc * 12288 + cc * 256 + lane * 4) = a;
            continue; } r -= I_MOD;
        if (r >= I_PEW) {
            const int k0 = (r - I_PEW) * 64; bf16_t* th = WSP(bf16_t, WS_WRT); bf16_t* tl = th + 80 * 2048;
#pragma unroll 4
            for (int kk = 0; kk < 64; ++kk) scr[kk * 65 + lane] = P.in[18][(size_t)(k0 + kk) * 64 + lane];
            asm volatile("s_waitcnt lgkmcnt(0)" ::: "memory");
#pragma unroll 4
            for (int n = 0; n < 64; ++n) { const float v = scr[lane * 65 + n]; const unsigned hb = f2bf(v);
                th[(size_t)(8 + n) * 2048 + k0 + lane] = (bf16_t)hb; tl[(size_t)(8 + n) * 2048 + k0 + lane] = (bf16_t)f2bf(v - __builtin_bit_cast(float, hb << 16)); }
#pragma unroll
            for (int n = 0; n < 8; ++n) { const float v = P.in[16][(size_t)(k0 + lane) * 8 + n]; const unsigned hb = f2bf(v);
                th[(size_t)n * 2048 + k0 + lane] = (bf16_t)hb; tl[(size_t)n * 2048 + k0 + lane] = (bf16_t)f2bf(v - __builtin_bit_cast(float, hb << 16));
                th[(size_t)(72 + n) * 2048 + k0 + lane] = 0; tl[(size_t)(72 + n) * 2048 + k0 + lane] = 0; }
            asm volatile("s_waitcnt lgkmcnt(0)" ::: "memory");
            continue; }
        {
            const int z = r / 32, fc = r % 32; const float* pe = P.in[7] + z * 2048 + fc * 64; const float* w = P.in[8] + (size_t)z * 2048 * 256 + (size_t)(fc * 64) * 256 + lane * 4;
            f32x4 a = (f32x4){0.f, 0.f, 0.f, 0.f};
#pragma unroll 8
            for (int k = 0; k < 64; ++k) a += *(const f32x4*)(w + (size_t)k * 256) * pe[k];
            *(f32x4*)(WSP(float, WS_PEWP) + ((size_t)z * 32 + fc) * 256 + lane * 4) = a;
        }
    }
    if (PART == 1) return;
    int* rt = WSP(int, WS_ROWTOK); int* rd = WSP(int, WS_ROWDST);
    for (int i = F.bid * NTHREADS + F.tid; i < MAXROWS; i += F.G * NTHREADS) { rt[i] = -1; rd[i] = -1; }
    { int* tk = WSP(int, WS_TOKL); for (int i = F.bid * NTHREADS + F.tid; i < 2 * BMS_MAXU * 64; i += F.G * NTHREADS) tk[i] = -1; }
}

DI void phase_ln1(Frame& F, const Params& P) {
    const int gid = F.bid * NTHREADS + F.tid;
    const float* modp = WSP(float, WS_MODP);
    if (gid < 12288) { float a = P.in[3][gid];
#pragma unroll
        for (int kc = 0; kc < 32; ++kc) a += modp[(size_t)kc * 12288 + gid];
        WSP(float, WS_MOD)[gid] = a; }
    else if (gid < 12288 + 512) { const int q = gid - 12288, z = q >> 8, col = q & 255; float a = P.in[9][q]; const float* pw = WSP(float, WS_PEWP);
#pragma unroll
        for (int fc = 0; fc < 32; ++fc) a += pw[((size_t)z * 32 + fc) * 256 + col]; WSP(float, WS_BIASC)[q] = a; }
    const int lane = F.lane;
    LAS float* lmod = (LAS float*)F.lds;
    { const int col = 4 * F.tid; f32x4 a = *(const f32x4*)(P.in[3] + col), b = *(const f32x4*)(P.in[3] + D + col);
#pragma unroll 8
      for (int kc = 0; kc < 32; ++kc) { a += *(const f32x4*)(modp + (size_t)kc * 12288 + col); b += *(const f32x4*)(modp + (size_t)kc * 12288 + D + col); }
      *(LAS f32x4*)(lmod + col) = a; *(LAS f32x4*)(lmod + 2048 + col) = b + 1.0f; }
    __syncthreads();
    f32x4 sc[8], sh[8];
#pragma unroll
    for (int j = 0; j < 8; ++j) { const int col = 4 * lane + 256 * j; sh[j] = *(const LAS f32x4*)(lmod + col); sc[j] = *(const LAS f32x4*)(lmod + 2048 + col); }
    const int gw = F.bid * NWAVES + F.wave, NGW = F.G * NWAVES;
    const float* x = P.in[0]; bf16_t* U = WSP(bf16_t, WS_U);
    for (int m = gw; m < S; m += NGW) {
        const f32x4* xr = (const f32x4*)(x + (size_t)m * D) + lane;
        f32x4 v[8]; float s = 0.f;
#pragma unroll
        for (int j = 0; j < 8; ++j) { v[j] = xr[64 * j]; s += (v[j][0] + v[j][1]) + (v[j][2] + v[j][3]); }
        const float mean = wave_sum(s) * (1.f / D); float s2 = 0.f;
#pragma unroll
        for (int j = 0; j < 8; ++j) { v[j] = v[j] - mean; s2 += (v[j][0] * v[j][0] + v[j][1] * v[j][1]) + (v[j][2] * v[j][2] + v[j][3] * v[j][3]); }
        const float rstd = 1.f / sqrtf(wave_sum(s2) * (1.f / D) + LN_EPS);
        u32x2* o8 = (u32x2*)(U + (size_t)m * D) + lane;
#pragma unroll
        for (int j = 0; j < 8; ++j) { const f32x4 y = v[j] * rstd * sc[j] + sh[j]; u32x2 w; w.x = cvtpk(y[0], y[1]); w.y = cvtpk(y[2], y[3]); o8[64 * j] = w; }
    }
}

DI f32x16 mfma32(bf16x8 a, bf16x8 b, f32x16 c) { return __builtin_amdgcn_mfma_f32_32x32x16_bf16(a, b, c, 0, 0, 0); }
DI f32x4 mfma16(bf16x8 a, bf16x8 b, f32x4 c) { return __builtin_amdgcn_mfma_f32_16x16x32_bf16(a, b, c, 0, 0, 0); }
DI int perm23(int i) { return (i & ~12) | ((i & 4) << 1) | ((i & 8) >> 1); }
DI int crow(int r, int hi) { return (r & 3) + 8 * (r >> 2) + 4 * hi; }
constexpr float NEG_INF = -__builtin_inff();

template <int CTRL> DI float dppf(float x) { return __builtin_bit_cast(float, __builtin_amdgcn_update_dpp(0, __builtin_bit_cast(int, x), CTRL, 0xF, 0xF, true)); }
template <int CTRL> DI int dppi(int x) { return __builtin_amdgcn_update_dpp(0, x, CTRL, 0xF, 0xF, true); }
DI float xmax32(float x) { auto rr = __builtin_amdgcn_permlane32_swap(__float_as_uint(x), __float_as_uint(x), false, false); return fmaxf(__uint_as_float(rr[0]), __uint_as_float(rr[1])); }
DI float xadd32(float x) { auto rr = __builtin_amdgcn_permlane32_swap(__float_as_uint(x), __float_as_uint(x), false, false); return __uint_as_float(rr[0]) + __uint_as_float(rr[1]); }
DI float xmax16(float x) { auto rr = __builtin_amdgcn_permlane16_swap(__float_as_uint(x), __float_as_uint(x), false, false); return fmaxf(__uint_as_float(rr[0]), __uint_as_float(rr[1])); }
DI float xadd16(float x) { auto rr = __builtin_amdgcn_permlane16_swap(__float_as_uint(x), __float_as_uint(x), false, false); return __uint_as_float(rr[0]) + __uint_as_float(rr[1]); }
DI float quad_sum(float x) { x += dppf<0xB1>(x); x += dppf<0x4E>(x); return x; }
DI float row_maxf(float x) { x = fmaxf(x, dppf<0xB1>(x)); x = fmaxf(x, dppf<0x4E>(x)); x = fmaxf(x, dppf<0x124>(x)); x = fmaxf(x, dppf<0x128>(x)); return x; }
DI float row_minf(float x) { x = fminf(x, dppf<0xB1>(x)); x = fminf(x, dppf<0x4E>(x)); x = fminf(x, dppf<0x124>(x)); x = fminf(x, dppf<0x128>(x)); return x; }
DI int row_mini(int x) { int y; y = dppi<0xB1>(x); x = y < x ? y : x; y = dppi<0x4E>(x); x = y < x ? y : x; y = dppi<0x124>(x); x = y < x ? y : x; y = dppi<0x128>(x); x = y < x ? y : x; return x; }
DI float rdl(float x, int l) { return __int_as_float(__builtin_amdgcn_readlane(__float_as_int(x), l)); }
DI float wave_max_u(float x) { x = row_maxf(x); const float a = rdl(x, 0), b = rdl(x, 16), c = rdl(x, 32), d = rdl(x, 48); return fmaxf(fmaxf(a, b), fmaxf(c, d)); }
DI float wave_min_u(float x) { x = row_minf(x); const float a = rdl(x, 0), b = rdl(x, 16), c = rdl(x, 32), d = rdl(x, 48); return fminf(fminf(a, b), fminf(c, d)); }
DI int wave_min_ui(int x) { x = row_mini(x); const int a = __builtin_amdgcn_readlane(x, 0), b = __builtin_amdgcn_readlane(x, 16), c = __builtin_amdgcn_readlane(x, 32), d = __builtin_amdgcn_readlane(x, 48); const int ab = a < b ? a : b, cd = c < d ? c : d; return ab < cd ? ab : cd; }

DI void phase_cmp2_scan(Frame& F, const Params& P) {
    const int lane = F.lane;
    { const float* hp = WSP(float, WS_HC); const float* w2 = P.in[10];
      for (int row = F.bid * NWAVES + F.wave; row < 4 * 1024; row += F.G * NWAVES) {
        const int zg = row >> 10, n = row & 1023, z = zg >> 1, g = zg & 1;
        f32x4 hv = *(const f32x4*)(WSP(float, WS_BIASC) + z * 256 + 4 * lane);
#pragma unroll
        for (int ks = 0; ks < 4; ++ks) hv += *(const f32x4*)(hp + ((size_t)(ks * 4 + zg) * 1024 + n) * 256 + 4 * lane);
        const float h0 = gelu_tanh(hv[0]), h1 = gelu_tanh(hv[1]), h2 = gelu_tanh(hv[2]), h3 = gelu_tanh(hv[3]);
        const float* w = w2 + (size_t)z * 256 * 64 + lane;
        float a = 0.f;
#pragma unroll 8
        for (int q = 0; q < 64; ++q) { a += rdl(h0, q) * w[(4 * q) * 64]; a += rdl(h1, q) * w[(4 * q + 1) * 64]; a += rdl(h2, q) * w[(4 * q + 2) * 64]; a += rdl(h3, q) * w[(4 * q + 3) * 64]; }
        if (z == 0) WSP(bf16_t, WS_KC)[((size_t)g * 1024 + n) * 64 + lane] = (bf16_t)f2bf(a);
        else WSP(bf16_t, WS_VCT)[(size_t)g * 64 * 1024 + ((size_t)(n >> 5) * 64 + lane) * 32 + (n & 31)] = (bf16_t)f2bf(a);
      } }
    { const int h = F.wave;
      for (int kb = F.bid; kb < S / 64; kb += F.G) {
        const u32x4* kr = (const u32x4*)(WSP(bf16_t, WS_FK) + ((size_t)h * S + kb * 64 + lane) * 64); float a = 0.f;
#pragma unroll
        for (int c = 0; c < 8; ++c) { const u32x4 wv = kr[c];
#pragma unroll
            for (int q = 0; q < 4; ++q) { const float lo = __builtin_bit_cast(float, wv[q] << 16), hi2 = __builtin_bit_cast(float, wv[q] & 0xffff0000u); a += lo * lo + hi2 * hi2; } }
        a = wave_max_u(a);
        if (lane == 0) WSP(float, WS_KMAX)[kb * 8 + h] = a;
      } }
    const int hb = F.G - 1 - F.bid;
    if (hb >= 0 && hb < 8) {
        const int h = hb; const float* lf = WSP(float, WS_LOGF); float* fc = WSP(float, WS_FC) + (size_t)h * S;
        LAS double* red = (LAS double*)F.lds;
        double loc = 0.0; const int t0 = F.tid * 32; float v[32];
#pragma unroll
        for (int i = 0; i < 32; ++i) { v[i] = lf[(size_t)(t0 + i) * 8 + h]; loc += (double)v[i]; }
        double inc = loc;
#pragma unroll
        for (int o = 1; o < 64; o <<= 1) { const double up = __shfl_up(inc, o); if (lane >= o) inc += up; }
        if (lane == 63) red[F.wave] = inc;
        __syncthreads();
        double run = inc - loc;
        for (int w = 0; w < F.wave; ++w) run += red[w];
#pragma unroll
        for (int i = 0; i < 32; ++i) { run += (double)v[i]; fc[t0 + i] = (float)run; }
        __syncthreads();
    }
}


constexpr int PSLC_LD = 272, XLD = 65, TB_LD = 132;
constexpr int AW_SEL = 512;
constexpr int AW_PSLC = 8 * PSLC_LD * 4;
constexpr int KROW = 144, VROW = 80;
constexpr int ST_K = 0, ST_V = 64 * KROW, ST_B = ST_V + 2 * 64 * VROW, ST_BYTES = ST_B + 256;
constexpr int AL_SELM = 0, AL_PSLC = NWAVES * AW_SEL, AL_STAGE = AL_PSLC + NWAVES * AW_PSLC, AL_TB = 135 * 1024, AL_FLAG = AL_TB + 2 * 4 * TB_LD * 4, AL_END = AL_FLAG + 128;
constexpr int SEL_TB = 3;
constexpr int AL_SEL2 = AL_PSLC, SEL2_BYTES = SEL_TB * ST_B;
static_assert(AL_SEL2 + 2 * SEL2_BYTES <= AL_TB && AL_STAGE + 2 * ST_BYTES <= AL_TB, "stages fit below the bias tables");
static_assert(AL_END <= LDS_MISC, "attention LDS map");

template <int SD, bool HAS_V, bool HAS_F, int TB = 1, int BASE = AL_STAGE, class Body>
DI void stream_tiles(Frame& F, const bf16_t* __restrict__ K, const bf16_t* __restrict__ Vtb, const float* __restrict__ Fk, float fref, int kv_first, int kv_step, int nt, Body&& body) {
    constexpr int STG = TB == 1 ? ST_BYTES : TB * ST_B;
    LAS unsigned char* st0 = F.lds + BASE;
    volatile LAS unsigned* flags = (volatile LAS unsigned*)(F.lds + AL_FLAG);
    const int tid = F.tid;
    const int krow = tid >> 3, kc = tid & 7;
    const int vsub = tid >> 8, vd = (tid & 255) >> 2, vc = tid & 3;
    const unsigned kdst = krow * KROW + kc * 16, vdst = ST_V + vsub * 64 * VROW + vd * VROW + vc * 16;
    const bf16_t* kbase = K + (size_t)krow * 64 + kc * 8; const bf16_t* vbase = HAS_V ? Vtb + tid * 8 : nullptr;
    u32x4 rk[SD][TB], rv[SD][TB]; float rf[SD];
#define ST_GLOAD(slot, kv0_) do { const int _kv = (kv0_); _Pragma("unroll") for (int _b = 0; _b < TB; ++_b) { rk[slot][_b] = *(const u32x4*)(kbase + (size_t)(_kv + 64 * _b) * 64); \
        if (HAS_V) rv[slot][_b] = *(const u32x4*)(vbase + (size_t)((_kv >> 5) + 2 * _b) * 2048); } if (HAS_F) { if (tid < 64) rf[slot] = Fk[_kv + tid]; } } while (0)
#define ST_LSTORE(stp, slot) do { LAS unsigned char* _st = (stp); _Pragma("unroll") for (int _b = 0; _b < TB; ++_b) { *(LAS u32x4*)(_st + _b * ST_B + kdst) = rk[slot][_b]; if (HAS_V) *(LAS u32x4*)(_st + _b * ST_B + vdst) = rv[slot][_b]; } \
        if (HAS_F) { if (tid < 64) *(LAS float*)(_st + ST_B + tid * 4) = (fref - rf[slot]) * LOG2E; } } while (0)
    if (nt <= 0) return;
    if (HAS_F) { if (tid < 16) flags[tid] = 0u; }
    ST_GLOAD(0, kv_first);
#pragma unroll
    for (int d = 1; d < SD; ++d) if (d < nt) ST_GLOAD(d, kv_first + d * kv_step);
    ST_LSTORE(st0, 0);
    if (SD < nt) ST_GLOAD(0, kv_first + SD * kv_step);
    __syncthreads();
    bool stop = false;
    for (int it0 = 0; it0 < nt && !stop; it0 += SD) {
#pragma unroll
        for (int d = 0; d < SD; ++d) {
            const int it = it0 + d;
            if (it >= nt || stop) break;
            const int par = (SD % 2 == 0) ? (d & 1) : (it & 1);
            __builtin_amdgcn_sched_barrier(0);
            const bool done = body(kv_first + it * kv_step, st0 + par * STG);
            __builtin_amdgcn_sched_barrier(0);
            if (it + 1 < nt) { ST_LSTORE(st0 + (par ^ 1) * STG, (d + 1) % SD); if (it + 1 + SD < nt) ST_GLOAD((d + 1) % SD, kv_first + (it + 1 + SD) * kv_step); }
            if constexpr (HAS_F) { if (F.lane == 0) flags[par * 8 + F.wave] = done ? 1u : 0u; } else { (void)done; }
            __syncthreads();
            if constexpr (HAS_F) {
                const u32x4 fa = *(volatile LAS u32x4*)(F.lds + AL_FLAG + par * 32), fb = *(volatile LAS u32x4*)(F.lds + AL_FLAG + par * 32 + 16);
                if ((fa[0] & fa[1] & fa[2] & fa[3] & fb[0] & fb[1] & fb[2] & fb[3]) != 0u) stop = true; }
        }
    }
    asm volatile("s_waitcnt vmcnt(0)" ::: "memory");
    __syncthreads();
#undef ST_GLOAD
#undef ST_LSTORE
}

DI void lds_k(bf16x8 (&kf)[4], const LAS unsigned char* st, int sub, int lane) {
    const LAS unsigned char* p = st + ST_K + (32 * sub + perm23(lane & 31)) * KROW + 16 * (lane >> 5);
#pragma unroll
    for (int ks = 0; ks < 4; ++ks) kf[ks] = *(const LAS bf16x8*)(p + 32 * ks);
}
DI void lds_v(bf16x8 (&vf)[4], const LAS unsigned char* st, int sub, int lane) {
    const LAS unsigned char* p = st + ST_V + sub * 64 * VROW + (lane & 31) * VROW + 16 * (lane >> 5);
#pragma unroll
    for (int d0 = 0; d0 < 2; ++d0)
#pragma unroll
        for (int s2 = 0; s2 < 2; ++s2) vf[d0 * 2 + s2] = *(const LAS bf16x8*)(p + d0 * 32 * VROW + 32 * s2);
}
DI f32x16 qk32f(const bf16x8 (&qf)[4], const bf16x8 (&kf)[4]) {
    f32x16 s;
#pragma unroll
    for (int r = 0; r < 16; ++r) s[r] = 0.f;
#pragma unroll
    for (int ks = 0; ks < 4; ++ks) s = mfma32(kf[ks], qf[ks], s);
    return s;
}
DI void pv32f(f32x16 (&o)[2], const f32x16& p, const bf16x8 (&vf)[4]) {
    bf16x8 pf[2];
#pragma unroll
    for (int s2 = 0; s2 < 2; ++s2) { u32x4 w; w.x = cvtpk(p[8 * s2 + 0], p[8 * s2 + 1]); w.y = cvtpk(p[8 * s2 + 2], p[8 * s2 + 3]); w.z = cvtpk(p[8 * s2 + 4], p[8 * s2 + 5]); w.w = cvtpk(p[8 * s2 + 6], p[8 * s2 + 7]); pf[s2] = __builtin_bit_cast(bf16x8, w); }
#pragma unroll
    for (int d0 = 0; d0 < 2; ++d0)
#pragma unroll
        for (int s2 = 0; s2 < 2; ++s2) o[d0] = mfma32(vf[d0 * 2 + s2], pf[s2], o[d0]);
}
DI float max16(const f32x16& s) {
    float mx = fmaxf(fmaxf(s[0], s[1]), fmaxf(s[2], s[3]));
#pragma unroll
    for (int r = 4; r < 16; r += 4) mx = fmaxf(mx, fmaxf(fmaxf(s[r], s[r + 1]), fmaxf(s[r + 2], s[r + 3])));
    return mx;
}
DI float online_upd(float mx, float& m, float& l, float& mu_out) {
    mx = xmax32(mx);
    const float mn = fmaxf(m, mx), mu = (mn == NEG_INF) ? 0.f : mn;
    const float alpha = fexp2(m - mu);
    l *= alpha; m = mn; mu_out = mu;
    return alpha;
}
DI void exp16(f32x16& s, float mu, float& l) {
    float ps = 0.f;
#pragma unroll
    for (int r = 0; r < 16; ++r) { s[r] = fexp2(s[r] - mu); ps += s[r]; }
    l += ps;
}

DI void fox_task(Frame& F, int h, int qb) {
    const int lane = F.lane, i = lane & 31, hi = lane >> 5, w = F.wave;
    const bf16_t* Q = WSP(bf16_t, WS_FQ) + (size_t)h * S * 64;
    const bf16_t* K = WSP(bf16_t, WS_FK) + (size_t)h * S * 64;
    const bf16_t* Vt = WSP(bf16_t, WS_FVT) + (size_t)h * 64 * S;
    const float* Fc = WSP(float, WS_FC) + (size_t)h * S;
    const int q0 = qb * 256, r0 = q0 + 32 * w, t = r0 + i;
    bf16x8 qf[4];
#pragma unroll
    for (int ks = 0; ks < 4; ++ks) qf[ks] = *(const bf16x8*)(Q + (size_t)t * 64 + 16 * ks + 8 * hi);
    asm volatile("" : "+v"(qf[0]), "+v"(qf[1]), "+v"(qf[2]), "+v"(qf[3]));
    const float fref = Fc[q0];
    float qn2 = 0.f;
#pragma unroll
    for (int ks = 0; ks < 4; ++ks)
#pragma unroll
        for (int j = 0; j < 8; ++j) { const float qv = bf2f((bf16_t)qf[ks][j]); qn2 += qv * qv; }
    qn2 = xadd32(qn2);
    float km2 = 0.f; { const float* kp = WSP(float, WS_KMAX) + h;
#pragma unroll
      for (int c = 0; c < 4; ++c) km2 = fmaxf(km2, kp[(lane + 64 * c) * 8]); }
    const float qkb = sqrtf(wave_max_u(qn2) * wave_max_u(km2)) * 1.01f;
    float m = NEG_INF, l = 0.f; f32x16 o[2];
#pragma unroll
    for (int r = 0; r < 16; ++r) { o[0][r] = 0.f; o[1][r] = 0.f; }
    constexpr float FOX_SKIP = 44.f;
    bool wdone = false;
    stream_tiles<4, true, true>(F, K, Vt, Fc, fref, q0 + 192, -64, qb * 4 + 4, [&](int kv0, const LAS unsigned char* st) __attribute__((always_inline)) -> bool {
        if (wdone) return true;
        if (kv0 > r0) return false;
        const bool two = (kv0 + 32 <= r0);
        bf16x8 kf[4]; f32x16 s0, s1;
        lds_k(kf, st, 0, lane); s0 = qk32f(qf, kf);
        { const LAS float* bp = (const LAS float*)(st + ST_B) + 8 * hi; const f32x4 b0 = *(const LAS f32x4*)(bp), b1 = *(const LAS f32x4*)(bp + 4), b2 = *(const LAS f32x4*)(bp + 16), b3 = *(const LAS f32x4*)(bp + 20);
#pragma unroll
          for (int r = 0; r < 16; ++r) s0[r] += (r < 4) ? b0[r & 3] : (r < 8) ? b1[r & 3] : (r < 12) ? b2[r & 3] : b3[r & 3]; }
        if (kv0 == r0) {
#pragma unroll
            for (int r = 0; r < 16; ++r) { const int key = kv0 + 16 * (r >> 3) + 8 * hi + (r & 7); s0[r] = (key <= t) ? s0[r] : NEG_INF; } }
        float mx = max16(s0);
        if (two) {
            lds_k(kf, st, 1, lane); s1 = qk32f(qf, kf);
            const LAS float* bp = (const LAS float*)(st + ST_B) + 32 + 8 * hi; const f32x4 b0 = *(const LAS f32x4*)(bp), b1 = *(const LAS f32x4*)(bp + 4), b2 = *(const LAS f32x4*)(bp + 16), b3 = *(const LAS f32x4*)(bp + 20);
#pragma unroll
            for (int r = 0; r < 16; ++r) s1[r] += (r < 4) ? b0[r & 3] : (r < 8) ? b1[r & 3] : (r < 12) ? b2[r & 3] : b3[r & 3];
            if (kv0 + 32 == r0) {
#pragma unroll
                for (int r = 0; r < 16; ++r) { const int key = kv0 + 32 + 16 * (r >> 3) + 8 * hi + (r & 7); s1[r] = (key <= t) ? s1[r] : NEG_INF; } }
            mx = fmaxf(mx, max16(s1));
        }
        float mu; const float alpha = online_upd(mx, m, l, mu);
        o[0] *= alpha; o[1] *= alpha;
        bf16x8 vf[4];
        exp16(s0, mu, l); lds_v(vf, st, 0, lane); pv32f(o, s0, vf);
        if (two) { exp16(s1, mu, l); lds_v(vf, st, 1, lane); pv32f(o, s1, vf); }
        const float b_first = *((const LAS float*)(st + ST_B));
        wdone = (qkb + b_first < wave_min_u(m) - FOX_SKIP);
        return wdone;
    });
    l = xadd32(l);
    const float inv = l > 0.f ? 1.f / l : 0.f;
    bf16_t* O = WSP(bf16_t, WS_O) + (size_t)t * 1024 + 512 + h * 64;
#pragma unroll
    for (int d0 = 0; d0 < 2; ++d0)
#pragma unroll
        for (int g4 = 0; g4 < 4; ++g4) { u32x2 wv; wv.x = cvtpk(o[d0][4 * g4] * inv, o[d0][4 * g4 + 1] * inv); wv.y = cvtpk(o[d0][4 * g4 + 2] * inv, o[d0][4 * g4 + 3] * inv);
            *(u32x2*)(O + 32 * d0 + 8 * g4 + 4 * hi) = wv; }
}

DI void t5_near(f32x16& s, const LAS float* tb, int dbase, int kstride, int key0, int hi, int dmax) {
#pragma unroll
    for (int r = 0; r < 16; ++r) { const int key = key0 + 16 * (r >> 3) + 8 * hi + (r & 7); const int dist = dbase - kstride * key;
        const int idx = dist < 0 ? 0 : (dist < 128 ? dist : 128); const float bv = tb[idx];
        s[r] = (dist >= 0 && dist < dmax) ? s[r] + bv : NEG_INF; }
}

DI void nsa_task(Frame& F, int g, int tg0, LAS float* pslc, LAS unsigned* selm, const LAS float* tbg) {
    const int lane = F.lane, i = lane & 31, hi = lane >> 5, tl = i >> 2, hh = i & 3, t0 = tg0 + 8 * F.wave, t = t0 + tl;
    const bf16_t* Q = WSP(bf16_t, WS_QN) + (size_t)(g * 4 + hh) * S * 64 + (size_t)t * 64;
    const bf16_t* Kc = WSP(bf16_t, WS_KC) + (size_t)g * 1024 * 64; const bf16_t* VcT = WSP(bf16_t, WS_VCT) + (size_t)g * 64 * 1024;
    const LAS float* tb = tbg + hh * TB_LD;
    const float tbfar = tb[128];
    bf16x8 qf[4];
#pragma unroll
    for (int ks = 0; ks < 4; ++ks) qf[ks] = *(const bf16x8*)(Q + 16 * ks + 8 * hi);
    asm volatile("" : "+v"(qf[0]), "+v"(qf[1]), "+v"(qf[2]), "+v"(qf[3]));
    const float* gn = WSP(float, WS_GN) + (size_t)t * 24 + g * 12 + hh * 3;
    const float g0 = gn[0], g2 = gn[2];
    const int tmax = t0 + 7;
    const int nt_c = (((tg0 + 63 - 31) >> 4) >> 6) + 1;
    float m = NEG_INF, l = 0.f;
    stream_tiles<2, false, false>(F, Kc, nullptr, nullptr, 0.f, 0, 64, nt_c, [&](int n0, const LAS unsigned char* st) __attribute__((always_inline)) -> bool {
#pragma unroll
        for (int sub = 0; sub < 2; ++sub) { const int ns = n0 + 32 * sub;
            if (16 * ns + 31 > tmax) continue;
            bf16x8 kf[4]; lds_k(kf, st, sub, lane); f32x16 s = qk32f(qf, kf);
            if (t0 - 16 * (ns + 31) - 31 >= 128) {
#pragma unroll
                for (int r = 0; r < 16; ++r) s[r] += tbfar; }
            else t5_near(s, tb, t - 31, 16, ns, hi, 1 << 30);
            float mu; (void)online_upd(max16(s), m, l, mu); exp16(s, mu, l);
        }
        return false; });
    l = xadd32(l);
    const float invl = l > 0.f ? 1.f / l : 0.f, mu = (m == NEG_INF) ? 0.f : m;
    float carry = 0.f;
    f32x16 oc[2];
#pragma unroll
    for (int r = 0; r < 16; ++r) { oc[0][r] = 0.f; oc[1][r] = 0.f; }
    stream_tiles<2, true, false>(F, Kc, VcT, nullptr, 0.f, 0, 64, nt_c, [&](int n0, const LAS unsigned char* st) __attribute__((always_inline)) -> bool {
#pragma unroll
        for (int sub = 0; sub < 2; ++sub) { const int ns = n0 + 32 * sub;
            if (16 * ns + 31 > tmax) continue;
            bf16x8 kf[4]; lds_k(kf, st, sub, lane); f32x16 s = qk32f(qf, kf);
            if (t0 - 16 * (ns + 31) - 31 >= 128) {
#pragma unroll
                for (int r = 0; r < 16; ++r) s[r] += tbfar; }
            else t5_near(s, tb, t - 31, 16, ns, hi, 1 << 30);
#pragma unroll
            for (int r = 0; r < 16; ++r) s[r] = fexp2(s[r] - mu) * invl;
            bf16x8 vf[4]; lds_v(vf, st, sub, lane); pv32f(oc, s, vf);
            { float a[4], b[4];
#pragma unroll
              for (int G4 = 0; G4 < 4; ++G4) { a[G4] = quad_sum(s[4 * G4] + s[4 * G4 + 1] + s[4 * G4 + 2] + 0.5f * s[4 * G4 + 3]); b[G4] = quad_sum(0.5f * s[4 * G4 + 3]); }
              const auto r1 = __builtin_amdgcn_permlane32_swap(__float_as_uint(b[1]), __float_as_uint(b[1]), false, false), r3 = __builtin_amdgcn_permlane32_swap(__float_as_uint(b[3]), __float_as_uint(b[3]), false, false);
              const float x1 = __uint_as_float(hi ? r1[0] : r1[1]), x3 = __uint_as_float(hi ? r3[0] : r3[1]);
              if (hh == 0) { LAS float* pr = pslc + tl * PSLC_LD + (ns >> 2) + 2 * hi;
                  pr[0] = a[0] + (hi ? x1 : carry); pr[1] = a[1] + b[0]; pr[4] = a[2] + (hi ? x3 : x1); pr[5] = a[3] + b[2]; }
              carry = x3; }
        }
        return false; });
    asm volatile("s_waitcnt lgkmcnt(0)" ::: "memory"); __builtin_amdgcn_wave_barrier();
    { const int cur = t0 >> 6;
      if (cur <= 15) { if (lane < 64) selm[lane] = ((lane & 7) == 0) ? ((2u << cur) - 1u) : 0u; }
      else {
#pragma unroll 1
        for (int k8 = 0; k8 < 8; ++k8) {
            float v[4];
#pragma unroll
            for (int k = 0; k < 4; ++k) { const int j = lane + 64 * k; v[k] = (j >= 1 && j <= cur - 2) ? pslc[k8 * PSLC_LD + j] : -1.f; }
            unsigned tb_ = 0u;
#pragma unroll 1
            for (int bit = 30; bit >= 0; --bit) { const float th = __uint_as_float(tb_ | (1u << bit));
                const int c = __builtin_popcountll(__ballot(v[0] >= th)) + __builtin_popcountll(__ballot(v[1] >= th)) + __builtin_popcountll(__ballot(v[2] >= th)) + __builtin_popcountll(__ballot(v[3] >= th));
                if (c >= 13) tb_ |= (1u << bit);
                if (c == 13) break; }
            const float T = __uint_as_float(tb_);
            unsigned long long sel[4]; int ngt = 0;
#pragma unroll
            for (int k = 0; k < 4; ++k) { sel[k] = __ballot(v[k] > T); ngt += __builtin_popcountll(sel[k]); }
            int need = 13 - ngt;
#pragma unroll
            for (int k = 0; k < 4; ++k) { unsigned long long eq = __ballot(v[k] == T); while (need > 0 && eq) { const unsigned long long low = eq & (0ull - eq); sel[k] |= low; eq ^= low; --need; } }
            unsigned mk[8];
#pragma unroll
            for (int k = 0; k < 4; ++k) { mk[2 * k] = (unsigned)sel[k]; mk[2 * k + 1] = (unsigned)(sel[k] >> 32); }
#pragma unroll
            for (int w = 0; w < 8; ++w) { if (w == 0) mk[w] |= 1u; if ((cur >> 5) == w) mk[w] |= 1u << (cur & 31); if (((cur - 1) >> 5) == w) mk[w] |= 1u << ((cur - 1) & 31); }
#pragma unroll
            for (int w = 0; w < 8; ++w) if (lane == w) selm[k8 * 8 + w] = mk[w];
        } } }
    asm volatile("s_waitcnt lgkmcnt(0)" ::: "memory"); __builtin_amdgcn_wave_barrier();
    const bf16_t* Sk = WSP(bf16_t, WS_SK) + (size_t)g * S * 64; const bf16_t* SvT = WSP(bf16_t, WS_SVT) + (size_t)g * 64 * S;
    const int n16 = lane & 15, kq = lane >> 4;
    LAS float* xch = pslc;
    float* XG = WSP(float, WS_U) + (size_t)t * 512 + g * 256 + hh * 64;
#pragma unroll
    for (int d0 = 0; d0 < 2; ++d0)
#pragma unroll
        for (int g4 = 0; g4 < 4; ++g4) *(f32x4*)(XG + 32 * d0 + 8 * g4 + 4 * hi) = (f32x4){g0 * oc[d0][4 * g4], g0 * oc[d0][4 * g4 + 1], g0 * oc[d0][4 * g4 + 2], g0 * oc[d0][4 * g4 + 3]};
    const bf16_t* Wk = WSP(bf16_t, WS_WK) + (size_t)g * S * 64; const bf16_t* WvT = WSP(bf16_t, WS_WVT) + (size_t)g * 64 * S;
    float mw = NEG_INF, lw = 0.f; f32x16 ow[2];
#pragma unroll
    for (int r = 0; r < 16; ++r) { ow[0][r] = 0.f; ow[1][r] = 0.f; }
    { const int lo = tg0 - 511 > 0 ? tg0 - 511 : 0; const int kvs = lo & ~63; const int nt_w = ((tg0 - kvs) >> 6) + 1;
      if (!(NSAP & 2)) stream_tiles<2, true, false>(F, Wk, WvT, nullptr, 0.f, kvs, 64, nt_w, [&](int kv0, const LAS unsigned char* st) __attribute__((always_inline)) -> bool {
#pragma unroll
        for (int sub = 0; sub < 2; ++sub) { const int ks0 = kv0 + 32 * sub;
            if (!((ks0 <= tmax) && (t0 - (ks0 + 31) < 512))) continue;
            __builtin_amdgcn_sched_barrier(0);
            bf16x8 kf[4]; lds_k(kf, st, sub, lane); f32x16 sw = qk32f(qf, kf);
            if (t0 - ks0 - 31 >= 128 && tmax - ks0 < 512) {
#pragma unroll
                for (int r = 0; r < 16; ++r) sw[r] += tbfar; }
            else t5_near(sw, tb, t, 1, ks0, hi, 512);
            float mu2; const float alpha = online_upd(max16(sw), mw, lw, mu2);
            ow[0] *= alpha; ow[1] *= alpha;
            exp16(sw, mu2, lw); bf16x8 vf[4]; lds_v(vf, st, sub, lane); pv32f(ow, sw, vf);
            __builtin_amdgcn_sched_barrier(0);
        }
        return false; }); }
    lw = xadd32(lw);
    { const float invw = lw > 0.f ? g2 / lw : 0.f;
      asm volatile("s_waitcnt vmcnt(0)" ::: "memory");
#pragma unroll
      for (int d0 = 0; d0 < 2; ++d0)
#pragma unroll
        for (int g4 = 0; g4 < 4; ++g4) { f32x4 v = *(const f32x4*)(XG + 32 * d0 + 8 * g4 + 4 * hi);
            v[0] += invw * ow[d0][4 * g4]; v[1] += invw * ow[d0][4 * g4 + 1]; v[2] += invw * ow[d0][4 * g4 + 2]; v[3] += invw * ow[d0][4 * g4 + 3];
            *(f32x4*)(XG + 32 * d0 + 8 * g4 + 4 * hi) = v; } }
#if BMS
    { unsigned* SG = WSP(unsigned, WS_SELMG);
      SG[((size_t)(t0 + (lane >> 3)) * 2 + g) * 8 + (lane & 7)] = selm[lane];
      if (F.tid < 256) { const int j = F.tid; int c = 0;
#pragma unroll
          for (int w8 = 0; w8 < 8; ++w8) { const LAS unsigned* sw = (const LAS unsigned*)(F.lds + AL_SELM + w8 * AW_SEL);
#pragma unroll
              for (int k8 = 0; k8 < 8; ++k8) c += (int)((sw[k8 * 8 + (j >> 5)] >> (j & 31)) & 1u); }
          WSP(int, WS_HISTB)[((size_t)g * 256 + (tg0 >> 6)) * 256 + j] = c; } }
}

#else
    {
        LAS unsigned* um = selm + 64;
        if (lane < 16) { const int qd = lane >> 3, w = lane & 7; um[lane] = selm[(4 * qd + 0) * 8 + w] | selm[(4 * qd + 1) * 8 + w] | selm[(4 * qd + 2) * 8 + w] | selm[(4 * qd + 3) * 8 + w]; }
        asm volatile("s_waitcnt lgkmcnt(0)" ::: "memory"); __builtin_amdgcn_wave_barrier();
        const int hq = n16 & 3;
        const LAS float* tb2 = tbg + hq * TB_LD; const float tbfar2 = tb2[128];
        bf16x8 q2[2][2]; float m2[2], l2[2], gs[2]; f32x4 o2[2][4];
#pragma unroll
        for (int qd = 0; qd < 2; ++qd) { const int ts = t0 + 4 * qd + (n16 >> 2);
            const bf16_t* Q2 = WSP(bf16_t, WS_QN) + (size_t)(g * 4 + hq) * S * 64 + (size_t)ts * 64;
            q2[qd][0] = *(const bf16x8*)(Q2 + 8 * kq); q2[qd][1] = *(const bf16x8*)(Q2 + 32 + 8 * kq);
            asm volatile("" : "+v"(q2[qd][0]), "+v"(q2[qd][1]));
            gs[qd] = WSP(float, WS_GN)[(size_t)ts * 24 + g * 12 + hq * 3 + 1];
            m2[qd] = NEG_INF; l2[qd] = 0.f;
#pragma unroll
            for (int dt = 0; dt < 4; ++dt) o2[qd][dt] = (f32x4){0.f, 0.f, 0.f, 0.f}; }
        const unsigned kfo = ST_K + (8 * (n16 >> 2) + (n16 & 3)) * KROW + 16 * kq, vfo = ST_V + n16 * VROW + 16 * kq;
        unsigned umw[2] = {0u, 0u}, ownw[2] = {0u, 0u};
        if (!(NSAP & 1)) stream_tiles<1, true, false, SEL_TB, AL_SEL2>(F, Sk, SvT, nullptr, 0.f, 0, 64 * SEL_TB, ((tg0 >> 6) + SEL_TB) / SEL_TB, [&](int kvt, const LAS unsigned char* stt) __attribute__((always_inline)) -> bool {
#pragma unroll 1
          for (int bb = 0; bb < SEL_TB; ++bb) { const int kv0 = kvt + 64 * bb; const LAS unsigned char* st = stt + bb * ST_B;
            const int j = kv0 >> 6;
            if (j > (tg0 >> 6)) break;
            if ((j & 31) == 0) {
#pragma unroll
                for (int qd = 0; qd < 2; ++qd) { umw[qd] = __builtin_amdgcn_readfirstlane(um[qd * 8 + (j >> 5)]); ownw[qd] = selm[(4 * qd + (n16 >> 2)) * 8 + (j >> 5)]; } }
#pragma unroll
            for (int qd = 0; qd < 2; ++qd) {
                __builtin_amdgcn_sched_barrier(0);
                if (!((umw[qd] >> (j & 31)) & 1u)) continue;
                const int tq = 4 * qd + (n16 >> 2), ts = t0 + tq, tsmin = t0 + 4 * qd;
                const bool selok = (ownw[qd] >> (j & 31)) & 1u;
                f32x4 sc[2][2];
#pragma unroll
                for (int gq = 0; gq < 2; ++gq)
#pragma unroll
                    for (int ab = 0; ab < 2; ++ab) { const LAS unsigned char* kp = st + kfo + (32 * gq + 4 * ab) * KROW;
                        f32x4 a = (f32x4){0.f, 0.f, 0.f, 0.f}; a = mfma16(*(const LAS bf16x8*)(kp), q2[qd][0], a); a = mfma16(*(const LAS bf16x8*)(kp + 64), q2[qd][1], a); sc[gq][ab] = a; }
                float mx = NEG_INF;
                if (tsmin - (kv0 + 63) >= 128) {
                    const float add = selok ? tbfar2 : NEG_INF;
#pragma unroll
                    for (int gq = 0; gq < 2; ++gq)
#pragma unroll
                        for (int ab = 0; ab < 2; ++ab)
#pragma unroll
                            for (int r = 0; r < 4; ++r) { const float v = sc[gq][ab][r] + add; sc[gq][ab][r] = v; mx = fmaxf(mx, v); }
                } else {
#pragma unroll
                    for (int gq = 0; gq < 2; ++gq)
#pragma unroll
                        for (int ab = 0; ab < 2; ++ab)
#pragma unroll
                            for (int r = 0; r < 4; ++r) { const int key = kv0 + 32 * gq + 8 * kq + 4 * ab + r; const int dist = ts - key;
                                const int idx = dist < 0 ? 0 : (dist < 128 ? dist : 128); const float bv = tb2[idx];
                                const float v = (selok && dist >= 0) ? sc[gq][ab][r] + bv : NEG_INF; sc[gq][ab][r] = v; mx = fmaxf(mx, v); }
                }
                mx = xmax16(mx); mx = xmax32(mx);
                const float mn = fmaxf(m2[qd], mx), mu2 = (mn == NEG_INF) ? 0.f : mn; const float alpha = fexp2(m2[qd] - mu2);
                float ps = 0.f;
#pragma unroll
                for (int gq = 0; gq < 2; ++gq)
#pragma unroll
                    for (int ab = 0; ab < 2; ++ab)
#pragma unroll
                        for (int r = 0; r < 4; ++r) { const float p = fexp2(sc[gq][ab][r] - mu2); sc[gq][ab][r] = p; ps += p; }
                l2[qd] = l2[qd] * alpha + ps; m2[qd] = mn;
#pragma unroll
                for (int dt = 0; dt < 4; ++dt) o2[qd][dt] *= alpha;
#pragma unroll
                for (int gq = 0; gq < 2; ++gq) {
                    u32x4 pw; pw.x = cvtpk(sc[gq][0][0], sc[gq][0][1]); pw.y = cvtpk(sc[gq][0][2], sc[gq][0][3]); pw.z = cvtpk(sc[gq][1][0], sc[gq][1][1]); pw.w = cvtpk(sc[gq][1][2], sc[gq][1][3]);
                    const bf16x8 pf = __builtin_bit_cast(bf16x8, pw);
#pragma unroll
                    for (int dt = 0; dt < 4; ++dt) o2[qd][dt] = mfma16(*(const LAS bf16x8*)(st + vfo + gq * 64 * VROW + 16 * dt * VROW), pf, o2[qd][dt]);
                }
            }
          }
            return false; });
#pragma unroll
        for (int qd = 0; qd < 2; ++qd) {
            float lt = xadd16(l2[qd]); lt = xadd32(lt);
            const float inv2 = lt > 0.f ? gs[qd] / lt : 0.f;
#pragma unroll
            for (int dt = 0; dt < 4; ++dt)
#pragma unroll
                for (int r = 0; r < 4; ++r) xch[(16 * qd + n16) * XLD + 16 * dt + 4 * kq + r] = inv2 * o2[qd][dt][r];
        }
        asm volatile("s_waitcnt lgkmcnt(0)" ::: "memory"); __builtin_amdgcn_wave_barrier();
    }
    { bf16_t* O = WSP(bf16_t, WS_O) + (size_t)t * 1024 + g * 256 + hh * 64;
#pragma unroll
      for (int d0 = 0; d0 < 2; ++d0)
#pragma unroll
        for (int g4 = 0; g4 < 4; ++g4) { const f32x4 a = *(const f32x4*)(XG + 32 * d0 + 8 * g4 + 4 * hi); float v[4];
#pragma unroll
            for (int q = 0; q < 4; ++q) v[q] = a[q] + xch[i * XLD + 32 * d0 + 8 * g4 + 4 * hi + q];
            u32x2 wv; wv.x = cvtpk(v[0], v[1]); wv.y = cvtpk(v[2], v[3]); *(u32x2*)(O + 32 * d0 + 8 * g4 + 4 * hi) = wv; } }
    asm volatile("s_waitcnt lgkmcnt(0)" ::: "memory"); __builtin_amdgcn_wave_barrier();
}

#endif
constexpr int NT_FOX = 8 * 64, NT_NSA = 2 * 256, NT_ATT = NT_FOX + NT_NSA;
DI void phase_attn(Frame& F, const Params& P, int rep) {
    LAS float* tball = (LAS float*)(F.lds + AL_TB);
    for (int q = F.tid; q < 2 * 4 * 129; q += NTHREADS) { const int dist = q % 129, gh = q / 129;
        int bucket; if (dist < 16) bucket = dist; else { const float rr = logf((float)dist / 16.f) / 2.0794415416798357f * 16.f; const int big = 16 + (int)rr; bucket = big < 31 ? big : 31; }
        tball[gh * TB_LD + dist] = P.in[6][bucket * 8 + gh] * LOG2E; }
    LAS float* pslc = (LAS float*)(F.lds + AL_PSLC + F.wave * AW_PSLC); LAS unsigned* selm = (LAS unsigned*)(F.lds + AL_SELM + F.wave * AW_SEL);
    volatile LAS int* tslot = (volatile LAS int*)(F.lds + AL_FLAG + 64);
    bool first = true;
    for (;;) {
        __syncthreads();
        if (F.tid == 0) *tslot = first ? F.bid : F.G + (int)atomicAdd(F.ctl + CW_QATT + 64 * rep, 1u);
        first = false;
        __syncthreads();
        const int task = __builtin_amdgcn_readfirstlane(*tslot);
        if (task >= (BMS ? NT_NSA : NT_ATT)) break;
        if (task < NT_NSA) { const int g = task & 1, tt = 255 - (task >> 1); nsa_task(F, g, tt * 64, pslc, selm, tball + g * 4 * TB_LD); }
        else { const int q = task - NT_NSA; fox_task(F, 7 - (q >> 6), 63 - (q & 63)); }
    }
}

#if BMS
DI void phase_bms_sort(Frame& F, const Params& P) {
    LAS unsigned* masks = (LAS unsigned*)F.lds;
    LAS int* pw = (LAS int*)(F.lds + 2048);
    LAS int* wsum = (LAS int*)(F.lds + 4096);
    const int* hist = WSP(int, WS_HISTB);
    for (int item = F.bid; item < 512; item += F.G) { const int g = item >> 8, T = item & 255;
        __syncthreads();
        masks[F.tid] = WSP(unsigned, WS_SELMG)[((size_t)(T * 64 + (F.tid >> 3)) * 2 + g) * 8 + (F.tid & 7)];
        int tot = 0, off = 0;
        { const int j = F.tid & 255, b0 = (F.tid >> 8) * 128; const int* hc = hist + (size_t)g * 256 * 256 + (size_t)b0 * 256 + j;
#pragma unroll 32
          for (int b = 0; b < 128; ++b) { const int hv = hc[b * 256]; tot += hv; off += (b0 + b < T) ? hv : 0; }
          LAS int* psum = (LAS int*)(F.lds + 8192);
          if (F.tid >= 256) { psum[j] = tot; psum[256 + j] = off; tot = 0; off = 0; }
          __syncthreads();
          if (F.tid < 256) { tot += psum[j]; off += psum[256 + j]; } }
        const int nu = (tot + 63) >> 6; int inc = nu;
#pragma unroll
        for (int o = 1; o < 64; o <<= 1) { const int up = __shfl_up(inc, o); if (F.lane >= o) inc += up; }
        if (F.lane == 63 && F.wave < 4) wsum[F.wave] = inc;
        __syncthreads();
        { const int tok = F.tid >> 3, w = F.tid & 7; int c = 0;
#pragma unroll
          for (int q = 0; q < 8; ++q) c += (q < w) ? __builtin_popcount(masks[tok * 8 + q]) : 0;
          pw[F.tid] = c; }
        const int w0 = wsum[0], w1 = wsum[1], w2 = wsum[2], w3 = wsum[3];
        const int ub_ = inc - nu + (F.wave > 0 ? w0 : 0) + (F.wave > 1 ? w1 : 0) + (F.wave > 2 ? w2 : 0);
        __syncthreads();
        if (F.tid < 256) { const int j = F.tid;
            if (T == 0) { int* ut = WSP(int, WS_UT) + g * (BMS_MAXU + 8); if (j == 0) ut[0] = w0 + w1 + w2 + w3; for (int c = 0; c < nu; ++c) ut[1 + ub_ + c] = j | (c << 16); }
            int* tk = WSP(int, WS_TOKL) + (size_t)g * BMS_MAXU * 64 + (size_t)ub_ * 64 + off; int run = 0;
            const unsigned bitm = 1u << (j & 31), lowm = bitm - 1u;
            for (int tok = 0; tok < 64; ++tok) { const unsigned wv = masks[tok * 8 + (j >> 5)];
                if (wv & bitm) { const int slot = pw[tok * 8 + (j >> 5)] + __builtin_popcount(wv & lowm); tk[run] = (T * 64 + tok) | (slot << 16); ++run; } } }
    }
    __syncthreads();
}

DI void lds_v_T(bf16x8 (&vf)[4], const LAS unsigned char* st, int sub, int lane) {
    const LAS unsigned char* p = st + ST_V + sub * 64 * VROW + 2 * (lane & 31) * VROW + 16 * (lane >> 5);
#pragma unroll
    for (int d0 = 0; d0 < 2; ++d0)
#pragma unroll
        for (int s2 = 0; s2 < 2; ++s2) vf[d0 * 2 + s2] = *(const LAS bf16x8*)(p + d0 * VROW + 32 * s2);
}
DI void pv32f_T(f32x16 (&o)[2], const f32x16& p, const bf16x8 (&vf)[4]) {
    bf16x8 pf[2];
#pragma unroll
    for (int s2 = 0; s2 < 2; ++s2) { u32x4 w; w.x = cvtpk(p[8 * s2 + 0], p[8 * s2 + 1]); w.y = cvtpk(p[8 * s2 + 2], p[8 * s2 + 3]); w.z = cvtpk(p[8 * s2 + 4], p[8 * s2 + 5]); w.w = cvtpk(p[8 * s2 + 6], p[8 * s2 + 7]); pf[s2] = __builtin_bit_cast(bf16x8, w); }
#pragma unroll
    for (int d0 = 0; d0 < 2; ++d0)
#pragma unroll
        for (int s2 = 0; s2 < 2; ++s2) o[d0] = mfma32(pf[s2], vf[d0 * 2 + s2], o[d0]);
}
constexpr int BMS_WGU = 36;
constexpr int BL_CODE = 0, BL_ENT = 256;
static_assert(BL_ENT + BMS_WGU * 256 <= AL_STAGE && 2 * BMS_MAXU <= 256 * (BMS_WGU - 2), "block-major unit lists");
DI void phase_bms_attn(Frame& F, const Params& P) {
    const int lane = F.lane, i = lane & 31, hi = lane >> 5, tl = i >> 2, hh = i & 3;
    LAS float* tball = (LAS float*)(F.lds + AL_TB);
    LAS int* lcode = (LAS int*)(F.lds + BL_CODE); LAS int* lent = (LAS int*)(F.lds + BL_ENT);
    __syncthreads();
    for (int q = F.tid; q < 2 * 4 * 129; q += NTHREADS) { const int dist = q % 129, gh = q / 129;
        int bucket; if (dist < 16) bucket = dist; else { const float rr = logf((float)dist / 16.f) / 2.0794415416798357f * 16.f; const int big = 16 + (int)rr; bucket = big < 31 ? big : 31; }
        tball[gh * TB_LD + dist] = P.in[6][bucket * 8 + gh] * LOG2E; }
    const int* ut = WSP(int, WS_UT); const int U0 = ut[0], U1 = ut[BMS_MAXU + 8], UT_ = U0 + U1;
    const int u_lo = (int)(((long)F.bid * UT_) / F.G), u_hi = (int)(((long)(F.bid + 1) * UT_) / F.G), nu = u_hi - u_lo;
    for (int q = F.tid; q < nu * 64; q += NTHREADS) { const int u = u_lo + (q >> 6), g = u >= U0, ug = g ? u - U0 : u; lent[q] = WSP(int, WS_TOKL)[(size_t)g * BMS_MAXU * 64 + (size_t)ug * 64 + (q & 63)]; }
    for (int q = F.tid; q < nu; q += NTHREADS) { const int u = u_lo + q, g = u >= U0, ug = g ? u - U0 : u; lcode[q] = g * 256 + (ut[g * (BMS_MAXU + 8) + 1 + ug] & 0xffff); }
    __syncthreads();
    LAS unsigned char* st = F.lds + AL_STAGE;
    const int tid = F.tid, krow = tid >> 3, kc = tid & 7, vsub = tid >> 8, vd = (tid & 255) >> 2, vc = tid & 3;
    auto ent = [&](int k) -> int { return lent[k * 64 + 8 * F.wave + tl]; };
    auto loadq = [&](int k, bf16x8 (&q)[4]) { const int e = ent(k), g = lcode[k] >> 8; const int t = e < 0 ? 0 : (e & 0xffff);
        const bf16_t* Q = WSP(bf16_t, WS_QN) + (size_t)(g * 4 + hh) * S * 64 + (size_t)t * 64 + 8 * hi;
#pragma unroll
        for (int ks = 0; ks < 4; ++ks) q[ks] = *(const bf16x8*)(Q + 16 * ks); };
    auto loadkv = [&](int gj, u32x4& rk, u32x4& rv) { const int g = gj >> 8, j = gj & 255;
        rk = *(const u32x4*)(WSP(bf16_t, WS_SK) + (size_t)g * S * 64 + (size_t)(64 * j + krow) * 64 + kc * 8); rv = *(const u32x4*)(WSP(bf16_t, WS_SVT) + (size_t)g * 64 * S + (size_t)(2 * j) * 2048 + tid * 8); };
    bf16x8 qr[3][4];
    if (nu > 0) loadq(0, qr[0]);
    if (nu > 1) loadq(1, qr[1]);
    int prev = -1; bool havepf = false; u32x4 rk, rv;
    for (int k0 = 0; k0 < nu; k0 += 3) {
#pragma unroll
      for (int d = 0; d < 3; ++d) { const int k = k0 + d; if (k >= nu) break;
        const int gj = __builtin_amdgcn_readfirstlane(lcode[k]); const int g = gj >> 8, j = gj & 255;
        if (k + 2 < nu) loadq(k + 2, qr[(d + 2) % 3]);
        if (gj != prev) {
            if (!havepf) loadkv(gj, rk, rv);
            __syncthreads();
            *(LAS u32x4*)(st + krow * KROW + kc * 16) = rk; *(LAS u32x4*)(st + ST_V + vsub * 64 * VROW + vd * VROW + vc * 16) = rv;
            __syncthreads(); prev = gj; havepf = false; }
        if (k + 1 < nu) { const int nx = __builtin_amdgcn_readfirstlane(lcode[k + 1]); if (nx != gj) { loadkv(nx, rk, rv); havepf = true; } }
        const int e_cur = ent(k);
        const bool valid = e_cur >= 0; const int t = valid ? (e_cur & 0xffff) : 0, slot = valid ? (e_cur >> 16) : 0;
        const LAS float* tb = tball + (g * 4 + hh) * TB_LD;
        int tmin = valid ? t : 0x7fffffff; tmin = wave_min_ui(tmin);
        const bool far = (tmin - (64 * j + 63) >= 128);
        f32x16 sv[2];
#pragma unroll
        for (int sub = 0; sub < 2; ++sub) { bf16x8 kf[4]; lds_k(kf, st, sub, lane); sv[sub] = qk32f(qr[d], kf);
            if (!far) t5_near(sv[sub], tb, t, 1, 64 * j + 32 * sub, hi, 1 << 30); }
        const float mx = xmax32(fmaxf(max16(sv[0]), max16(sv[1])));
        const float mu = (mx == NEG_INF) ? 0.f : mx;
        float l = 0.f; f32x16 o[2];
#pragma unroll
        for (int r = 0; r < 16; ++r) { o[0][r] = 0.f; o[1][r] = 0.f; }
#pragma unroll
        for (int sub = 0; sub < 2; ++sub) { exp16(sv[sub], mu, l); bf16x8 vf[4]; lds_v_T(vf, st, sub, lane); pv32f_T(o, sv[sub], vf); }
        l = xadd32(l);
        if (valid && hi == 0) *(f32x2*)(WSP(float, WS_PML) + ((((size_t)t * 2 + g) * 16 + slot) * 4 + hh) * 2) = (f32x2){far ? mx + tb[128] : mx, l};
        bf16_t* pbase = (g ? WSP(bf16_t, WS_X1) : (bf16_t*)P.out) + 2 * i;
#pragma unroll
        for (int rg = 0; rg < 4; ++rg) { const int e2 = lent[k * 64 + 8 * F.wave + 2 * rg + hi];
            if (e2 >= 0) { bf16_t* po = pbase + ((size_t)(e2 & 0xffff) * 16 + (e2 >> 16)) * 256;
#pragma unroll
                for (int h2 = 0; h2 < 4; ++h2) __builtin_nontemporal_store(cvtpk(o[0][4 * rg + h2], o[1][4 * rg + h2]), (unsigned*)(po + h2 * 64)); } }
      }
    }
    { volatile LAS int* tslot = (volatile LAS int*)(F.lds + AL_FLAG + 64);
      for (;;) {
        __syncthreads();
        if (F.tid == 0) *tslot = (int)atomicAdd(F.ctl + CW_QATT + 64, 1u);
        __syncthreads();
        const int q = __builtin_amdgcn_readfirstlane(*tslot);
        if (q >= NT_FOX) break;
        fox_task(F, 7 - (q >> 6), 63 - (q & 63));
      } }
    __syncthreads();
}

DI void phase_bms_combine(Frame& F, const Params& P) {
    const int lane = F.lane, gw = F.bid * NWAVES + F.wave, NGW = F.G * NWAVES;
    const int slotL = lane >> 2, hhL = lane & 3;
    const int sub = lane & 7, hhO = (lane >> 3) & 3, par = lane >> 5;
    struct Item { u32x4 pv[8]; f32x2 ml; float gate; f32x4 x0, x1; };
    auto load = [&](int it, Item& I) __attribute__((always_inline)) { const int t = it >> 1, g = it & 1; const int cur = t >> 6, nsel = cur < 15 ? cur + 1 : 16;
        const bf16_t* po = (g ? WSP(bf16_t, WS_X1) : (const bf16_t*)P.out) + (size_t)t * 4096 + hhO * 64 + 8 * sub;
#pragma unroll
        for (int k = 0; k < 8; ++k) { const int slot = 2 * k + par; I.pv[k] = __builtin_nontemporal_load((const u32x4*)(po + (slot < nsel ? slot : 0) * 256)); }
        I.ml = *(const f32x2*)(WSP(float, WS_PML) + ((size_t)it * 64 + lane) * 2);
        I.gate = WSP(float, WS_GN)[(size_t)t * 24 + g * 12 + hhL * 3 + 1];
        const float* XG = WSP(float, WS_U) + (size_t)t * 512 + g * 256 + hhO * 64 + 8 * sub;
        I.x0 = (f32x4){0.f, 0.f, 0.f, 0.f}; I.x1 = I.x0; if (par == 0) { I.x0 = *(const f32x4*)XG; I.x1 = *(const f32x4*)(XG + 4); } };
    auto compute = [&](int it, const Item& I) __attribute__((always_inline)) { const int t = it >> 1, g = it & 1; const int cur = t >> 6, nsel = cur < 15 ? cur + 1 : 16;
        const bool ok = slotL < nsel;
        const float m = ok ? I.ml[0] : NEG_INF;
        float M = m; M = fmaxf(M, dppf<0x124>(M)); M = fmaxf(M, dppf<0x128>(M)); M = xmax16(M); M = xmax32(M);
        const float wgt = (m == NEG_INF) ? 0.f : fexp2(m - M);
        float den = ok ? wgt * I.ml[1] : 0.f; den += dppf<0x124>(den); den += dppf<0x128>(den); den = xadd16(den); den = xadd32(den);
        const float sc = (den > 0.f) ? wgt * I.gate / den : 0.f;
        float acc[8];
#pragma unroll
        for (int q = 0; q < 8; ++q) acc[q] = 0.f;
#pragma unroll
        for (int k = 0; k < 8; ++k) { const int slot = 2 * k + par;
            const float w = __int_as_float(__builtin_amdgcn_ds_bpermute(4 * (slot * 4 + hhO), __float_as_int(sc)));
#pragma unroll
            for (int q = 0; q < 4; ++q) { acc[2 * q] += w * __builtin_bit_cast(float, I.pv[k][q] << 16); acc[2 * q + 1] += w * __builtin_bit_cast(float, I.pv[k][q] & 0xffff0000u); } }
#pragma unroll
        for (int q = 0; q < 8; ++q) acc[q] = xadd32(acc[q]);
        if (par == 0) { u32x4 wv; wv.x = cvtpk(I.x0[0] + acc[0], I.x0[1] + acc[1]); wv.y = cvtpk(I.x0[2] + acc[2], I.x0[3] + acc[3]); wv.z = cvtpk(I.x1[0] + acc[4], I.x1[1] + acc[5]); wv.w = cvtpk(I.x1[2] + acc[6], I.x1[3] + acc[7]);
            *(u32x4*)(WSP(bf16_t, WS_O) + (size_t)t * 1024 + g * 256 + hhO * 64 + 8 * sub) = wv; } };
    for (int it = gw; it < 2 * S; it += 4 * NGW) { Item A, B, C, D2; const bool h1 = it + NGW < 2 * S, h2 = it + 2 * NGW < 2 * S, h3 = it + 3 * NGW < 2 * S;
        load(it, A); if (h1) load(it + NGW, B); if (h2) load(it + 2 * NGW, C); if (h3) load(it + 3 * NGW, D2);
        compute(it, A); if (h1) compute(it + NGW, B); if (h2) compute(it + 2 * NGW, C); if (h3) compute(it + 3 * NGW, D2); }
}
#endif

DI void phase_lnmid_route(Frame& F, const Params& P, int rep) {
    const int lane = F.lane, w = F.wave;
    const float* XI = P.in[0]; const bf16_t* YB = WSP(bf16_t, WS_X1); bf16_t* X1 = WSP(bf16_t, WS_X1); bf16_t* U2 = WSP(bf16_t, WS_U); bf16_t* U2L = WSP(bf16_t, WS_U2L); const float* mod = WSP(float, WS_MOD);
    const float* ln1g = P.in[14]; const float* ln1b = P.in[15]; const float* brg = P.in[17]; const float* bre = P.in[19];
    int* toke = WSP(int, WS_TOKE); int* tokp = WSP(int, WS_TOKP); float* tokw = WSP(float, WS_TOKW);
    const bf16_t* WTh = WSP(bf16_t, WS_WRT); const bf16_t* WTl = WTh + 80 * 2048;
    LAS float* part = (LAS float*)F.lds;
    LAS unsigned* lhist = (LAS unsigned*)(F.lds + 4 * 64 * 84 * 4);
    constexpr int PLD = 84;
    LAS float* lv = (LAS float*)(F.lds + 88 * 1024);
    { const int col = 4 * F.tid; *(LAS f32x4*)(lv + col) = *(const f32x4*)(ln1g + col); *(LAS f32x4*)(lv + 2048 + col) = *(const f32x4*)(ln1b + col);
      *(LAS f32x4*)(lv + 4096 + col) = *(const f32x4*)(mod + 4 * D + col) + 1.0f; *(LAS f32x4*)(lv + 6144 + col) = *(const f32x4*)(mod + 3 * D + col); }
    __syncthreads();
    for (int blk = F.bid; blk < S / 64; blk += F.G) {
        const int base = blk * 64;
        if (F.tid < 64) lhist[F.tid] = 0u;
        { f32x4 vn[8];
          u32x2 yn[8];
          { const f32x4* rr = (const f32x4*)(XI + (size_t)(base + 8 * w) * D) + lane; const u32x2* yr = (const u32x2*)(YB + (size_t)(base + 8 * w) * D) + lane;
#pragma unroll
            for (int j = 0; j < 8; ++j) { vn[j] = rr[64 * j]; yn[j] = yr[64 * j]; } }
          for (int i8 = 0; i8 < (rep ? 0 : 8); ++i8) { const int m = base + 8 * w + i8;
            u32x2* xr = (u32x2*)(X1 + (size_t)m * D) + lane;
            LAS float* lvr = lv; asm volatile("" : "+v"(lvr));
            f32x4 v[8]; float s = 0.f;
#pragma unroll
            for (int j = 0; j < 8; ++j) { const u32x2 yw = yn[j];
                v[j][0] = vn[j][0] * ALPHA + __builtin_bit_cast(float, yw.x << 16); v[j][1] = vn[j][1] * ALPHA + __builtin_bit_cast(float, yw.x & 0xffff0000u);
                v[j][2] = vn[j][2] * ALPHA + __builtin_bit_cast(float, yw.y << 16); v[j][3] = vn[j][3] * ALPHA + __builtin_bit_cast(float, yw.y & 0xffff0000u);
                s += (v[j][0] + v[j][1]) + (v[j][2] + v[j][3]); }
            if (i8 < 7) { const f32x4* rr = (const f32x4*)(XI + (size_t)(m + 1) * D) + lane; const u32x2* yr = (const u32x2*)(YB + (size_t)(m + 1) * D) + lane;
#pragma unroll
                for (int j = 0; j < 8; ++j) { vn[j] = rr[64 * j]; yn[j] = yr[64 * j]; } }
            float mean = wave_sum(s) * (1.f / D), s2 = 0.f;
#pragma unroll
            for (int j = 0; j < 8; ++j) { v[j] = v[j] - mean; s2 += (v[j][0] * v[j][0] + v[j][1] * v[j][1]) + (v[j][2] * v[j][2] + v[j][3] * v[j][3]); }
            float rstd = 1.f / sqrtf(wave_sum(s2) * (1.f / D) + LN_EPS);
            s = 0.f;
#pragma unroll
            for (int j = 0; j < 8; ++j) { const int col = 4 * lane + 256 * j; v[j] = v[j] * rstd * *(const LAS f32x4*)(lvr + col) + *(const LAS f32x4*)(lvr + 2048 + col); { u32x2 xw; xw.x = cvtpk(v[j][0], v[j][1]); xw.y = cvtpk(v[j][2], v[j][3]); xr[64 * j] = xw; } s += (v[j][0] + v[j][1]) + (v[j][2] + v[j][3]); }
            mean = wave_sum(s) * (1.f / D); s2 = 0.f;
#pragma unroll
            for (int j = 0; j < 8; ++j) { v[j] = v[j] - mean; s2 += (v[j][0] * v[j][0] + v[j][1] * v[j][1]) + (v[j][2] * v[j][2] + v[j][3] * v[j][3]); }
            rstd = 1.f / sqrtf(wave_sum(s2) * (1.f / D) + LN_EPS);
            u32x2* oh = (u32x2*)(U2 + (size_t)m * D) + lane; u32x2* ol = (u32x2*)(U2L + (size_t)m * D) + lane;
#pragma unroll
            for (int j = 0; j < 8; ++j) { const int col = 4 * lane + 256 * j; const f32x4 y = v[j] * rstd * *(const LAS f32x4*)(lvr + 4096 + col) + *(const LAS f32x4*)(lvr + 6144 + col);
                u32x2 wh; wh.x = cvtpk(y[0], y[1]); wh.y = cvtpk(y[2], y[3]); oh[64 * j] = wh;
                const float r0 = y[0] - __builtin_bit_cast(float, wh.x << 16), r1 = y[1] - __builtin_bit_cast(float, wh.x & 0xffff0000u), r2 = y[2] - __builtin_bit_cast(float, wh.y << 16), r3 = y[3] - __builtin_bit_cast(float, wh.y & 0xffff0000u);
                u32x2 wl; wl.x = cvtpk(r0, r1); wl.y = cvtpk(r2, r3); ol[64 * j] = wl; }
          } }
        asm volatile("s_waitcnt vmcnt(0)" ::: "memory");
        __syncthreads();
        { const int n16 = lane & 15, kq = lane >> 4;
          const bf16_t* uh = U2 + (size_t)(base + n16) * D + w * 256 + 8 * kq; const bf16_t* ul = U2L + (size_t)(base + n16) * D + w * 256 + 8 * kq;
          const bf16_t* wh0 = WTh + (size_t)n16 * 2048 + w * 256 + 8 * kq; const bf16_t* wl0 = WTl + (size_t)n16 * 2048 + w * 256 + 8 * kq;
          f32x4 acc[4][5];
#pragma unroll
          for (int rt = 0; rt < 4; ++rt)
#pragma unroll
              for (int nt = 0; nt < 5; ++nt) acc[rt][nt] = (f32x4){0.f, 0.f, 0.f, 0.f};
#pragma unroll 1
          for (int ks = 0; ks < 8; ++ks) {
              bf16x8 a_h[4], a_l[4], b_h[5], b_l[5];
#pragma unroll
              for (int rt = 0; rt < 4; ++rt) { a_h[rt] = *(const bf16x8*)(uh + (size_t)rt * 16 * D + 32 * ks); a_l[rt] = *(const bf16x8*)(ul + (size_t)rt * 16 * D + 32 * ks); }
#pragma unroll
              for (int nt = 0; nt < 5; ++nt) { b_h[nt] = *(const bf16x8*)(wh0 + (size_t)nt * 16 * 2048 + 32 * ks); b_l[nt] = *(const bf16x8*)(wl0 + (size_t)nt * 16 * 2048 + 32 * ks); }
#pragma unroll
              for (int rt = 0; rt < 4; ++rt)
#pragma unroll
                  for (int nt = 0; nt < 5; ++nt) { acc[rt][nt] = mfma16(b_h[nt], a_h[rt], acc[rt][nt]); acc[rt][nt] = mfma16(b_l[nt], a_h[rt], acc[rt][nt]); acc[rt][nt] = mfma16(b_h[nt], a_l[rt], acc[rt][nt]); }
          }
          LAS float* slot = part + (w & 3) * 64 * PLD;
          if (w < 4) {
#pragma unroll
              for (int rt = 0; rt < 4; ++rt)
#pragma unroll
                  for (int nt = 0; nt < 5; ++nt)
#pragma unroll
                      for (int r = 0; r < 4; ++r) slot[(16 * rt + n16) * PLD + 16 * nt + 4 * kq + r] = acc[rt][nt][r]; }
          __syncthreads();
          if (w >= 4) {
#pragma unroll
              for (int rt = 0; rt < 4; ++rt)
#pragma unroll
                  for (int nt = 0; nt < 5; ++nt)
#pragma unroll
                      for (int r = 0; r < 4; ++r) slot[(16 * rt + n16) * PLD + 16 * nt + 4 * kq + r] += acc[rt][nt][r]; }
        }
        __syncthreads();
        if (F.tid < 64) { const int row = F.tid, m = base + row; const LAS float* p0 = part + row * PLD;
            float lg[8]; int grp = 0; float gmax = NEG_INF;
#pragma unroll
            for (int e = 0; e < 8; ++e) { lg[e] = ((p0[e] + p0[64 * PLD + e]) + (p0[2 * 64 * PLD + e] + p0[3 * 64 * PLD + e])) + brg[e]; if (lg[e] > gmax) { gmax = lg[e]; grp = e; } }
            float gden = 0.f;
#pragma unroll
            for (int e = 0; e < 8; ++e) gden += __expf(lg[e] - gmax);
            const float pgrp = 1.f / gden;
            int e0 = 0; float m0 = NEG_INF, le[8];
#pragma unroll
            for (int e = 0; e < 8; ++e) { { const int c = 8 + grp * 8 + e; le[e] = ((p0[c] + p0[64 * PLD + c]) + (p0[2 * 64 * PLD + c] + p0[3 * 64 * PLD + c])) + bre[grp * 8 + e]; } if (le[e] > m0) { m0 = le[e]; e0 = e; } }
            int e1 = 0; float m1 = NEG_INF;
#pragma unroll
            for (int e = 0; e < 8; ++e) if (e != e0 && le[e] > m1) { m1 = le[e]; e1 = e; }
            const float r1 = __expf(m1 - m0); const float w0 = pgrp / (1.f + r1), w1 = pgrp * r1 / (1.f + r1);
            const int ea = grp * 8 + e0, eb = grp * 8 + e1;
            const int pa = (int)__hip_atomic_fetch_add(lhist + ea, 1u, __ATOMIC_RELAXED, __HIP_MEMORY_SCOPE_WORKGROUP), pb = (int)__hip_atomic_fetch_add(lhist + eb, 1u, __ATOMIC_RELAXED, __HIP_MEMORY_SCOPE_WORKGROUP);
            toke[2 * m] = ea; toke[2 * m + 1] = eb; tokp[2 * m] = pa; tokp[2 * m + 1] = pb; tokw[2 * m] = w0; tokw[2 * m + 1] = w1;
        }
        __syncthreads();
        if (F.tid < 64) WSP(int, WS_HIST)[blk * 64 + F.tid] = (int)lhist[F.tid];
        __syncthreads();
    }
}

DI void phase_scatter(Frame& F, const Params& P) {
    LAS int* base = (LAS int*)F.lds;
    LAS int* tot = base + 64; LAS int* off = base + 128;
    LAS int* ptot = base + 192; LAS int* poff = base + 192 + 512;
    const int* hist = WSP(int, WS_HIST);
    const int* toke = WSP(int, WS_TOKE); const int* tokp = WSP(int, WS_TOKP); const float* tokw = WSP(float, WS_TOKW);
    int* rt = WSP(int, WS_ROWTOK); int* rd = WSP(int, WS_ROWDST); float* rw = WSP(float, WS_ROWW);
    for (int blk = F.bid; blk < S / 64; blk += F.G) {
        { const int e = F.tid & 63, part = F.tid >> 6; int t = 0, o = 0;
#pragma unroll 8
          for (int b = part * 32; b < part * 32 + 32; ++b) { const int hv = hist[b * 64 + e]; t += hv; o += (b < blk) ? hv : 0; }
          ptot[part * 64 + e] = t; poff[part * 64 + e] = o; }
        __syncthreads();
        if (F.tid < 64) { int t = 0, o = 0;
#pragma unroll
            for (int p = 0; p < 8; ++p) { t += ptot[p * 64 + F.tid]; o += poff[p * 64 + F.tid]; }
            tot[F.tid] = t; off[F.tid] = o; }
        __syncthreads();
        if (F.tid == 0) { int run = 0; int* pane = WSP(int, WS_PANE); int np = 0;
            for (int e = 0; e < NEXP; ++e) { const int c = tot[e]; base[e] = run; const int npan = (c + 255) >> 8;
                if (blk == 0) for (int q = 0; q < npan; ++q) pane[1 + np + q] = e;
                np += npan; run += npan * 256; }
            if (blk == 0) pane[0] = np; }
        __syncthreads();
        if (F.tid < 128) { const int i = blk * 128 + F.tid; const int e = toke[i]; const int row = base[e] + off[e] + tokp[i]; rt[row] = i >> 1; rd[row] = i; rw[row] = tokw[i]; }
        __syncthreads();
    }
}

DI void phase_final(Frame& F, const Params& P) {
    const int lane = F.lane, gw = F.bid * NWAVES + F.wave, NGW = F.G * NWAVES;
    const bf16_t* X1 = WSP(bf16_t, WS_X1); const bf16_t* Y2 = WSP(bf16_t, WS_Y2); const float* mod = WSP(float, WS_MOD);
    const float* g2p = mod + 5 * D; const float* lg = P.in[23]; const float* lb = P.in[24];
    f32x4 G2[8], LG[8], LB[8];
#pragma unroll
    for (int j = 0; j < 8; ++j) { const int col = 4 * lane + 256 * j; G2[j] = *(const f32x4*)(g2p + col) + 1.0f; LG[j] = *(const f32x4*)(lg + col); LB[j] = *(const f32x4*)(lb + col); }
    for (int m = gw; m < S; m += NGW) {
        const u32x2* xr = (const u32x2*)(X1 + (size_t)m * D) + lane;
        const u32x2* ya = (const u32x2*)(Y2 + (size_t)(2 * m) * D) + lane; const u32x2* yb = (const u32x2*)(Y2 + (size_t)(2 * m + 1) * D) + lane;
        f32x4 v[8]; float s = 0.f;
#pragma unroll
        for (int j = 0; j < 8; ++j) { const int col = 4 * lane + 256 * j; const u32x2 a = ya[64 * j], b = yb[64 * j];
            f32x4 y; y[0] = __builtin_bit_cast(float, a.x << 16) + __builtin_bit_cast(float, b.x << 16); y[1] = __builtin_bit_cast(float, a.x & 0xffff0000u) + __builtin_bit_cast(float, b.x & 0xffff0000u);
            y[2] = __builtin_bit_cast(float, a.y << 16) + __builtin_bit_cast(float, b.y << 16); y[3] = __builtin_bit_cast(float, a.y & 0xffff0000u) + __builtin_bit_cast(float, b.y & 0xffff0000u);
            const u32x2 xw = xr[64 * j]; const f32x4 x1v = (f32x4){__builtin_bit_cast(float, xw.x << 16), __builtin_bit_cast(float, xw.x & 0xffff0000u), __builtin_bit_cast(float, xw.y << 16), __builtin_bit_cast(float, xw.y & 0xffff0000u)};
            v[j] = x1v * ALPHA + G2[j] * y; s += (v[j][0] + v[j][1]) + (v[j][2] + v[j][3]); }
        const float mean = wave_sum(s) * (1.f / D); float s2 = 0.f;
#pragma unroll
        for (int j = 0; j < 8; ++j) { v[j] = v[j] - mean; s2 += (v[j][0] * v[j][0] + v[j][1] * v[j][1]) + (v[j][2] * v[j][2] + v[j][3] * v[j][3]); }
        const float rstd = 1.f / sqrtf(wave_sum(s2) * (1.f / D) + LN_EPS);
        f32x4* o = (f32x4*)(P.out + (size_t)m * D) + lane;
#pragma unroll
        for (int j = 0; j < 8; ++j) o[64 * j] = v[j] * rstd * LG[j] + LB[j];
    }
}

constexpr int NPHASE = 14;
__global__ void __launch_bounds__(NTHREADS, 2) fwd_kernel(Params P) {
    extern __shared__ __attribute__((aligned(16))) unsigned char lds_raw[];
    Frame F;
    F.lds = (LAS unsigned char*)lds_raw; F.ws = P.ws; F.ctl = (unsigned*)(P.ws + WS_CTL);
    F.tid = threadIdx.x; F.lane = F.tid & 63; F.wave = __builtin_amdgcn_readfirstlane(F.tid >> 6); F.G = gridDim.x; F.bid = blockIdx.x;
    volatile LAS unsigned* misc = (volatile LAS unsigned*)(F.lds + LDS_MISC);
    if (F.tid < 16) misc[F.tid] = 0u;
    __syncthreads();
    const int lo = P.ph_lo, hi = P.ph_hi;
    XcdBarrier bar; bar.bar = F.ctl + CW_BAR; bar.x = 0; bar.st = nullptr;
    if (hi - lo > 1) bar = xcd_barrier_post(F.ctl + CW_BAR, misc + 8);
#ifndef PHMASK
#define PHMASK 0xffff
#endif
#define IN(k) (((PHMASK >> (k)) & 1) && lo <= (k) && (k) < hi)
#define RUN(k, ...) do { __VA_ARGS__; if (REPS(k) > 1) { __VA_ARGS__; } } while (0)
#define SEAM(k) do { if (IN(k) && IN((k) + 1)) xcd_barrier(bar); } while (0)
    LAS unsigned char* glds = F.lds;

    if (IN(0)) { RUN(0, phase_prologue<0>(F, P)); }
    SEAM(0);
    if (IN(1)) { RUN(1, phase_ln1(F, P)); }
    SEAM(1);
    if (IN(2)) {
        pg8::Gemm g{WSP(bf16_t, WS_U), WSP(bf16_t, WS_WINT), D, D, D, nullptr}; pg8::SchedGrid Sd; Sd.init(S, NIN, D, D, F.G, F.bid);
        EpiIn E{F.ws, P.in[5]};
        if (WCO) { const int a = F.bid & 7; using SR = pg8::SchedRange<pg8::SchedGrid>; SR r0{Sd, 0, a}, r1{Sd, a, 1 << 30};
            pg8::gemm_phase<EpiIn, SR, false>(glds, g, r0, E); __syncthreads();
            phase_prologue<1>(F, P); __syncthreads();
            pg8::gemm_phase<EpiIn, SR, false>(glds, g, r1, E); }
        else RUN(2, pg8::gemm_phase<EpiIn, pg8::SchedGrid, false>(glds, g, Sd, E));
    }
    SEAM(2);
    if (IN(3)) {
        pg8::Gemm g{WSP(bf16_t, WS_CKV), WSP(bf16_t, WS_W1T), 1024, 2048, 512, nullptr}; SchedCmp Sd{F.G, F.bid};
        EpiCmp E{WSP(float, WS_HC)};
        RUN(3, pg8::gemm_phase<EpiCmp, SchedCmp, false>(glds, g, Sd, E));
    }
    SEAM(3);
    if (IN(4)) { RUN(4, phase_cmp2_scan(F, P)); }
    SEAM(4);
    if (IN(5)) { { phase_attn(F, P, 0); if (REPS(5) > 1) phase_attn(F, P, 1); } }
#if BMS
    if (IN(5)) { if (hi - lo > 1) xcd_barrier(bar); phase_bms_sort(F, P); if (BMSREP & 1) phase_bms_sort(F, P);
                 if (hi - lo > 1) xcd_barrier(bar); phase_bms_attn(F, P); if (BMSREP & 2) phase_bms_attn(F, P);
                 if (hi - lo > 1) xcd_barrier(bar); phase_bms_combine(F, P); if (BMSREP & 4) phase_bms_combine(F, P); }
#endif
    SEAM(5);
    if (IN(6)) {
        pg8::Gemm g{WSP(bf16_t, WS_O), WSP(bf16_t, WS_BRT1), 1024, 512, 512, nullptr}; pg8::SchedGrid Sd; Sd.init(S, D, 1024, 512, F.G, F.bid);
        EpiMerge<1> E{WSP(bf16_t, WS_GM), WSP(bf16_t, WS_MG)};
        RUN(6, pg8::gemm_phase<EpiMerge<1>, pg8::SchedGrid, false>(glds, g, Sd, E));
    }
    if (IN(6) && IN(7)) __syncthreads();
    if (IN(7)) {
        pg8::Gemm g{WSP(bf16_t, WS_O) + 512, WSP(bf16_t, WS_BRT2), 1024, 512, 512, nullptr}; pg8::SchedGrid Sd; Sd.init(S, D, 1024, 512, F.G, F.bid);
        EpiMerge<2> E{WSP(bf16_t, WS_GM), WSP(bf16_t, WS_MG)};
        pg8::gemm_phase<EpiMerge<2>, pg8::SchedGrid, false>(glds, g, Sd, E);
    }
    SEAM(7);
    if (IN(8)) {
        pg8::Gemm g{WSP(bf16_t, WS_MG), WSP(bf16_t, WS_WOT), D, D, D, nullptr}; pg8::SchedGrid Sd; Sd.init(S, D, D, D, F.G, F.bid);
        EpiWo E{WSP(float, WS_MOD), WSP(bf16_t, WS_X1)};
        RUN(8, pg8::gemm_phase<EpiWo, pg8::SchedGrid, false>(glds, g, Sd, E));
    }
    SEAM(8);
    if (IN(9)) { phase_lnmid_route(F, P, 0); if (REPS(9) > 1) phase_lnmid_route(F, P, 1); }
    SEAM(9);
    if (IN(10)) { RUN(10, phase_scatter(F, P)); }
    SEAM(10);
    if (IN(11)) {
        LAS int* lpane = (LAS int*)(F.lds + 131072); if (F.tid < 256) lpane[F.tid] = WSP(int, WS_PANE)[F.tid]; __syncthreads();
        pg8::Gemm g{WSP(bf16_t, WS_U), WSP(bf16_t, WS_WGUT), D, D, D, WSP(int, WS_ROWTOK)}; SchedMoe Sd{lpane, 4, F.G, F.bid, 0, (size_t)256 * D * 2};
        EpiGU E{WSP(bf16_t, WS_H)};
        RUN(11, pg8::gemm_phase<EpiGU, SchedMoe, true>(glds, g, Sd, E));
    }
    SEAM(11);
    if (IN(12)) {
        LAS int* lpane = (LAS int*)(F.lds + 131072); if (F.tid < 256) lpane[F.tid] = WSP(int, WS_PANE)[F.tid]; __syncthreads();
        pg8::Gemm g{WSP(bf16_t, WS_H), WSP(bf16_t, WS_WDT), DEXP, DEXP, DEXP, nullptr}; SchedMoe Sd{lpane, 8, F.G, F.bid, (size_t)256 * DEXP * 2, (size_t)256 * DEXP * 2};
        EpiDown E{WSP(int, WS_ROWDST), WSP(float, WS_ROWW), WSP(bf16_t, WS_Y2)};
        RUN(12, pg8::gemm_phase<EpiDown, SchedMoe, false>(glds, g, Sd, E));
    }
    SEAM(12);
    if (IN(13)) { RUN(13, phase_final(F, P)); }
#undef IN
#undef SEAM
}

extern "C" void kernel_launch(void* const* d_in, const int* in_sizes, int n_in, void* d_out, int out_size, void* d_ws, size_t ws_size, hipStream_t stream) {
    static int grid = 0;
    if (grid == 0) {
        if (n_in != 25 || out_size != S * D || ws_size < WS_END) { fprintf(stderr, "kernel_launch: unexpected problem (n_in %d, out %d, ws %zu < %zu)\n", n_in, out_size, ws_size, (size_t)WS_END); grid = -1; return; }
        int dev = 0, cus = 0, per_cu = 0;
        if (hipGetDevice(&dev) != hipSuccess || hipDeviceGetAttribute(&cus, hipDeviceAttributeMultiprocessorCount, dev) != hipSuccess) { grid = -1; return; }
        if (hipFuncSetAttribute((const void*)fwd_kernel, hipFuncAttributeMaxDynamicSharedMemorySize, LDS_BYTES) != hipSuccess) { fprintf(stderr, "kernel_launch: hipFuncSetAttribute failed\n"); grid = -1; return; }
        if (hipOccupancyMaxActiveBlocksPerMultiprocessor(&per_cu, (const void*)fwd_kernel, NTHREADS, LDS_BYTES) != hipSuccess || per_cu < 1) fprintf(stderr, "kernel_launch: occupancy query says %d\n", per_cu);
        (void)hipGetLastError();
        grid = cus;
    }
    if (grid < 0) return;
    (void)hipMemsetAsync((char*)d_ws + WS_CTL, 0, CTL_BYTES, stream);
    Params p{};
    for (int i = 0; i < 25; ++i) p.in[i] = (const float*)d_in[i];
    p.out = (float*)d_out; p.ws = (unsigned char*)d_ws;
#if N_LAUNCH_SPLIT
    for (int k = 0; k < NPHASE; ++k) { p.ph_lo = k; p.ph_hi = k + 1; hipLaunchKernelGGL(fwd_kernel, dim3(grid), dim3(NTHREADS), LDS_BYTES, stream, p); }
#else
    p.ph_lo = 0; p.ph_hi = NPHASE; hipLaunchKernelGGL(fwd_kernel, dim3(grid), dim3(NTHREADS), LDS_BYTES, stream, p);
#endif
}
```
